# Optimizing an MI355X kernel written in HIP

```python
import math
import jax
import jax.numpy as jnp
from jax import lax
import numpy as np

D_MODEL = 1024
BATCH = 4
SEQ = 8192
DEPTH = 2

GRID_W = 64
CTX_LEN = 256
N_ADA = 9
EPS = 1e-6
NEG_INF = -1e30
ROPE_BASE = 10000.0
D_FF = ((8 * D_MODEL // 3 + 127) // 128) * 128

HEAD_DIM = 64
NA_HEADS = 4
NA_WIN_ROWS = 8
NA_WIN_COLS = 16
NA_QBLOCK_COLS = 16
NA_KBLOCK_COLS = 32
D_A = NA_HEADS * HEAD_DIM
GM_GROUPS = 4
GM_WIDTH = 64
GM_CHUNK = 128
D_B = GM_GROUPS * GM_WIDTH
DA_HEADS = 4
DA_QK_DIM = 64
DA_V_DIM = 2 * DA_QK_DIM
DA_QBLOCK = 128
D_C = DA_HEADS * DA_V_DIM
D_QK_C = DA_HEADS * 2 * DA_QK_DIM

D_MIX = D_A + D_B + D_C
SPLIT_SIZES = (D_A, D_A, D_A, D_B, D_B, D_QK_C, D_QK_C, D_C)
SPLIT_POINTS = (D_A, 2 * D_A, 3 * D_A, 3 * D_A + D_B, 3 * D_A + 2 * D_B,
                3 * D_A + 2 * D_B + D_QK_C, 3 * D_A + 2 * D_B + 2 * D_QK_C)
D_IN = 3 * D_A + 2 * D_B + 2 * D_QK_C + D_C

kernel_name = "hybrid_natten_gmlp_diffattn_dit_block"


def rms_norm(x, gain=None, eps=EPS):
    xf = x.astype(jnp.float32)
    y = xf * lax.rsqrt(jnp.mean(xf * xf, axis=-1, keepdims=True) + eps)
    if gain is not None:
        y = y * gain.astype(jnp.float32)
    return y.astype(x.dtype)


def modulate(x, shift, scale):
    return rms_norm(x) * (1 + scale) + shift


def swiglu(h, w1, w3, w2):
    return (jax.nn.silu(h @ w1) * (h @ w3)) @ w2


def axial_rope_tables(n_tokens):
    t = jnp.arange(n_tokens)
    row = (t // GRID_W).astype(jnp.float32)
    col = (t % GRID_W).astype(jnp.float32)
    n_freq = DA_QK_DIM // 4
    freqs = ROPE_BASE ** (-jnp.arange(n_freq, dtype=jnp.float32) / n_freq)
    ang = jnp.concatenate([row[:, None] * freqs, col[:, None] * freqs], axis=-1)
    return jnp.cos(ang), jnp.sin(ang)


def apply_rope(x, cos, sin):
    half = x.shape[-1] // 2
    xf = x.astype(jnp.float32)
    x1, x2 = xf[..., :half], xf[..., half:]
    out = jnp.concatenate([x1 * cos - x2 * sin, x1 * sin + x2 * cos], axis=-1)
    return out.astype(x.dtype)


def split_projection(z):
    B, n, _ = z.shape
    qa, ka, va, ub, vb, qd, kd, vd = jnp.split(z, SPLIT_POINTS, axis=-1)
    heads = lambda t: t.reshape(B, n, NA_HEADS, HEAD_DIM).transpose(0, 2, 1, 3)
    groups = lambda t: jax.nn.gelu(t, approximate=False).reshape(B, n, GM_GROUPS, GM_WIDTH)
    qk_c = lambda t: t.reshape(B, n, DA_HEADS, 2, DA_QK_DIM)
    return (heads(qa), heads(ka), heads(va), groups(ub), groups(vb),
            qk_c(qd), qk_c(kd), vd.reshape(B, n, DA_HEADS, DA_V_DIM))


def neighborhood_attention(q, k, v, kc, vc, rpb):
    B, H, L, d = q.shape
    rows = L // GRID_W
    kh = min(NA_WIN_ROWS, rows)
    scale = d ** -0.5
    qg = q.reshape(B, H, rows, GRID_W, d)
    kg = k.reshape(B, H, rows, GRID_W, d)
    vg = v.reshape(B, H, rows, GRID_W, d)
    r = jnp.arange(rows)
    key_rows = jnp.clip(r - kh // 2, 0, rows - kh)[:, None] + jnp.arange(kh)[None, :]
    dr_idx = key_rows - r[:, None] + (NA_WIN_ROWS - 1)
    s_ctx = (jnp.einsum('bhld,bhcd->bhlc', q, kc).astype(jnp.float32) * scale
             ).reshape(B, H, rows, GRID_W, -1)
    n_win = kh * NA_KBLOCK_COLS
    outs = []
    for j in range(GRID_W // NA_QBLOCK_COLS):
        qc0 = j * NA_QBLOCK_COLS
        kc0 = min(max(qc0 - NA_WIN_COLS // 2, 0), GRID_W - NA_KBLOCK_COLS)
        qcols = np.arange(qc0, qc0 + NA_QBLOCK_COLS)
        kcols = np.arange(kc0, kc0 + NA_KBLOCK_COLS)
        w0 = np.clip(qcols - NA_WIN_COLS // 2, 0, GRID_W - NA_WIN_COLS)
        in_win = (kcols[None, :] >= w0[:, None]) & (kcols[None, :] < w0[:, None] + NA_WIN_COLS)
        mask = np.broadcast_to(in_win[:, None, :], (NA_QBLOCK_COLS, kh, NA_KBLOCK_COLS)
                               ).reshape(NA_QBLOCK_COLS, n_win)
        dc_idx = np.clip(kcols[None, :] - qcols[:, None] + NA_WIN_COLS - 1, 0, 2 * NA_WIN_COLS - 2)
        bias = rpb[:, dr_idx[:, :, None, None], dc_idx[None, None, :, :]]
        bias = bias.transpose(0, 1, 3, 2, 4).reshape(H, rows, NA_QBLOCK_COLS, n_win)
        kb = kg[:, :, :, kc0:kc0 + NA_KBLOCK_COLS][:, :, key_rows].reshape(B, H, rows, n_win, d)
        vb = vg[:, :, :, kc0:kc0 + NA_KBLOCK_COLS][:, :, key_rows].reshape(B, H, rows, n_win, d)
        qb = qg[:, :, :, qc0:qc0 + NA_QBLOCK_COLS]
        s_win = jnp.einsum('bhrqd,bhrkd->bhrqk', qb, kb).astype(jnp.float32) * scale \
            + bias.astype(jnp.float32)[None]
        s_win = jnp.where(mask, s_win, NEG_INF)
        s = jnp.concatenate([s_win, s_ctx[:, :, :, qc0:qc0 + NA_QBLOCK_COLS]], axis=-1)
        p = jax.nn.softmax(s, axis=-1).astype(v.dtype)
        o = jnp.einsum('bhrqk,bhrkd->bhrqd', p[..., :n_win], vb) \
            + jnp.einsum('bhrqc,bhcd->bhrqd', p[..., n_win:], vc)
        outs.append(o)
    return jnp.concatenate(outs, axis=3).reshape(B, H, L, d)


def dense_attention(q, k, v):
    s = jnp.einsum('bhqd,bhkd->bhqk', q, k).astype(jnp.float32) * (q.shape[-1] ** -0.5)
    p = jax.nn.softmax(s, axis=-1).astype(v.dtype)
    return jnp.einsum('bhqk,bhkd->bhqd', p, v)


def chunk_gmlp(u, v, w_s, b_s, g_norm):
    B, n, G, W = u.shape
    vn = rms_norm(v, g_norm).reshape(B, n // GM_CHUNK, GM_CHUNK, G, W)
    s = jnp.einsum('gpq,bcqgw->bcpgw', w_s, vn) + b_s.T[None, None, :, :, None]
    return u * s.reshape(B, n, G, W)


def diff_weighted_values(q, k, v, lam, scale):
    s = jnp.einsum('bqhcd,bkhcd->bhcqk', q, k).astype(jnp.float32) * scale
    p = jax.nn.softmax(s, axis=-1)
    w = p[:, :, 0] - lam * p[:, :, 1]
    return jnp.einsum('bhqk,bkhd->bqhd', w.astype(v.dtype), v)


def diff_attention_latent(q, k, v, kc, vc, lam):
    B, L, H, _, dq = q.shape
    scale = dq ** -0.5
    keys = jnp.concatenate([k, kc], axis=1)
    vals = jnp.concatenate([v, vc], axis=1)
    nb = L // DA_QBLOCK
    q_blocks = q.reshape(B, nb, DA_QBLOCK, H, 2, dq).transpose(1, 0, 2, 3, 4, 5)
    out = lax.map(lambda qb: diff_weighted_values(qb, keys, vals, lam, scale), q_blocks)
    return out.transpose(1, 0, 2, 3, 4).reshape(B, L, H, v.shape[-1])


def merge_mixers(out_a, out_b, out_c, w_out, da_subln, lambda_init):
    B, n = out_b.shape[0], out_b.shape[1]
    a = out_a.transpose(0, 2, 1, 3).reshape(B, n, D_A)
    b = out_b.reshape(B, n, D_B)
    cmix = (rms_norm(out_c, da_subln) * (1.0 - lambda_init)).reshape(B, n, D_C)
    return jnp.concatenate([a, b, cmix], axis=-1) @ w_out


def hybrid_layer(x, xc, c_silu, cc_silu, rope_cos, rope_sin, layer_idx, ctx_out,
                 w_ada, b_ada, ffn1_w1, ffn1_w3, ffn1_w2, w_in, w_out, na_rpb,
                 gm_ws, gm_bs, gm_norm, da_lq1, da_lk1, da_lq2, da_lk2, da_subln,
                 ffn2_w1, ffn2_w3, ffn2_w2):
    mod = jnp.split((c_silu @ w_ada + b_ada)[:, None, :], N_ADA, axis=-1)
    mod_c = jnp.split((cc_silu @ w_ada + b_ada)[None, None, :], N_ADA, axis=-1)

    x = x + 0.5 * mod[2] * swiglu(modulate(x, mod[0], mod[1]), ffn1_w1, ffn1_w3, ffn1_w2)
    xc = xc + 0.5 * mod_c[2] * swiglu(modulate(xc, mod_c[0], mod_c[1]), ffn1_w1, ffn1_w3, ffn1_w2)

    qa, ka, va, ub, vb, qd, kd, vd = split_projection(modulate(x, mod[3], mod[4]) @ w_in)
    qac, kac, vac, ubc, vbc, qdc, kdc, vdc = split_projection(modulate(xc, mod_c[3], mod_c[4]) @ w_in)

    lambda_init = 0.8 - 0.6 * math.exp(-0.3 * layer_idx)
    lam = (jnp.exp(jnp.sum(da_lq1.astype(jnp.float32) * da_lk1.astype(jnp.float32)))
           - jnp.exp(jnp.sum(da_lq2.astype(jnp.float32) * da_lk2.astype(jnp.float32))) + lambda_init)

    out_a = neighborhood_attention(qa, ka, va, kac, vac, na_rpb)
    out_b = chunk_gmlp(ub, vb, gm_ws, gm_bs, gm_norm)
    cos = rope_cos[None, :, None, None, :]
    sin = rope_sin[None, :, None, None, :]
    out_c = diff_attention_latent(apply_rope(qd, cos, sin), apply_rope(kd, cos, sin), vd, kdc, vdc, lam)
    x = x + mod[5] * merge_mixers(out_a, out_b, out_c, w_out, da_subln, lambda_init)

    if ctx_out:
        out_ac = dense_attention(qac, kac, vac)
        out_bc = chunk_gmlp(ubc, vbc, gm_ws, gm_bs, gm_norm)
        out_cc = diff_weighted_values(qdc, kdc, vdc, lam, DA_QK_DIM ** -0.5)
        xc = xc + mod_c[5] * merge_mixers(out_ac, out_bc, out_cc, w_out, da_subln, lambda_init)
        xc = xc + 0.5 * mod_c[8] * swiglu(modulate(xc, mod_c[6], mod_c[7]), ffn2_w1, ffn2_w3, ffn2_w2)

    x = x + 0.5 * mod[8] * swiglu(modulate(x, mod[6], mod[7]), ffn2_w1, ffn2_w3, ffn2_w2)
    return x, xc


def setup_inputs(seed: int = 0) -> dict:
    key = jax.random.key(seed)
    ks = jax.random.split(key, 24)
    f32 = jnp.float32

    def nrm(k, shape, scale):
        return jax.random.normal(k, shape, f32) * scale

    return {
        "x": nrm(ks[0], (BATCH, SEQ, D_MODEL), 1.0),
        "c": nrm(ks[1], (BATCH, D_MODEL), 1.0),
        "ctx": nrm(ks[2], (BATCH, CTX_LEN, D_MODEL), 1.0),
        "c_ctx": nrm(ks[3], (D_MODEL,), 1.0),
        "w_ada": nrm(ks[4], (DEPTH, D_MODEL, N_ADA * D_MODEL), D_MODEL ** -0.5),
        "b_ada": nrm(ks[5], (DEPTH, N_ADA * D_MODEL), 0.02),
        "ffn1_w1": nrm(ks[6], (DEPTH, D_MODEL, D_FF), D_MODEL ** -0.5),
        "ffn1_w3": nrm(ks[7], (DEPTH, D_MODEL, D_FF), D_MODEL ** -0.5),
        "ffn1_w2": nrm(ks[8], (DEPTH, D_FF, D_MODEL), D_FF ** -0.5),
        "w_in": nrm(ks[9], (DEPTH, D_MODEL, D_IN), D_MODEL ** -0.5),
        "w_out": nrm(ks[10], (DEPTH, D_MIX, D_MODEL), D_MIX ** -0.5),
        "na_rpb": nrm(ks[11], (DEPTH, NA_HEADS, 2 * NA_WIN_ROWS - 1, 2 * NA_WIN_COLS - 1), 0.5),
        "gm_ws": nrm(ks[12], (DEPTH, GM_GROUPS, GM_CHUNK, GM_CHUNK), GM_CHUNK ** -0.5),
        "gm_bs": 1.0 + nrm(ks[13], (DEPTH, GM_GROUPS, GM_CHUNK), 0.02),
        "gm_norm": 1.0 + nrm(ks[14], (DEPTH, GM_GROUPS, GM_WIDTH), 0.02),
        "da_lq1": nrm(ks[15], (DEPTH, DA_QK_DIM), 0.1),
        "da_lk1": nrm(ks[16], (DEPTH, DA_QK_DIM), 0.1),
        "da_lq2": nrm(ks[17], (DEPTH, DA_QK_DIM), 0.1),
        "da_lk2": nrm(ks[18], (DEPTH, DA_QK_DIM), 0.1),
        "da_subln": 1.0 + nrm(ks[19], (DEPTH, DA_V_DIM), 0.02),
        "ffn2_w1": nrm(ks[20], (DEPTH, D_MODEL, D_FF), D_MODEL ** -0.5),
        "ffn2_w3": nrm(ks[21], (DEPTH, D_MODEL, D_FF), D_MODEL ** -0.5),
        "ffn2_w2": nrm(ks[22], (DEPTH, D_FF, D_MODEL), D_FF ** -0.5),
        "final_norm": 1.0 + nrm(ks[23], (D_MODEL,), 0.02),
    }


def reference(x, c, ctx, c_ctx, w_ada, b_ada, ffn1_w1, ffn1_w3, ffn1_w2, w_in, w_out, na_rpb,
              gm_ws, gm_bs, gm_norm, da_lq1, da_lk1, da_lq2, da_lk2, da_subln,
              ffn2_w1, ffn2_w3, ffn2_w2, final_norm):
    n_tokens = x.shape[1]
    rope_cos, rope_sin = axial_rope_tables(n_tokens)
    c_silu = jax.nn.silu(c)
    cc_silu = jax.nn.silu(c_ctx)
    xc = ctx
    for l in range(DEPTH):
        x, xc = hybrid_layer(
            x, xc, c_silu, cc_silu, rope_cos, rope_sin, l, l < DEPTH - 1,
            w_ada[l], b_ada[l], ffn1_w1[l], ffn1_w3[l], ffn1_w2[l], w_in[l], w_out[l], na_rpb[l],
            gm_ws[l], gm_bs[l], gm_norm[l], da_lq1[l], da_lk1[l], da_lq2[l], da_lk2[l], da_subln[l],
            ffn2_w1[l], ffn2_w3[l], ffn2_w2[l])
    return rms_norm(x, final_norm)
```

```cpp
#include <hip/hip_runtime.h>
#include <hip/hip_cooperative_groups.h>
#include <cstdio>
#include <cstdint>
namespace cg = cooperative_groups;
#ifndef ONE_LAUNCH
#define ONE_LAUNCH 1
#endif
namespace pg8 {
#define PG8_LAS __attribute__((address_space(3)))
typedef unsigned short bf16_t;
typedef short bf16x8 __attribute__((ext_vector_type(8)));
typedef float f32x4 __attribute__((ext_vector_type(4)));
typedef unsigned u32x4 __attribute__((ext_vector_type(4)));
constexpr int BM = 256, BK = 64, HALF = 128, HTB = HALF * BK * 2  , STAGE_BYTES = 8 * HTB, NXCD = 8, WGM = 8;

__host__ __device__ __forceinline__ int lds_byte(int r, int c) { const int st = (r >> 4) * 2 + (c >> 5), rr = r & 15, cc = c & 31, ob = rr * 64 + cc * 2; return st * 1024 + (ob ^ (((ob >> 9) & 1) << 5)); }
__host__ __device__ __forceinline__ void stage_rc(int b, int& R, int& C) { const int st = b / 1024, sb = b % 1024, swz = sb ^ (((sb >> 9) & 1) << 5); R = (st >> 1) * 16 + swz / 64; C = (st & 1) * 32 + (swz % 64) / 2; }
__host__ __device__ __forceinline__ int perm32(int rho) { const int n = rho >> 4, i = rho & 15; return 8 * (i >> 2) + 4 * n + (i & 3); }

struct Unit { int pm, pn; };
struct Gemm { const bf16_t* A; const bf16_t* Bt; int M, N, K; };

struct StaticOrder {
    int nM, nN, nwg, G, c;
    __host__ __device__ void init(int M, int N, int G_, int c_) { nM = M / BM; nN = N / BM; nwg = nM * nN; G = G_; c = c_; }
    __host__ __device__ bool next(int i, Unit& u) const {
        const long L = (long)i * G + c; if (L >= nwg) return false;
        int wgid = (int)L; { const int q = nwg / NXCD, r = nwg % NXCD, xcd = wgid % NXCD, off = wgid / NXCD; wgid = (xcd < r ? xcd * (q + 1) : r * (q + 1) + (xcd - r) * q) + off; }
        const int nig = WGM * nN, gid = wgid / nig, fm = gid * WGM, gsz = (nM - fm) < WGM ? (nM - fm) : WGM;
        u.pm = fm + ((wgid % nig) % gsz); u.pn = (wgid % nig) / gsz; return true;
    }
    __device__ __forceinline__ void a_ready(const Unit&) const {}
    __device__ __forceinline__ void done(const Unit&) const {}
};

__device__ __forceinline__ unsigned cvt_pk_bf16(float lo, float hi) { unsigned r; asm volatile("v_cvt_pk_bf16_f32 %0, %1, %2" : "=v"(r) : "v"(lo), "v"(hi)); return r; }
typedef float f32x2 __attribute__((ext_vector_type(2)));
__device__ __forceinline__ f32x2 gelu_pk(f32x2 v) {
    const f32x2 av = __builtin_elementwise_abs(v), d = av * 0.2316418882f + 1.0f;
    f32x2 t; t.x = __builtin_amdgcn_rcpf(d.x); t.y = __builtin_amdgcn_rcpf(d.y);
    f32x2 q = t * 0.5307027145f + (-0.7265760135f); q = q * t + 0.7107068705f; q = q * t + (-0.142248368f); q = q * t + 0.127414796f; q = q * t;
    const f32x2 s = (v * v) * (-0.72134752044f);
    f32x2 e; e.x = __builtin_amdgcn_exp2f(s.x); e.y = __builtin_amdgcn_exp2f(s.y);
    const f32x2 m = v * (q * e), r = v - m;
    f32x2 o; o.x = v.x < 0.f ? m.x : r.x; o.y = v.y < 0.f ? m.y : r.y; return o;
}


constexpr int NLAT_ROWS = 32768, DMODEL = 1024, NADA_COLS = 9216;
__device__ __forceinline__ float silu_f(float a) { return a * __builtin_amdgcn_rcpf(1.0f + __builtin_amdgcn_exp2f(-1.4426950408889634f * a)); }

struct EpiSwiGLU {
    static constexpr bool PERM = true, AFTER_DRAIN = false;
    bf16_t* G; int ldc;
    __device__ __forceinline__ void operator()(const f32x4 (&acc)[2][2][4][2], const Unit& u, int wr, int wc, int fr, int fq) const {
        const int row0 = u.pm * BM + wr * 64 + fr; const int col0 = u.pn * HALF + wc * 32 + 8 * fq;
#pragma unroll
        for (int ai = 0; ai < 2; ++ai)
#pragma unroll
            for (int m = 0; m < 4; ++m) {
                bf16_t* rowp = G + (size_t)(row0 + ai * HALF + m * 16) * ldc + col0;
                const f32x4 a0 = acc[ai][0][m][0], a1 = acc[ai][0][m][1], b0 = acc[ai][1][m][0], b1 = acc[ai][1][m][1];
                u32x4 w;
                w.x = cvt_pk_bf16(silu_f(a0[0]) * b0[0], silu_f(a0[1]) * b0[1]); w.y = cvt_pk_bf16(silu_f(a0[2]) * b0[2], silu_f(a0[3]) * b0[3]);
                w.z = cvt_pk_bf16(silu_f(a1[0]) * b1[0], silu_f(a1[1]) * b1[1]); w.w = cvt_pk_bf16(silu_f(a1[2]) * b1[2], silu_f(a1[3]) * b1[3]);
                *(u32x4*)rowp = w;
            }
    }
};

struct EpiInProj {
    static constexpr bool PERM = true, AFTER_DRAIN = false;
    bf16_t* Z;
    __device__ __forceinline__ void operator()(const f32x4 (&acc)[2][2][4][2], const Unit& u, int wr, int wc, int fr, int fq) const {
        const int pn = u.pn; const bool do_gelu = (pn == 3 || pn == 4); const bool do_rope = (pn >= 5 && pn <= 8 && u.pm < 128);
        const int row0 = u.pm * BM + wr * 64 + fr; const int colb = pn * 256 + 64 * wc + 8 * fq;
        float fq8[8];
#pragma unroll
        for (int i = 0; i < 8; ++i) fq8[i] = __builtin_amdgcn_exp2f(-(float)(8 * (fq & 1) + i) * 0.8304820237218406f);
#pragma unroll
        for (int ai = 0; ai < 2; ++ai)
#pragma unroll
            for (int m = 0; m < 4; ++m) {
                const int row = row0 + ai * HALF + m * 16;
                f32x4 a0 = acc[ai][0][m][0], a1 = acc[ai][0][m][1], b0 = acc[ai][1][m][0], b1 = acc[ai][1][m][1];
                if (do_gelu) {
                    f32x2 t;
                    t = gelu_pk((f32x2){a0[0], a0[1]}); a0[0] = t.x; a0[1] = t.y; t = gelu_pk((f32x2){a0[2], a0[3]}); a0[2] = t.x; a0[3] = t.y;
                    t = gelu_pk((f32x2){a1[0], a1[1]}); a1[0] = t.x; a1[1] = t.y; t = gelu_pk((f32x2){a1[2], a1[3]}); a1[2] = t.x; a1[3] = t.y;
                    t = gelu_pk((f32x2){b0[0], b0[1]}); b0[0] = t.x; b0[1] = t.y; t = gelu_pk((f32x2){b0[2], b0[3]}); b0[2] = t.x; b0[3] = t.y;
                    t = gelu_pk((f32x2){b1[0], b1[1]}); b1[0] = t.x; b1[1] = t.y; t = gelu_pk((f32x2){b1[2], b1[3]}); b1[2] = t.x; b1[3] = t.y;
                } else if (do_rope) {
                    const int t = row & 8191; const float fpos = (float)((fq < 2) ? (t >> 6) : (t & 63));
#pragma unroll
                    for (int e = 0; e < 4; ++e) {
                        { const float ang = fpos * fq8[e]; const float c = __cosf(ang), s = __sinf(ang); const float x1 = a0[e], x2 = b0[e]; a0[e] = x1 * c - x2 * s; b0[e] = x1 * s + x2 * c; }
                        { const float ang = fpos * fq8[4 + e]; const float c = __cosf(ang), s = __sinf(ang); const float x1 = a1[e], x2 = b1[e]; a1[e] = x1 * c - x2 * s; b1[e] = x1 * s + x2 * c; }
                    }
                }
                bf16_t* rowp = Z + (size_t)row * 2816 + colb;
                u32x4 w; w.x = cvt_pk_bf16(a0[0], a0[1]); w.y = cvt_pk_bf16(a0[2], a0[3]); w.z = cvt_pk_bf16(a1[0], a1[1]); w.w = cvt_pk_bf16(a1[2], a1[3]);
                *(u32x4*)rowp = w;
                u32x4 v; v.x = cvt_pk_bf16(b0[0], b0[1]); v.y = cvt_pk_bf16(b0[2], b0[3]); v.z = cvt_pk_bf16(b1[0], b1[1]); v.w = cvt_pk_bf16(b1[2], b1[3]);
                *(u32x4*)(rowp + 32) = v;
            }
    }
};

struct EpiResid {
    static constexpr bool PERM = true, AFTER_DRAIN = false;
    const float* srcL; const float* srcC; float* dstL; float* dstC; const float* modl; int gidx; float gscale;
    __device__ __forceinline__ void operator()(const f32x4 (&acc)[2][2][4][2], const Unit& u, int wr, int wc, int fr, int fq) const {
        const bool lat = u.pm < 128;
        const float* sb = lat ? srcL + (size_t)u.pm * BM * DMODEL : srcC + (size_t)(u.pm - 128) * BM * DMODEL;
        float* db = lat ? dstL + (size_t)u.pm * BM * DMODEL : dstC + (size_t)(u.pm - 128) * BM * DMODEL;
        const float* gate = modl + (size_t)(lat ? (u.pm >> 5) : 4) * NADA_COLS + gidx * DMODEL;
        const int col0 = u.pn * BM + wc * 32 + 8 * fq;
        f32x4 g4[2][2];
#pragma unroll
        for (int bj = 0; bj < 2; ++bj)
#pragma unroll
            for (int n = 0; n < 2; ++n) g4[bj][n] = *(const f32x4*)(gate + col0 + bj * HALF + n * 4) * gscale;
#pragma unroll
        for (int ai = 0; ai < 2; ++ai)
#pragma unroll
            for (int m = 0; m < 4; ++m) {
                const size_t off = (size_t)(ai * HALF + wr * 64 + m * 16 + fr) * DMODEL + col0;
#pragma unroll
                for (int bj = 0; bj < 2; ++bj)
#pragma unroll
                    for (int n = 0; n < 2; ++n) {
                        const f32x4 bs = *(const f32x4*)(sb + off + bj * HALF + n * 4);
                        *(f32x4*)(db + off + bj * HALF + n * 4) = bs + g4[bj][n] * acc[ai][bj][m][n];
                    }
                if (m & 1) asm volatile("" ::: "memory");
            }
    }
};
template <class Epi, class Sched, bool ALIGN_EPI = false, bool SP2 = false>
__device__ __forceinline__ void gemm_phase(PG8_LAS unsigned char* lds, const Gemm g, const Sched& S, const Epi& E) {
    int tid_ = threadIdx.x; asm volatile("" : "+v"(tid_));
    const int tid = tid_, wid = __builtin_amdgcn_readfirstlane(tid >> 6), lane = tid & 63, wr = wid >> 2, wc = wid & 3, fr = lane & 15, fq = lane >> 4;
    const int K = g.K, nt = K / BK;
    unsigned voffA[2], voffB[2];
#pragma unroll
    for (int i = 0; i < 2; ++i) { int R, C; stage_rc(tid * 16 + i * 8192, R, C); const int Rb = Epi::PERM ? ((R & ~31) + perm32(R & 31)) : R;
        voffA[i] = (unsigned)(R * K + C) * 2u; voffB[i] = (unsigned)(Rb * K + C) * 2u; }
    const size_t kstep = (size_t)(BK * 2);
    const size_t hstep = (size_t)HALF * K * 2;
    const size_t tstep = 2 * hstep;
    const unsigned ldsw = (unsigned)wid * 1024u;
    const int aoff = lds_byte(wr * 64 + fr, fq * 8), boff = lds_byte(wc * 32 + fr, fq * 8);
#define PG8_SA(b, h) (((b) * 2 + (h)) * HTB)
#define PG8_SB(b, h) ((4 + (b) * 2 + (h)) * HTB)
#define PG8_STAGE(bufoff, gbase, voff) do { _Pragma("unroll") for (int _i = 0; _i < 2; ++_i) \
        __builtin_amdgcn_global_load_lds((const unsigned*)((const char*)(gbase) + (voff)[_i]), (PG8_LAS unsigned*)(lds + (bufoff) + ldsw + _i * 8192), 16, 0, 0); } while (0)
#define PG8_LDA(dst, b, h) do { _Pragma("unroll") for (int m = 0; m < 4; ++m) _Pragma("unroll") for (int k = 0; k < 2; ++k) dst[m][k] = *(const PG8_LAS bf16x8*)(lds + PG8_SA(b, h) + aoff + m * 2048 + k * 1024); } while (0)
#define PG8_LDB(dst, b, h) do { _Pragma("unroll") for (int n = 0; n < 2; ++n) _Pragma("unroll") for (int k = 0; k < 2; ++k) dst[n][k] = *(const PG8_LAS bf16x8*)(lds + PG8_SB(b, h) + boff + n * 2048 + k * 1024); } while (0)
#define PG8_MMA(ai, bj, At, Bt) do { __builtin_amdgcn_s_setprio(1); _Pragma("unroll") for (int m = 0; m < 4; ++m) _Pragma("unroll") for (int n = 0; n < 2; ++n) _Pragma("unroll") for (int k = 0; k < 2; ++k) \
        acc[ai][bj][m][n] = __builtin_amdgcn_mfma_f32_16x16x32_bf16(Bt[n][k], At[m][k], acc[ai][bj][m][n], 0, 0, 0); __builtin_amdgcn_s_setprio(0); } while (0)
#define PG8_WAIT_V(n) asm volatile("s_waitcnt vmcnt(" #n ")" ::: "memory")
#define PG8_WAIT_L(n) asm volatile("s_waitcnt lgkmcnt(" #n ")" ::: "memory")
#define PG8_BAR __builtin_amdgcn_s_barrier()
#define PG8_SCHED __builtin_amdgcn_sched_barrier(0)
    Unit cur, nxt; int ui = 0;
    if (!S.next(0, cur)) return;
    f32x4 acc[2][2][4][2];
#pragma unroll
    for (int a = 0; a < 2; ++a)
#pragma unroll
        for (int b = 0; b < 2; ++b)
#pragma unroll
            for (int m = 0; m < 4; ++m)
#pragma unroll
                for (int n = 0; n < 2; ++n) acc[a][b][m][n] = (f32x4){0.f, 0.f, 0.f, 0.f};
    bf16x8 At[4][2], B0[2][2], B1[2][2];
    const char* cA = (const char*)g.A + (size_t)cur.pm * tstep; const char* cB = (const char*)g.Bt + (size_t)cur.pn * tstep;
    S.a_ready(cur);
    if constexpr (SP2) {
        PG8_STAGE(PG8_SB(0, 0), cB, voffB); PG8_STAGE(PG8_SB(0, 1), cB + hstep, voffB); PG8_STAGE(PG8_SA(0, 0), cA, voffA); PG8_STAGE(PG8_SA(0, 1), cA + hstep, voffA);
        if (wr == 1) PG8_BAR;
        PG8_WAIT_V(2); PG8_BAR;
        PG8_STAGE(PG8_SB(1, 0), cB + kstep, voffB); PG8_STAGE(PG8_SA(1, 0), cA + kstep, voffA); PG8_STAGE(PG8_SB(1, 1), cB + hstep + kstep, voffB);
        PG8_WAIT_V(6); PG8_BAR;
    } else {
        PG8_STAGE(PG8_SB(0, 0), cB, voffB); PG8_STAGE(PG8_SA(0, 0), cA, voffA); PG8_STAGE(PG8_SB(0, 1), cB + hstep, voffB); PG8_STAGE(PG8_SA(0, 1), cA + hstep, voffA);
        if (wr == 1) PG8_BAR;
        PG8_WAIT_V(4); PG8_BAR;
        PG8_STAGE(PG8_SB(1, 0), cB + kstep, voffB); PG8_STAGE(PG8_SA(1, 0), cA + kstep, voffA); PG8_STAGE(PG8_SB(1, 1), cB + hstep + kstep, voffB);
        PG8_WAIT_V(6); PG8_BAR;
    }
    for (;;) {
        const bool has_next = S.next(ui + 1, nxt);
        const char* nA = has_next ? (const char*)g.A + (size_t)nxt.pm * tstep : cA; const char* nB = has_next ? (const char*)g.Bt + (size_t)nxt.pn * tstep : cB;
        for (int t = 0; t < nt; t += 2) {
            const bool last = (t == nt - 2);
            const char* a1 = cA + (size_t)(t + 1) * kstep;
            const char* a2 = last ? nA : cA + (size_t)(t + 2) * kstep; const char* b2 = last ? nB : cB + (size_t)(t + 2) * kstep;
            const char* a3 = a2 + kstep; const char* b3 = b2 + kstep;
            if (last && has_next) S.a_ready(nxt);
            if constexpr (SP2) {
            PG8_LDB(B0, 0, 0); PG8_LDB(B1, 0, 1); PG8_SCHED; PG8_LDA(At, 0, 0); PG8_STAGE(PG8_SA(1, 1), a1 + hstep, voffA);
            PG8_WAIT_V(8); PG8_WAIT_L(0); PG8_BAR; PG8_MMA(0, 0, At, B0); PG8_MMA(0, 1, At, B1); PG8_BAR; PG8_SCHED;
            PG8_LDA(At, 0, 1); PG8_STAGE(PG8_SB(0, 0), b2, voffB); PG8_STAGE(PG8_SB(0, 1), b2 + hstep, voffB); PG8_STAGE(PG8_SA(0, 0), a2, voffA);
            PG8_WAIT_V(8); PG8_WAIT_L(0); PG8_BAR; PG8_MMA(1, 0, At, B0); PG8_MMA(1, 1, At, B1); PG8_BAR; PG8_SCHED;
            PG8_LDB(B0, 1, 0); PG8_LDB(B1, 1, 1); PG8_SCHED; PG8_LDA(At, 1, 0); PG8_STAGE(PG8_SA(0, 1), a2 + hstep, voffA);
            PG8_WAIT_V(8); PG8_WAIT_L(0); PG8_BAR; PG8_MMA(0, 0, At, B0); PG8_MMA(0, 1, At, B1); PG8_BAR; PG8_SCHED;
            PG8_LDA(At, 1, 1); PG8_STAGE(PG8_SB(1, 0), b3, voffB); PG8_STAGE(PG8_SB(1, 1), b3 + hstep, voffB); PG8_STAGE(PG8_SA(1, 0), a3, voffA);
            PG8_WAIT_V(8); PG8_WAIT_L(0); PG8_BAR; PG8_MMA(1, 0, At, B0); PG8_MMA(1, 1, At, B1); PG8_BAR; PG8_SCHED;
            } else {
            PG8_LDB(B0, 0, 0); PG8_SCHED; PG8_LDA(At, 0, 0); PG8_STAGE(PG8_SA(1, 1), a1 + hstep, voffA);
            PG8_WAIT_L(8); PG8_BAR; PG8_WAIT_L(0); PG8_MMA(0, 0, At, B0); PG8_BAR; PG8_SCHED;
            PG8_LDB(B1, 0, 1); PG8_STAGE(PG8_SB(0, 0), b2, voffB);
            PG8_BAR; PG8_WAIT_L(0); PG8_MMA(0, 1, At, B1); PG8_BAR;
            PG8_LDA(At, 0, 1); PG8_STAGE(PG8_SA(0, 0), a2, voffA);
            PG8_BAR; PG8_WAIT_L(0); PG8_MMA(1, 0, At, B0); PG8_BAR; PG8_SCHED;
            PG8_STAGE(PG8_SB(0, 1), b2 + hstep, voffB);
            PG8_WAIT_V(6); PG8_BAR; PG8_MMA(1, 1, At, B1); PG8_BAR;
            PG8_LDB(B0, 1, 0); PG8_SCHED; PG8_LDA(At, 1, 0); PG8_STAGE(PG8_SA(0, 1), a2 + hstep, voffA);
            PG8_WAIT_L(8); PG8_BAR; PG8_WAIT_L(0); PG8_MMA(0, 0, At, B0); PG8_BAR; PG8_SCHED;
            PG8_LDB(B1, 1, 1); PG8_STAGE(PG8_SB(1, 0), b3, voffB);
            PG8_BAR; PG8_WAIT_L(0); PG8_MMA(0, 1, At, B1); PG8_BAR;
            PG8_LDA(At, 1, 1); PG8_STAGE(PG8_SA(1, 0), a3, voffA);
            PG8_BAR; PG8_WAIT_L(0); PG8_MMA(1, 0, At, B0); PG8_BAR; PG8_SCHED;
            PG8_STAGE(PG8_SB(1, 1), b3 + hstep, voffB);
            PG8_WAIT_V(6); PG8_BAR; PG8_MMA(1, 1, At, B1); PG8_BAR;
            }
        }
        if constexpr (ALIGN_EPI) { if (wr == 0) PG8_BAR; }
        if constexpr (!Epi::AFTER_DRAIN) { E(acc, cur, wr, wc, fr, fq); S.done(cur); }
        if (!has_next) break;
#pragma unroll
        for (int a = 0; a < 2; ++a)
#pragma unroll
            for (int b = 0; b < 2; ++b)
#pragma unroll
                for (int m = 0; m < 4; ++m)
#pragma unroll
                    for (int n = 0; n < 2; ++n) acc[a][b][m][n] = (f32x4){0.f, 0.f, 0.f, 0.f};
        cur = nxt; cA = nA; cB = nB; ++ui;
        if constexpr (ALIGN_EPI) { if (wr == 1) PG8_BAR; }
    }
    PG8_WAIT_V(0);
    if constexpr (!ALIGN_EPI) { if (wr == 0) PG8_BAR; }
    PG8_BAR;
    if constexpr (Epi::AFTER_DRAIN) { E.fused(acc, cur, wr, wc, fr, fq, lds, wid, lane); S.done(cur); }
#undef PG8_SA
#undef PG8_SB
#undef PG8_STAGE
#undef PG8_LDA
#undef PG8_LDB
#undef PG8_MMA
#undef PG8_WAIT_V
#undef PG8_WAIT_L
#undef PG8_BAR
#undef PG8_SCHED
}
}

#define LAS __attribute__((address_space(3)))
typedef unsigned short bf16_t;
constexpr int DM = 1024, NBATCH = 4, SEQ = 8192, CTXL = 256, NLAT = NBATCH * SEQ, NCTX = NBATCH * CTXL, MT = NLAT + NCTX, DFF = 2816, DIN = 2816, NADA = 9216;
constexpr size_t MiB = 1u << 20;
constexpr size_t WS_MOD = 0, WS_XC = 1 * MiB, WS_W = 8 * MiB, WS_WLAYER = 41 * MiB, WS_H = 90 * MiB, WS_O = 156 * MiB, WS_G = 222 * MiB, WS_END = 404 * MiB;
constexpr size_t WO_UP1 = 0, WO_DN1 = 11534336, WO_IN = WO_DN1 + 5767168, WO_OUT = WO_IN + 5767168, WO_UP2 = WO_OUT + 2097152, WO_DN2 = WO_UP2 + 11534336;
static_assert(WO_DN2 + 5767168 <= WS_WLAYER, "weights per layer");
constexpr int LDS_BYTES = 135168;

#ifndef DBG_INJECT
#define DBG_INJECT 0.0f
#endif
namespace fa {
typedef short bf16x8 __attribute__((ext_vector_type(8)));
typedef short s16x4 __attribute__((ext_vector_type(4)));
typedef float f32x16 __attribute__((ext_vector_type(16)));
typedef float f32x4 __attribute__((ext_vector_type(4)));
typedef unsigned u32x4 __attribute__((ext_vector_type(4)));
typedef unsigned u32x2 __attribute__((ext_vector_type(2)));
typedef float f32x2_t __attribute__((ext_vector_type(2)));
typedef __bf16 bf16x2_t __attribute__((ext_vector_type(2)));
__device__ __forceinline__ unsigned cvtpk(float lo, float hi) { f32x2_t v = {lo, hi}; bf16x2_t b = __builtin_convertvector(v, bf16x2_t); return __builtin_bit_cast(unsigned, b); }
__device__ __forceinline__ float bf2f(unsigned short b) { return __uint_as_float(((unsigned)b) << 16); }
__device__ __forceinline__ float max3f(float a, float b, float c) { float r; asm("v_max3_f32 %0, %1, %2, %3" : "=v"(r) : "v"(a), "v"(b), "v"(c)); return r; }
__device__ __forceinline__ float xmax32(float v) { auto rr = __builtin_amdgcn_permlane32_swap(__float_as_uint(v), __float_as_uint(v), false, false); return fmaxf(__uint_as_float(rr[0]), __uint_as_float(rr[1])); }
__device__ __forceinline__ float xsum32(float v) { auto rr = __builtin_amdgcn_permlane32_swap(__float_as_uint(v), __float_as_uint(v), false, false); return __uint_as_float(rr[0]) + __uint_as_float(rr[1]); }
__device__ __forceinline__ s16x4 vtr(const LAS unsigned char* p) { return __builtin_bit_cast(s16x4, __builtin_amdgcn_ds_read_tr16_b64_v4i16((LAS s16x4*)p)); }
__device__ __forceinline__ float lane_xor(float v, int lane, int o) { return __builtin_bit_cast(float, __builtin_amdgcn_ds_bpermute((lane ^ o) << 2, __builtin_bit_cast(int, v))); }
__device__ __forceinline__ float wave_sum(float v, int lane) {
#pragma unroll
    for (int o = 1; o < 64; o <<= 1) v += lane_xor(v, lane, o);
    return v;
}

template <int KW, int VW> struct Geo {
    static constexpr int KSTR = KW * 2 + 16, VSTR = VW * 2 + 64;
    static constexpr int KBYTES = 64 * KSTR, VBYTES = 64 * VSTR, BUF = KBYTES + VBYTES;
    static constexpr int KCH = KW / 8, VCH = VW / 8;
    static constexpr int NCH = (64 * (KCH + VCH)) / 512;
};
template <int KW, int VW, int NCHP = Geo<KW, VW>::NCH>
__device__ __forceinline__ void st_load(u32x4 (&st)[NCHP], const bf16_t* Z, long rowbase, int kcol0, int vcol0, int tid) {
    using G = Geo<KW, VW>;
#pragma unroll
    for (int i = 0; i < G::NCH; ++i) {
        const int c = tid + i * 512;
        if (i * 512 < 64 * G::KCH) { const int key = c / G::KCH, ch = c % G::KCH; st[i] = *(const u32x4*)(Z + (size_t)(rowbase + key) * DIN + kcol0 + ch * 8); }
        else { const int c2 = c - 64 * G::KCH; const int key = c2 / G::VCH, ch = c2 % G::VCH; st[i] = *(const u32x4*)(Z + (size_t)(rowbase + key) * DIN + vcol0 + ch * 8); }
    }
}
template <int KW, int VW, int NCHP = Geo<KW, VW>::NCH>
__device__ __forceinline__ void st_store(LAS unsigned char* buf, const u32x4 (&st)[NCHP], int tid) {
    using G = Geo<KW, VW>;
#pragma unroll
    for (int i = 0; i < G::NCH; ++i) {
        const int c = tid + i * 512;
        if (i * 512 < 64 * G::KCH) { const int key = c / G::KCH, ch = c % G::KCH; *(LAS u32x4*)(buf + key * G::KSTR + ch * 16) = st[i]; }
        else { const int c2 = c - 64 * G::KCH; const int key = c2 / G::VCH, ch = c2 % G::VCH; *(LAS u32x4*)(buf + G::KBYTES + key * G::VSTR + ch * 16) = st[i]; }
    }
}
__device__ __forceinline__ f32x16 qk32(const LAS unsigned char* kp, const bf16x8 (&qf)[4]) {
    f32x16 s = {0.f, 0.f, 0.f, 0.f, 0.f, 0.f, 0.f, 0.f, 0.f, 0.f, 0.f, 0.f, 0.f, 0.f, 0.f, 0.f};
#pragma unroll
    for (int ks = 0; ks < 4; ++ks) { const bf16x8 kf = *(const LAS bf16x8*)(kp + ks * 32); s = __builtin_amdgcn_mfma_f32_32x32x16_bf16(kf, qf[ks], s, 0, 0, 0); }
    return s;
}
template <int NDB, int VSTR>
__device__ __forceinline__ void pv32(f32x16 (&o)[NDB], const LAS unsigned char* vp, const f32x16& p) {
#pragma unroll
    for (int s = 0; s < 2; ++s) {
        u32x4 w; w.x = cvtpk(p[8 * s + 0], p[8 * s + 1]); w.y = cvtpk(p[8 * s + 2], p[8 * s + 3]); w.z = cvtpk(p[8 * s + 4], p[8 * s + 5]); w.w = cvtpk(p[8 * s + 6], p[8 * s + 7]);
        const bf16x8 pf = __builtin_bit_cast(bf16x8, w);
#pragma unroll
        for (int db = 0; db < NDB; ++db) {
            const s16x4 lo = vtr(vp + (16 * s) * VSTR + 64 * db), hi = vtr(vp + (16 * s + 8) * VSTR + 64 * db);
            const bf16x8 vf = {lo[0], lo[1], lo[2], lo[3], hi[0], hi[1], hi[2], hi[3]};
            o[db] = __builtin_amdgcn_mfma_f32_32x32x16_bf16(vf, pf, o[db], 0, 0, 0);
        }
    }
}
template <int NDB>
__device__ __forceinline__ void sm_update(f32x16& s0, f32x16& s1, float& m, float& l, f32x16 (&o)[NDB]) {
    float pm = fmaxf(s0[0], s1[0]);
#pragma unroll
    for (int r = 1; r < 16; ++r) pm = fmaxf(pm, fmaxf(s0[r], s1[r]));
    pm = xmax32(pm);
    if (!__all(pm - m <= 8.0f)) {
        const float mn = fmaxf(m, pm); const float alpha = __builtin_amdgcn_exp2f(m - mn); m = mn; l *= alpha;
#pragma unroll
        for (int db = 0; db < NDB; ++db)
#pragma unroll
            for (int r = 0; r < 16; ++r) o[db][r] *= alpha;
    }
    float ps = 0.f;
#pragma unroll
    for (int r = 0; r < 16; ++r) { s0[r] = __builtin_amdgcn_exp2f(s0[r] - m); s1[r] = __builtin_amdgcn_exp2f(s1[r] - m); ps += s0[r] + s1[r]; }
    l += ps;
}
constexpr float QK_C = 0.125f * 1.4426950408889634f;

template <int NDB>
__device__ __forceinline__ void sm_update_raw(f32x16& s0, f32x16& s1, float& m, float& l, f32x16 (&o)[NDB]) {
    float pm = max3f(s0[0], s1[0], s0[1]);
    pm = max3f(pm, s1[1], s1[1]);
#pragma unroll
    for (int r = 2; r < 16; ++r) pm = max3f(pm, s0[r], s1[r]);
    pm = xmax32(pm) * QK_C;
    if (!__all(pm - m <= 8.0f)) {
        const float mn = fmaxf(m, pm); const float alpha = __builtin_amdgcn_exp2f(m - mn); m = mn; l *= alpha;
#pragma unroll
        for (int db = 0; db < NDB; ++db)
#pragma unroll
            for (int r = 0; r < 16; ++r) o[db][r] *= alpha;
    }
    const float nm = -m; float ps = 0.f;
#pragma unroll
    for (int r = 0; r < 16; ++r) { s0[r] = __builtin_amdgcn_exp2f(fmaf(s0[r], QK_C, nm)); s1[r] = __builtin_amdgcn_exp2f(fmaf(s1[r], QK_C, nm)); ps += s0[r] + s1[r]; }
    l += ps;
}

__device__ __forceinline__ void glds16(const void* gsrc, unsigned lds_dst) { unsigned keep;
    asm volatile("s_mov_b32 %0, m0\n\ts_mov_b32 m0, %2\n\ts_nop 0\n\tglobal_load_lds_dwordx4 %1, off\n\ts_mov_b32 m0, %0" : "=&s"(keep) : "v"(gsrc), "s"(lds_dst) : "memory"); }
#define FA_WAIT_BAR(N) asm volatile("s_waitcnt vmcnt(" #N ") lgkmcnt(0)\n\ts_barrier" ::: "memory")
__device__ __forceinline__ f32x16 qk32s(const LAS unsigned char* kslot, const int (&ko)[4], const bf16x8 (&qf)[4]) {
    f32x16 s = {0.f, 0.f, 0.f, 0.f, 0.f, 0.f, 0.f, 0.f, 0.f, 0.f, 0.f, 0.f, 0.f, 0.f, 0.f, 0.f};
#pragma unroll
    for (int ks = 0; ks < 4; ++ks) { const bf16x8 kf = *(const LAS bf16x8*)(kslot + ko[ks]); s = __builtin_amdgcn_mfma_f32_32x32x16_bf16(kf, qf[ks], s, 0, 0, 0); }
    return s;
}
__device__ __forceinline__ void pv32d(f32x16 (&o)[4], const LAS unsigned char* vp, const f32x16& p) {
#pragma unroll
    for (int s = 0; s < 2; ++s) {
        u32x4 w; w.x = cvtpk(p[8 * s + 0], p[8 * s + 1]); w.y = cvtpk(p[8 * s + 2], p[8 * s + 3]); w.z = cvtpk(p[8 * s + 4], p[8 * s + 5]); w.w = cvtpk(p[8 * s + 6], p[8 * s + 7]);
        const bf16x8 pf = __builtin_bit_cast(bf16x8, w);
#pragma unroll
        for (int db = 0; db < 4; ++db) {
            const s16x4 lo = vtr(vp + (16 * s) * 64 + 4096 * db), hi = vtr(vp + (16 * s + 8) * 64 + 4096 * db);
            const bf16x8 vf = {lo[0], lo[1], lo[2], lo[3], hi[0], hi[1], hi[2], hi[3]};
            o[db] = __builtin_amdgcn_mfma_f32_32x32x16_bf16(vf, pf, o[db], 0, 0, 0);
        }
    }
}
__device__ __forceinline__ void diff_unit(LAS unsigned char* lds, const bf16_t* Z, bf16_t* O, int b, int hd, int q0row, int nlat_tiles, float lam, float oscale, const float* subln, int tid) {
    constexpr int KSLOT = 16384, VRING = 4 * KSLOT;
    const int lane = tid & 63, w = __builtin_amdgcn_readfirstlane(tid >> 6), r32 = lane & 31, h = lane >> 5;
    const int comp = w & 1, qblk = w >> 1;
    const int kcol0 = 1792 + hd * 128, vcol0 = 2304 + hd * 128;
    const unsigned lds0 = (unsigned)(size_t)lds;
    long kg[2], vg[2];
#pragma unroll
    for (int i = 0; i < 2; ++i) {
        const int krow = 8 * w + 4 * i + (lane >> 4);
        kg[i] = ((long)krow * DIN + kcol0 + (((lane & 15) ^ (krow & 7)) * 8)) * 2;
        const int vkey = 32 * (w & 1) + 16 * i + (lane >> 2);
        vg[i] = ((long)vkey * DIN + vcol0 + 32 * (w >> 1) + 8 * (lane & 3)) * 2;
    }
    const unsigned kdst = lds0 + (unsigned)(2 * w) * 1024u, vdst = lds0 + VRING + (unsigned)(2 * w) * 1024u;
#define DIFF_TROW(t) ((t) < nlat_tiles ? (long)b * SEQ + 64 * (t) : (long)NLAT + b * CTXL + 64 * ((t) - nlat_tiles))
#define DIFF_DMA(t) do { const char* tb_ = (const char*)Z + DIFF_TROW(t) * (long)(DIN * 2); const unsigned sl_ = (unsigned)(((t) & 3) * KSLOT); \
        glds16(tb_ + kg[0], (unsigned)__builtin_amdgcn_readfirstlane(kdst + sl_)); glds16(tb_ + kg[1], (unsigned)__builtin_amdgcn_readfirstlane(kdst + sl_ + 1024u)); \
        glds16(tb_ + vg[0], (unsigned)__builtin_amdgcn_readfirstlane(vdst + sl_)); glds16(tb_ + vg[1], (unsigned)__builtin_amdgcn_readfirstlane(vdst + sl_ + 1024u)); } while (0)
    const int NT = nlat_tiles + 4;
    DIFF_DMA(0); DIFF_DMA(1); DIFF_DMA(2);
    bf16x8 qf[4];
    { const bf16_t* qp = Z + (size_t)(q0row + 32 * qblk + r32) * DIN + 1280 + hd * 128 + comp * 64 + 8 * h;
#pragma unroll
      for (int ks = 0; ks < 4; ++ks) qf[ks] = *(const bf16x8*)(qp + 16 * ks); }
    f32x16 o[4];
#pragma unroll
    for (int db = 0; db < 4; ++db)
#pragma unroll
        for (int r = 0; r < 16; ++r) o[db][r] = 0.f;
    float m = -1e30f, l = 0.f;
    int ko[4];
#pragma unroll
    for (int ks = 0; ks < 4; ++ks) ko[ks] = r32 * 256 + (((comp * 8 + 2 * ks + h) ^ (r32 & 7)) << 4);
    const int voff = VRING + (4 * h + ((lane & 15) >> 2)) * 64 + (16 * ((lane >> 4) & 1) + 4 * (lane & 3)) * 2;
    asm volatile("s_waitcnt vmcnt(0)" ::: "memory");
    FA_WAIT_BAR(0);
    for (int t = 0; t < NT; ++t) {
        if (t + 3 < NT) DIFF_DMA(t + 3);
        const LAS unsigned char* kslot = lds + (t & 3) * KSLOT;
        bf16x8 kf[8];
#pragma unroll
        for (int i = 0; i < 8; ++i) kf[i] = *(const LAS bf16x8*)(kslot + ko[i & 3] + (i >> 2) * 8192);
        __builtin_amdgcn_sched_barrier(0);
        f32x16 s0 = {0.f, 0.f, 0.f, 0.f, 0.f, 0.f, 0.f, 0.f, 0.f, 0.f, 0.f, 0.f, 0.f, 0.f, 0.f, 0.f}, s1 = s0;
#pragma unroll
        for (int ks = 0; ks < 4; ++ks) { s0 = __builtin_amdgcn_mfma_f32_32x32x16_bf16(kf[ks], qf[ks], s0, 0, 0, 0); s1 = __builtin_amdgcn_mfma_f32_32x32x16_bf16(kf[4 + ks], qf[ks], s1, 0, 0, 0); }
        __builtin_amdgcn_sched_barrier(0);
        sm_update_raw<4>(s0, s1, m, l, o);
        bf16x8 pf[4];
#pragma unroll
        for (int g = 0; g < 4; ++g) { const f32x16& p = (g < 2) ? s0 : s1; const int e = 8 * (g & 1);
            u32x4 wv; wv.x = cvtpk(p[e + 0], p[e + 1]); wv.y = cvtpk(p[e + 2], p[e + 3]); wv.z = cvtpk(p[e + 4], p[e + 5]); wv.w = cvtpk(p[e + 6], p[e + 7]); pf[g] = __builtin_bit_cast(bf16x8, wv); }
        __builtin_amdgcn_sched_barrier(0);
        const LAS unsigned char* vs = lds + voff + (t & 3) * KSLOT;
        s16x4 va[8], vb[8];
#define DIFF_VLD(dst, g) do { _Pragma("unroll") for (int db = 0; db < 4; ++db) { dst[2 * db] = vtr(vs + (16 * (g)) * 64 + 4096 * db); dst[2 * db + 1] = vtr(vs + (16 * (g) + 8) * 64 + 4096 * db); } } while (0)
#define DIFF_PV(src, g) do { _Pragma("unroll") for (int db = 0; db < 4; ++db) { const bf16x8 vf = {src[2 * db][0], src[2 * db][1], src[2 * db][2], src[2 * db][3], src[2 * db + 1][0], src[2 * db + 1][1], src[2 * db + 1][2], src[2 * db + 1][3]}; \
            o[db] = __builtin_amdgcn_mfma_f32_32x32x16_bf16(vf, pf[g], o[db], 0, 0, 0); } } while (0)
        DIFF_VLD(va, 0);
        DIFF_VLD(vb, 1); __builtin_amdgcn_sched_barrier(0);
        DIFF_PV(va, 0);  __builtin_amdgcn_sched_barrier(0);
        DIFF_VLD(va, 2); __builtin_amdgcn_sched_barrier(0);
        DIFF_PV(vb, 1);  __builtin_amdgcn_sched_barrier(0);
        DIFF_VLD(vb, 3); __builtin_amdgcn_sched_barrier(0);
        DIFF_PV(va, 2);  __builtin_amdgcn_sched_barrier(0);
        DIFF_PV(vb, 3);  __builtin_amdgcn_sched_barrier(0);
#undef DIFF_VLD
#undef DIFF_PV
        if (t + 3 < NT) FA_WAIT_BAR(8); else if (t + 2 < NT) FA_WAIT_BAR(4); else FA_WAIT_BAR(0);
    }
#undef DIFF_TROW
#undef DIFF_DMA
    int tid_e = tid; asm volatile("" : "+v"(tid_e));
    const int lane_e = tid_e & 63, r32e = lane_e & 31, he = lane_e >> 5;
    l = xsum32(l); const float inv = 1.0f / l;
    LAS float* ex = (LAS float*)lds + qblk * 4096;
    if (comp == 1) {
#pragma unroll
        for (int db = 0; db < 4; ++db)
#pragma unroll
            for (int r = 0; r < 16; ++r) ex[(db * 16 + r) * 64 + lane_e] = o[db][r] * inv;
    }
    __syncthreads();
    if (comp == 0) {
        float ss = 0.f;
#pragma unroll
        for (int db = 0; db < 4; ++db)
#pragma unroll
            for (int r = 0; r < 16; ++r) { const float v = o[db][r] * inv - lam * ex[(db * 16 + r) * 64 + lane_e]; o[db][r] = v; ss += v * v; }
        ss = xsum32(ss);
        const float rstd = rsqrtf(ss * (1.0f / 128.0f) + 1e-6f) * oscale;
        bf16_t* op = O + (size_t)(q0row + 32 * qblk + r32e) * DM + 512 + hd * 128 + 4 * he;
#pragma unroll
        for (int db = 0; db < 4; ++db)
#pragma unroll
            for (int i = 0; i < 4; ++i) {
                const f32x4 g = *(const f32x4*)(subln + 32 * db + 8 * i + 4 * he);
                u32x2 wv; wv.x = cvtpk(o[db][4 * i + 0] * rstd * g[0], o[db][4 * i + 1] * rstd * g[1]); wv.y = cvtpk(o[db][4 * i + 2] * rstd * g[2], o[db][4 * i + 3] * rstd * g[3]);
                *(u32x2*)(op + 32 * db + 8 * i) = wv;
            }
    }
    __syncthreads();
}

constexpr int NA_RPB_OFF = 49152;
__device__ __forceinline__ void na_unit(LAS unsigned char* lds, const bf16_t* Z, bf16_t* O, const float* rpb_h, int b, int hd, int r0, int ctxq, int tid) {
    using G = Geo<64, 64>;
    const int lane = tid & 63, w = __builtin_amdgcn_readfirstlane(tid >> 6), r32 = lane & 31, h = lane >> 5;
    const int gr = r0 + (w >> 1), hh = w & 1;
    const int kcol0 = 256 + hd * 64, vcol0 = 512 + hd * 64;
    const long qrow = ctxq ? (long)NLAT + b * CTXL + 32 * w + r32 : (long)b * SEQ + gr * 64 + 32 * hh + r32;
    LAS float* rpbL = (LAS float*)(lds + NA_RPB_OFF);
    if (tid < 465) rpbL[tid] = rpb_h[tid] * 1.4426950408889634f;
    bf16x8 qf[4];
    { const bf16_t* qp = Z + (size_t)qrow * DIN + hd * 64 + 8 * h;
#pragma unroll
      for (int ks = 0; ks < 4; ++ks) qf[ks] = *(const bf16x8*)(qp + 16 * ks); }
    f32x16 o[2];
#pragma unroll
    for (int db = 0; db < 2; ++db)
#pragma unroll
        for (int r = 0; r < 16; ++r) o[db][r] = 0.f;
    float m = -1e30f, l = 0.f;
    int kr_lo = r0 - 4; kr_lo = kr_lo < 0 ? 0 : (kr_lo > 120 ? 120 : kr_lo);
    int kr_hi = r0 + 3 - 4; kr_hi = (kr_hi < 0 ? 0 : (kr_hi > 120 ? 120 : kr_hi)) + 7;
    const int NT = ctxq ? 4 : 4 + (kr_hi - kr_lo + 1);
    int ks0 = gr - 4; ks0 = ks0 < 0 ? 0 : (ks0 > 120 ? 120 : ks0);
    const int qcol = 32 * hh + r32; int w0 = qcol - 8; w0 = w0 < 0 ? 0 : (w0 > 48 ? 48 : w0);
    const int koff = r32 * G::KSTR + 16 * h;
    const int voff = G::KBYTES + (4 * h + ((lane & 15) >> 2)) * G::VSTR + (16 * ((lane >> 4) & 1) + 4 * (lane & 3)) * 2;
    u32x4 st[G::NCH];
#define NA_TROW(t) ((t) < 4 ? (long)NLAT + b * CTXL + 64 * (t) : (long)b * SEQ + (kr_lo + (t) - 4) * 64)
    u32x4 stB[G::NCH];
    st_load<64, 64>(st, Z, NA_TROW(0), kcol0, vcol0, tid);
    st_store<64, 64>(lds, st, tid);
    st_load<64, 64>(st, Z, NA_TROW(1), kcol0, vcol0, tid);
    __syncthreads();
    for (int t0 = 0; t0 < NT; t0 += 2) {
#pragma unroll
    for (int u = 0; u < 2; ++u) {
        const int t = t0 + u;
        if (t < NT) {
        LAS unsigned char* cur = lds + (t & 1) * G::BUF; LAS unsigned char* nxt = lds + ((t + 1) & 1) * G::BUF;
        if (t + 2 < NT) { if (u == 0) st_load<64, 64>(stB, Z, NA_TROW(t + 2), kcol0, vcol0, tid); else st_load<64, 64>(st, Z, NA_TROW(t + 2), kcol0, vcol0, tid); }
        const int kr = kr_lo + t - 4;
        const bool active = (t < 4) || (kr >= ks0 && kr < ks0 + 8);
        if (active) {
            f32x16 s0 = qk32(cur + koff, qf), s1 = qk32(cur + koff + 32 * G::KSTR, qf);
            if (t < 4) {
#pragma unroll
                for (int r = 0; r < 16; ++r) { s0[r] *= QK_C; s1[r] *= QK_C; }
            } else {
                const LAS float* brow = rpbL + (kr - gr + 7) * 31;
                int hq = 4 * h - qcol + 15, hw = 4 * h - w0;
                asm volatile("" : "+v"(hq), "+v"(hw));
#pragma unroll
                for (int r = 0; r < 16; ++r) {
                    const int cr = (r & 3) + 8 * (r >> 2);
                    { const int d = cr + hq; const int dc = d < 0 ? 0 : (d > 30 ? 30 : d); const bool ok = (unsigned)(cr + hw) < 16u; const float bias = brow[dc]; s0[r] = ok ? fmaf(s0[r], QK_C, bias) : -1e30f; }
                    { const int d = cr + 32 + hq; const int dc = d < 0 ? 0 : (d > 30 ? 30 : d); const bool ok = (unsigned)(cr + 32 + hw) < 16u; const float bias = brow[dc]; s1[r] = ok ? fmaf(s1[r], QK_C, bias) : -1e30f; }
                }
            }
            sm_update<2>(s0, s1, m, l, o);
            pv32<2, G::VSTR>(o, cur + voff, s0);
            pv32<2, G::VSTR>(o, cur + voff + 32 * G::VSTR, s1);
        }
        if (t + 1 < NT) { if (u == 0) st_store<64, 64>(nxt, st, tid); else st_store<64, 64>(nxt, stB, tid); }
        __syncthreads();
        }
    }
    }
#undef NA_TROW
    l = xsum32(l); const float inv = 1.0f / l;
    bf16_t* op = O + (size_t)qrow * DM + hd * 64 + 4 * h;
#pragma unroll
    for (int db = 0; db < 2; ++db)
#pragma unroll
        for (int i = 0; i < 4; ++i) {
            u32x2 wv; wv.x = cvtpk(o[db][4 * i + 0] * inv, o[db][4 * i + 1] * inv); wv.y = cvtpk(o[db][4 * i + 2] * inv, o[db][4 * i + 3] * inv);
            *(u32x2*)(op + 32 * db + 8 * i) = wv;
        }
    __syncthreads();
}

__device__ __forceinline__ void gmlp_unit(LAS unsigned char* lds, const bf16_t* Z, bf16_t* O, const float* ws_g  , const float* bs_g  , const float* gn_g  , long row0, int g, int tid) {
    constexpr int STR = 272;
    LAS unsigned char* WsL = lds; LAS unsigned char* vnT = lds + 128 * STR;
    const int lane = tid & 63, w = __builtin_amdgcn_readfirstlane(tid >> 6), r32 = lane & 31, h = lane >> 5;
#pragma unroll
    for (int i = 0; i < 8; ++i) {
        const int c = tid + i * 512; const int p = c >> 5, q4 = c & 31;
        const f32x4 v = *(const f32x4*)(ws_g + p * 128 + q4 * 4);
        u32x2 wv; wv.x = cvtpk(v[0], v[1]); wv.y = cvtpk(v[2], v[3]);
        *(LAS u32x2*)(WsL + p * STR + q4 * 8) = wv;
    }
    {
        const int q = tid >> 2, part = tid & 3;
        const bf16_t* vp = Z + (size_t)(row0 + q) * DIN + 1024 + 64 * g + 16 * part;
        const u32x4 x0 = *(const u32x4*)vp, x1 = *(const u32x4*)(vp + 8);
        float f[16];
#pragma unroll
        for (int e = 0; e < 4; ++e) { f[2 * e] = __uint_as_float(x0[e] << 16); f[2 * e + 1] = __uint_as_float(x0[e] & 0xffff0000u); f[8 + 2 * e] = __uint_as_float(x1[e] << 16); f[8 + 2 * e + 1] = __uint_as_float(x1[e] & 0xffff0000u); }
        float ss = 0.f;
#pragma unroll
        for (int e = 0; e < 16; ++e) ss += f[e] * f[e];
        ss += lane_xor(ss, lane, 1); ss += lane_xor(ss, lane, 2);
        const float rstd = rsqrtf(ss * (1.0f / 64.0f) + 1e-6f);
#pragma unroll
        for (int e = 0; e < 16; ++e) {
            const int wc = 16 * part + e; const float y = f[e] * rstd * gn_g[wc];
            *(LAS unsigned short*)(vnT + wc * STR + q * 2) = (unsigned short)(cvtpk(y, 0.f) & 0xffffu);
        }
    }
    __syncthreads();
    const int pb = w >> 1, wb = w & 1;
    f32x16 acc = {0.f, 0.f, 0.f, 0.f, 0.f, 0.f, 0.f, 0.f, 0.f, 0.f, 0.f, 0.f, 0.f, 0.f, 0.f, 0.f};
#pragma unroll
    for (int ks = 0; ks < 8; ++ks) {
        const bf16x8 a = *(const LAS bf16x8*)(WsL + (32 * pb + r32) * STR + (16 * ks + 8 * h) * 2);
        const bf16x8 bq = *(const LAS bf16x8*)(vnT + (32 * wb + r32) * STR + (16 * ks + 8 * h) * 2);
        acc = __builtin_amdgcn_mfma_f32_32x32x16_bf16(a, bq, acc, 0, 0, 0);
    }
    const int wcol = 32 * wb + r32;
#pragma unroll
    for (int r = 0; r < 16; ++r) {
        const int p = 32 * pb + (r & 3) + 8 * (r >> 2) + 4 * h;
        const float s = acc[r] + bs_g[p];
        const float uval = bf2f(Z[(size_t)(row0 + p) * DIN + 768 + 64 * g + wcol]);
        O[(size_t)(row0 + p) * DM + 256 + 64 * g + wcol] = (unsigned short)(cvtpk(uval * s, 0.f) & 0xffffu);
    }
    __syncthreads();
}
}

typedef float f32x4 __attribute__((ext_vector_type(4)));
typedef unsigned v4u __attribute__((ext_vector_type(4)));
typedef unsigned v2u __attribute__((ext_vector_type(2)));
#ifndef DBG_SKIP
#define DBG_SKIP 0
#endif
#ifndef REP_MASK
#define REP_MASK 7
#endif
#ifndef REP_MIX
#define REP_MIX 1
#endif
#ifndef DBG_SKIP_LAYERS
#define DBG_SKIP_LAYERS 3
#endif
#ifndef DBG_FILL
#define DBG_FILL 1
#endif
#ifndef DBG_CHECK
#define DBG_CHECK 0
#endif
#ifndef DBG_STOP
#define DBG_STOP 17
#endif
#ifndef DBG_IDENT
#define DBG_IDENT 0
#endif
#ifndef MIX_MASK
#define MIX_MASK 0xff
#endif
#ifndef PH_MASK
#define PH_MASK 0xff
#endif
constexpr int NSTEPS = 22;

struct Args { const float* in[24]; float* out; unsigned char* ws; int ph_lo, ph_hi; };
enum { I_X = 0, I_C, I_CTX, I_CCTX, I_WADA, I_BADA, I_F1W1, I_F1W3, I_F1W2, I_WIN, I_WOUT, I_RPB, I_GMWS, I_GMBS, I_GMNORM, I_LQ1, I_LK1, I_LQ2, I_LK2, I_SUBLN, I_F2W1, I_F2W3, I_F2W2, I_FNORM };

__device__ __forceinline__ void transpose_item(const float* W, int K, int N, bf16_t* WT, int dst_row0, int k0, int n0, LAS float* scr, int lane) {
#pragma unroll 8
    for (int i = 0; i < 32; ++i) { const int kk = 2 * i + (lane >> 5); scr[kk * 33 + (lane & 31)] = W[(size_t)(k0 + kk) * N + n0 + (lane & 31)]; }
    asm volatile("s_waitcnt lgkmcnt(0)" ::: "memory");
    const int c = lane & 7;
#pragma unroll
    for (int j = 0; j < 4; ++j) { const int n = (lane >> 3) + 8 * j; const LAS float* s = scr + (8 * c) * 33 + n;
        v4u o; o.x = fa::cvtpk(s[0 * 33], s[1 * 33]); o.y = fa::cvtpk(s[2 * 33], s[3 * 33]); o.z = fa::cvtpk(s[4 * 33], s[5 * 33]); o.w = fa::cvtpk(s[6 * 33], s[7 * 33]);
        *(v4u*)(WT + (size_t)(dst_row0 + n) * K + k0 + 8 * c) = o; }
    asm volatile("s_waitcnt lgkmcnt(0)" ::: "memory");
}

__device__ __forceinline__ void prologue(const Args& a, LAS unsigned char* lds, int tid, int G) {
    const int lane = tid & 63, wave = __builtin_amdgcn_readfirstlane(tid >> 6);
    float* mod = (float*)(a.ws + WS_MOD);
    if ((int)blockIdx.x < 288) {
        LAS float* sv = (LAS float*)lds; LAS float* red = sv + 5120;
        for (int i = tid; i < 5120; i += 512) { const int ci = i >> 10, k = i & 1023; const float c = ci < 4 ? a.in[I_C][ci * 1024 + k] : a.in[I_CCTX][k]; sv[i] = c / (1.0f + __expf(-c)); }
        __syncthreads();
        for (int it = blockIdx.x; it < 288; it += G) {
            const int l = it / 144, j0 = (it % 144) * 64;
            const float* W = a.in[I_WADA] + (size_t)l * 1024 * NADA + j0 + lane;
            float a0 = 0.f, a1 = 0.f, a2 = 0.f, a3 = 0.f, a4 = 0.f;
#pragma unroll 16
            for (int kk = 0; kk < 128; ++kk) { const int k = wave * 128 + kk; const float wv = W[(size_t)k * NADA];
                a0 += sv[k] * wv; a1 += sv[1024 + k] * wv; a2 += sv[2048 + k] * wv; a3 += sv[3072 + k] * wv; a4 += sv[4096 + k] * wv; }
            red[(wave * 5 + 0) * 64 + lane] = a0; red[(wave * 5 + 1) * 64 + lane] = a1; red[(wave * 5 + 2) * 64 + lane] = a2; red[(wave * 5 + 3) * 64 + lane] = a3; red[(wave * 5 + 4) * 64 + lane] = a4;
            __syncthreads();
            if (tid < 320) { const int i = tid >> 6, ln = tid & 63; float s = 0.f;
#pragma unroll
                for (int ww = 0; ww < 8; ++ww) s += red[(ww * 5 + i) * 64 + ln];
                mod[(size_t)(l * 5 + i) * NADA + j0 + ln] = s + a.in[I_BADA][l * NADA + j0 + ln]; }
            __syncthreads();
        }
    }
    __syncthreads();
    LAS float* scr = (LAS float*)(lds + wave * 16384);
    const int gw = blockIdx.x * 8 + wave, NGW = G * 8;
    constexpr int I_UP = 16 * 88, I_DN = 44 * 32, I_INP = 16 * 88, I_OUTP = 16 * 32;
    constexpr int PER_LAYER = 2 * I_UP + I_DN + I_INP + I_OUTP + 2 * I_UP + I_DN;
    for (int it = gw; it < 2 * PER_LAYER; it += NGW) {
        const int l = it / PER_LAYER; int r = it % PER_LAYER;
        unsigned char* wl = a.ws + WS_W + (size_t)l * WS_WLAYER;
        int which = 0;
        if (r < 2 * I_UP) which = 0; else { r -= 2 * I_UP; if (r < I_DN) which = 1; else { r -= I_DN; if (r < I_INP) which = 2; else { r -= I_INP; if (r < I_OUTP) which = 3; else { r -= I_OUTP; if (r < 2 * I_UP) which = 4; else { r -= 2 * I_UP; which = 5; } } } } }
        if (which == 0 || which == 4) {
            const int bj = r / I_UP; const int rr = r % I_UP; const int kb = rr / 88, nb = rr % 88; const int n0 = 32 * nb;
            const float* W = (which == 0 ? (bj ? a.in[I_F1W3] : a.in[I_F1W1]) : (bj ? a.in[I_F2W3] : a.in[I_F2W1])) + (size_t)l * 1024 * DFF;
            bf16_t* WT = (bf16_t*)(wl + (which == 0 ? WO_UP1 : WO_UP2));
            transpose_item(W, 1024, DFF, WT, 256 * (n0 / 128) + 128 * bj + (n0 % 128), 64 * kb, n0, scr, lane);
        } else if (which == 1 || which == 5) {
            const int kb = r / 32, nb = r % 32;
            const float* W = (which == 1 ? a.in[I_F1W2] : a.in[I_F2W2]) + (size_t)l * DFF * 1024;
            bf16_t* WT = (bf16_t*)(wl + (which == 1 ? WO_DN1 : WO_DN2));
            transpose_item(W, DFF, 1024, WT, 32 * nb, 64 * kb, 32 * nb, scr, lane);
        } else if (which == 2) {
            const int kb = r / 88, nb = r % 88; const int n0 = 32 * nb; const int pn = n0 / 256, rem = n0 % 256; const int comp = rem / 64, bj = (rem % 64) / 32;
            const float* W = a.in[I_WIN] + (size_t)l * 1024 * DIN;
            transpose_item(W, 1024, DIN, (bf16_t*)(wl + WO_IN), 256 * pn + 128 * bj + 32 * comp, 64 * kb, n0, scr, lane);
        } else {
            const int kb = r / 32, nb = r % 32;
            const float* W = a.in[I_WOUT] + (size_t)l * 1024 * 1024;
            transpose_item(W, 1024, 1024, (bf16_t*)(wl + WO_OUT), 32 * nb, 64 * kb, 32 * nb, scr, lane);
        }
    }
}

__device__ __forceinline__ void modulate_phase(const float* srcL, const float* srcC, bf16_t* H, const float* modl, int si, int nrows, int tid, int G) {
    const int lane = tid & 63, wave = tid >> 6; const int gw = blockIdx.x * 8 + wave, NGW = G * 8;
    for (int row = gw; row < nrows; row += NGW) {
        const bool lat = row < NLAT;
        const f32x4* xr = (const f32x4*)(lat ? srcL + (size_t)row * DM : srcC + (size_t)(row - NLAT) * DM) + lane;
        const float* sh = modl + (size_t)(lat ? (row >> 13) : 4) * NADA + si * DM;
        f32x4 v[4]; float ss = 0.f;
#pragma unroll
        for (int j = 0; j < 4; ++j) { v[j] = xr[64 * j]; ss += (v[j].x * v[j].x + v[j].y * v[j].y) + (v[j].z * v[j].z + v[j].w * v[j].w); }
        ss = fa::wave_sum(ss, lane);
        const float rstd = rsqrtf(ss * (1.0f / DM) + 1e-6f);
        v2u* o8 = (v2u*)(H + (size_t)row * DM) + lane;
#pragma unroll
        for (int j = 0; j < 4; ++j) {
            const f32x4 h4 = ((const f32x4*)sh)[lane + 64 * j], s4 = ((const f32x4*)(sh + DM))[lane + 64 * j];
            const f32x4 y = v[j] * rstd * (s4 + 1.0f) + h4;
            v2u wv; wv.x = fa::cvtpk(y.x, y.y); wv.y = fa::cvtpk(y.z, y.w); o8[64 * j] = wv;
        }
    }
}
__device__ __forceinline__ void final_norm_phase(const float* Xs, float* X, const float* gain, int tid, int G) {
    const int lane = tid & 63, wave = tid >> 6; const int gw = blockIdx.x * 8 + wave, NGW = G * 8;
    for (int row = gw; row < NLAT; row += NGW) {
        f32x4* xr = (f32x4*)(X + (size_t)row * DM) + lane; const f32x4* xs = (const f32x4*)(Xs + (size_t)row * DM) + lane;
        f32x4 v[4]; float ss = 0.f;
#pragma unroll
        for (int j = 0; j < 4; ++j) { v[j] = xs[64 * j]; ss += (v[j].x * v[j].x + v[j].y * v[j].y) + (v[j].z * v[j].z + v[j].w * v[j].w); }
        ss = fa::wave_sum(ss, lane);
        const float rstd = rsqrtf(ss * (1.0f / DM) + 1e-6f);
#pragma unroll
        for (int j = 0; j < 4; ++j) { const f32x4 g = ((const f32x4*)gain)[lane + 64 * j]; xr[64 * j] = v[j] * rstd * g; }
    }
}

__device__ __forceinline__ void mix_phase(const Args& a, LAS unsigned char* lds, int l, int tid, int G, const int umask) {
    const bf16_t* Z = (const bf16_t*)(a.ws + WS_G); bf16_t* O = (bf16_t*)(a.ws + WS_O);
    const int lane = tid & 63;
    const float linit = (l == 0) ? 0.2f : 0.35550906759f;
    float lam;
    { const float d1 = fa::wave_sum(a.in[I_LQ1][l * 64 + lane] * a.in[I_LK1][l * 64 + lane], lane); const float d2 = fa::wave_sum(a.in[I_LQ2][l * 64 + lane] * a.in[I_LK2][l * 64 + lane], lane);
      lam = __expf(d1) - __expf(d2) + linit; }
    const float* subln = a.in[I_SUBLN] + l * 128;
    const int n_diff = 1024, n_na = 512, n_gm = (l == 0) ? 1056 : 1024, n_nac = (l == 0) ? 16 : 0, n_dc = (l == 0) ? 32 : 0;
    const int total = n_diff + n_na + n_gm + n_nac + n_dc;
    const int tid_m = tid;
    for (int it = blockIdx.x; it < total; it += G) {
        int tid = tid_m; asm volatile("" : "+v"(tid));
        int r = it;
        const bool is_dl = r < n_diff, is_dc = r >= n_diff + n_na + n_gm + n_nac;
        const bool is_nl = !is_dl && r < n_diff + n_na, is_nc = !is_dc && r >= n_diff + n_na + n_gm;
        if (is_dl || is_dc) {
            int b, hd, q0row, nlat;
            if (is_dl) { const int blk = r & 255, k = r >> 8; const int xcd = blk & 7, slot = blk >> 3; const int jj = k * 32 + slot; const int bh = 2 * xcd + (jj >> 6), qb = jj & 63;
                b = bh >> 2; hd = bh & 3; q0row = b * SEQ + qb * 128; nlat = 128; }
            else { const int rr = r - (n_diff + n_na + n_gm + n_nac); b = rr >> 3; hd = (rr >> 1) & 3; q0row = NLAT + b * CTXL + (rr & 1) * 128; nlat = 0; }
            if (umask & 1) fa::diff_unit(lds, Z, O, b, hd, q0row, nlat, lam, 1.0f - linit, subln, tid);
        } else if (is_nl || is_nc) {
            int b, hd, r0, ctxq;
            if (is_nl) { const int rr = r - n_diff; b = rr >> 7; hd = (rr >> 5) & 3; r0 = 4 * (rr & 31); ctxq = 0; }
            else { const int rr = r - (n_diff + n_na + n_gm); b = rr >> 2; hd = rr & 3; r0 = 0; ctxq = 1; }
            if (umask & 2) fa::na_unit(lds, Z, O, a.in[I_RPB] + (size_t)(l * 4 + hd) * 465, b, hd, r0, ctxq, tid);
        } else {
            const int rr = r - (n_diff + n_na); const int chunk = rr >> 2, g = rr & 3;
            const long row0 = chunk < 256 ? (long)chunk * 128 : (long)NLAT + (chunk - 256) * 128;
            if (umask & 4) fa::gmlp_unit(lds, Z, O, a.in[I_GMWS] + (size_t)(l * 4 + g) * 16384, a.in[I_GMBS] + (l * 4 + g) * 128, a.in[I_GMNORM] + (l * 4 + g) * 64, row0, g, tid);
        }
    }
}


#if DBG_CHECK
constexpr size_t WS_DBG = 5 * MiB, WS_XC2 = 404 * MiB;
__device__ __forceinline__ float dbg_bf(const bf16_t* p, size_t i) { return __uint_as_float(((unsigned)p[i]) << 16); }
__device__ __forceinline__ unsigned dbg_hash(unsigned x) { x ^= x >> 16; x *= 0x7feb352du; x ^= x >> 15; x *= 0x846ca68bu; x ^= x >> 16; return x; }
__device__ __forceinline__ bool dbg_bad(float got, float ref, float atol = 0.03f) { return !(fabsf(got - ref) <= atol + 0.03f * fabsf(ref)); }
__device__ __forceinline__ float dbg_block_sum(float v, LAS float* red, int tid) {
    v = fa::wave_sum(v, tid & 63); __syncthreads(); if ((tid & 63) == 0) red[tid >> 6] = v; __syncthreads();
    float s = 0.f; for (int i = 0; i < 8; ++i) s += red[i]; __syncthreads(); return s;
}
__device__ __forceinline__ float dbg_block_max(float v, LAS float* red, int tid) {
    for (int o = 1; o < 64; o <<= 1) v = fmaxf(v, __shfl_xor(v, o));
    __syncthreads(); if ((tid & 63) == 0) red[tid >> 6] = v; __syncthreads();
    float s = red[0]; for (int i = 1; i < 8; ++i) s = fmaxf(s, red[i]); __syncthreads(); return s;
}
template <class KR, class BI>
__device__ __forceinline__ void dbg_attn(const bf16_t* Z, long qrow, int qcol, int kcol, int vcol, int dv, int nk, KR krow, BI bias, LAS float* sc, LAS float* outv, LAS float* red, int tid) {
    float lm = -3e38f;
    for (int i = tid; i < nk; i += 512) { const long kr = krow(i); float s = 0.f; for (int d = 0; d < 64; ++d) s += dbg_bf(Z, (size_t)qrow * DIN + qcol + d) * dbg_bf(Z, (size_t)kr * DIN + kcol + d); s = s * 0.125f + bias(i); sc[i] = s; lm = fmaxf(lm, s); }
    const float m = dbg_block_max(lm, red, tid);
    float ls = 0.f;
    for (int i = tid; i < nk; i += 512) { const float p = __expf(sc[i] - m); sc[i] = p; ls += p; }
    const float tot = dbg_block_sum(ls, red, tid);
    const int d = tid & 127, part = tid >> 7;
    float acc = 0.f;
    if (d < dv) for (int i = part; i < nk; i += 4) acc += sc[i] * dbg_bf(Z, (size_t)krow(i) * DIN + vcol + d);
    __syncthreads();
    LAS float* tmp = red + 16;
    tmp[part * 128 + d] = acc; __syncthreads();
    if (tid < dv) outv[tid] = (tmp[tid] + tmp[128 + tid] + tmp[256 + tid] + tmp[384 + tid]) / tot;
    __syncthreads();
}
__device__ __forceinline__ void dbg_check(const Args& a, LAS unsigned char* lds, int tid, int G, const int l, const int sres) {
    unsigned* flags = (unsigned*)(a.ws + WS_DBG);
    const bf16_t* H = (const bf16_t*)(a.ws + WS_H); const bf16_t* Z = (const bf16_t*)(a.ws + WS_G); const bf16_t* O = (const bf16_t*)(a.ws + WS_O);
    const float* mod = (const float*)(a.ws + WS_MOD) + (size_t)l * 5 * NADA;
    const int blk = blockIdx.x;
    if (blk == 7 && tid == 0) atomicOr(flags, 1u);
    if (sres == 6) {
    {
        const int rows[8] = {0, 77, 8192, 20000, 32767, 32768, 33000, 33791};
        bool bad = false;
        for (int sidx = tid; sidx < 8 * 70; sidx += 512) {
            int ri = sidx / 70; const int row = (int)(dbg_hash(blk * 8 + ri + 1000) % (unsigned)MT); const int col = ((sidx % 70) * 37 + blk) % DIN;
            const bool rope = (col >= 1280 && col < 2304 && row < NLAT);
            const int c1 = rope ? (col & ~63) + (col & 31) : col; const int c2 = c1 + 32;
            float x1 = 0.f, x2 = 0.f;
            for (int k = 0; k < 1024; ++k) { const float hv = dbg_bf(H, (size_t)row * DM + k); x1 += hv * a.in[I_WIN][(size_t)l * 1024 * DIN + (size_t)k * DIN + c1]; if (rope) x2 += hv * a.in[I_WIN][(size_t)l * 1024 * DIN + (size_t)k * DIN + c2]; }
            float ref = x1;
            if (col >= 768 && col < 1280) ref = 0.5f * x1 * (1.0f + erff(x1 * 0.70710678f));
            if (rope) { const int t = row & 8191; const int j = col & 31; const float pos = (j < 16) ? (float)(t >> 6) : (float)(t & 63); const float fr = __builtin_amdgcn_exp2f(-(float)(j & 15) * 0.8304820237218406f);
                const float ang = pos * fr; const float c = __cosf(ang), s = __sinf(ang); ref = ((col & 63) < 32) ? x1 * c - x2 * s : x1 * s + x2 * c; }
            if (dbg_bad(dbg_bf(Z, (size_t)row * DIN + col), ref)) bad = true;
        }
        (void)rows;
        if (bad) atomicOr(flags, 2u);
    }
    {
        bool bad = false;
        if (tid < 144) {
            const int ci = tid / 36, g = (tid / 9) & 3, pi = (tid / 3) % 3, wi = tid % 3;
            const long row0 = 128L * (dbg_hash(blk * 4 + ci + 77) % (l == 0 ? 264u : 256u)); const int p = (int)(dbg_hash(blk * 16 + pi + 5) % 128u); const int w = (int)(dbg_hash(blk * 16 + wi + 11) % 64u);
            float s = 0.f;
            for (int q = 0; q < 128; ++q) { float ss = 0.f; for (int e = 0; e < 64; ++e) { const float v = dbg_bf(Z, (size_t)(row0 + q) * DIN + 1024 + 64 * g + e); ss += v * v; }
                const float vn = dbg_bf(Z, (size_t)(row0 + q) * DIN + 1024 + 64 * g + w) * rsqrtf(ss / 64.f + 1e-6f) * a.in[I_GMNORM][(l * 4 + g) * 64 + w];
                s += a.in[I_GMWS][(size_t)(l * 4 + g) * 16384 + p * 128 + q] * vn; }
            s += a.in[I_GMBS][(l * 4 + g) * 128 + p];
            const float ref = dbg_bf(Z, (size_t)(row0 + p) * DIN + 768 + 64 * g + w) * s;
            if (dbg_bad(dbg_bf(O, (size_t)(row0 + p) * DM + 256 + 64 * g + w), ref)) bad = true;
        }
        if (bad) atomicOr(flags, 4u);
    }
    for (int pass = 2; pass <= 3; ++pass) {
        LAS float* sc = (LAS float*)lds; LAS float* outv = sc + 8448; LAS float* outv2 = outv + 128; LAS float* red = outv2 + 128;
        bool bad = false;
        for (int smp = 0; smp < 2; ++smp) {
            if (pass == 2) {
                const unsigned hh_ = dbg_hash(blk * 2 + smp + 333); const int b = hh_ & 3, hd = (hh_ >> 2) & 3; const int t = (hh_ >> 4) & 8191; const bool cq = false;
                const int gr = t >> 6, gc = t & 63; int ks = gr - 4; ks = ks < 0 ? 0 : (ks > 120 ? 120 : ks); int w0 = gc - 8; w0 = w0 < 0 ? 0 : (w0 > 48 ? 48 : w0);
                const long qrow = (long)b * SEQ + t; const float* rp = a.in[I_RPB] + (size_t)(l * 4 + hd) * 465;
                auto krow = [=](int i) -> long { return i < 128 ? (long)b * SEQ + (ks + (i >> 4)) * 64 + w0 + (i & 15) : (long)NLAT + b * CTXL + (i - 128); };
                auto bias = [=](int i) -> float { return i < 128 ? rp[(ks + (i >> 4) - gr + 7) * 31 + (w0 + (i & 15) - gc + 15)] : 0.f; };
                dbg_attn(Z, qrow, hd * 64, 256 + hd * 64, 512 + hd * 64, 64, 384, krow, bias, sc, outv, red, tid);
                if (tid < 64 && dbg_bad(dbg_bf(O, (size_t)qrow * DM + hd * 64 + tid), outv[tid], 0.01f)) bad = true;
                (void)cq;
            } else {
                const unsigned hh_ = dbg_hash(blk * 2 + smp + 999); const int b = hh_ & 3, hd = (hh_ >> 2) & 3; const bool cq = ((hh_ >> 20) & 15) == 0 && (l == 0);
                const long qrow = cq ? (long)NLAT + b * CTXL + ((hh_ >> 4) & 255) : (long)b * SEQ + ((hh_ >> 4) & 8191);
                const int nk = cq ? 256 : 8448;
                auto krow = [=](int i) -> long { return cq ? (long)NLAT + b * CTXL + i : (i < 8192 ? (long)b * SEQ + i : (long)NLAT + b * CTXL + (i - 8192)); };
                auto bias = [=](int i) -> float { return 0.f; };
                dbg_attn(Z, qrow, 1280 + hd * 128, 1792 + hd * 128, 2304 + hd * 128, 128, nk, krow, bias, sc, outv, red, tid);
                dbg_attn(Z, qrow, 1280 + hd * 128 + 64, 1792 + hd * 128 + 64, 2304 + hd * 128, 128, nk, krow, bias, sc, outv2, red, tid);
                float d1 = 0.f, d2 = 0.f; for (int e = 0; e < 64; ++e) { d1 += a.in[I_LQ1][l * 64 + e] * a.in[I_LK1][l * 64 + e]; d2 += a.in[I_LQ2][l * 64 + e] * a.in[I_LK2][l * 64 + e]; }
                const float linit = l == 0 ? 0.2f : 0.35550906759f; const float lam = __expf(d1) - __expf(d2) + linit;
                float ss = 0.f; for (int e = 0; e < 128; ++e) { const float v = outv[e] - lam * outv2[e]; ss += v * v; }
                if (tid < 128) { const float ref = (outv[tid] - lam * outv2[tid]) * rsqrtf(ss / 128.f + 1e-6f) * a.in[I_SUBLN][l * 128 + tid] * (1.0f - linit);
                    if (dbg_bad(dbg_bf(O, (size_t)qrow * DM + 512 + hd * 128 + tid), ref, 0.05f)) bad = true; }
                __syncthreads();
            }
        }
        if (bad) atomicOr(flags, pass == 2 ? 8u : 16u);
    }
    }
    if (sres != 6) {
        const bf16_t* Gb = (const bf16_t*)(a.ws + WS_G);
        const float* w1 = (sres == 2 ? a.in[I_F1W1] : a.in[I_F2W1]) + (size_t)l * 1024 * DFF; const float* w3 = (sres == 2 ? a.in[I_F1W3] : a.in[I_F2W3]) + (size_t)l * 1024 * DFF;
        bool bad = false;
        for (int sidx = tid; sidx < 6 * 60; sidx += 512) {
            const int ri = sidx / 60; const int row = (int)(dbg_hash(blk * 8 + ri + 31337) % (unsigned)NLAT); const int col = ((sidx % 60) * 47 + blk * 11) % DFF;
            float x1 = 0.f, x3 = 0.f;
            for (int k = 0; k < 1024; ++k) { const float hv = dbg_bf(H, (size_t)row * DM + k); x1 += hv * w1[(size_t)k * DFF + col]; x3 += hv * w3[(size_t)k * DFF + col]; }
            const float ref = x1 / (1.0f + __expf(-x1)) * x3;
            if (dbg_bad(dbg_bf(Gb, (size_t)row * DFF + col), ref)) bad = true;
        }
        if (bad) atomicOr(flags, 2u);
    }
    {
        const float* saved = (const float*)(a.ws + WS_DBG + 65536);
        const bf16_t* A = sres == 6 ? O : (const bf16_t*)(a.ws + WS_G); const int K = sres == 6 ? DM : DFF;
        const float* W = sres == 6 ? a.in[I_WOUT] + (size_t)l * DM * DM : (sres == 2 ? a.in[I_F1W2] : a.in[I_F2W2]) + (size_t)l * DFF * DM;
        const int gidx = sres == 2 ? 2 : (sres == 6 ? 5 : 8); const float gs = sres == 6 ? 1.0f : 0.5f;
        bool bad = false;
        for (int sidx = tid; sidx < 64; sidx += 512) {
            const int ri = blk; const int row = (int)(dbg_hash(blk + 4242) % (unsigned)NLAT); const int col = (sidx * 16 + blk) % DM;
            float acc = 0.f; for (int k = 0; k < K; ++k) acc += dbg_bf(A, (size_t)row * K + k) * W[(size_t)k * DM + col];
            const float ref = saved[ri * DM + col] + gs * mod[(size_t)(row >> 13) * NADA + gidx * DM + col] * acc;
            if (dbg_bad(a.out[(size_t)row * DM + col], ref)) bad = true;
        }
        if (bad) atomicOr(flags, 32u);
    }
    if (sres != 6 && blk == 8) {
        const float* modall = (const float*)(a.ws + WS_MOD);
        bool bad = false;
        if (tid < 100) { const int ll = tid & 1, i = (tid >> 1) % 5, j = (tid * 977) % NADA;
            float acc = 0.f; for (int k = 0; k < 1024; ++k) { const float c = i < 4 ? a.in[I_C][i * 1024 + k] : a.in[I_CCTX][k]; acc += c / (1.0f + __expf(-c)) * a.in[I_WADA][(size_t)ll * 1024 * NADA + (size_t)k * NADA + j]; }
            acc += a.in[I_BADA][ll * NADA + j];
            if (dbg_bad(modall[(size_t)(ll * 5 + i) * NADA + j], acc)) bad = true; }
        if (bad) atomicOr(flags, 4u);
    }
    if (sres == 2 && l == 0 && blk == 9) {
        bool bad = false;
        if (tid < 5 * 40) { const int ri = tid / 40; const int row = ri == 0 ? 0 : ri == 1 ? 12345 : ri == 2 ? 32767 : ri == 3 ? 32768 : 33791; const int col = ((tid % 40) * 53) % DM;
            const float* xr = row < NLAT ? a.in[I_X] + (size_t)row * DM : a.in[I_CTX] + (size_t)(row - NLAT) * DM; const int bi = row < NLAT ? row >> 13 : 4;
            float ss = 0.f; for (int k = 0; k < DM; ++k) ss += xr[k] * xr[k];
            const float ref = xr[col] * rsqrtf(ss / DM + 1e-6f) * (1.0f + mod[(size_t)bi * NADA + DM + col]) + mod[(size_t)bi * NADA + col];
            if (dbg_bad(dbg_bf(H, (size_t)row * DM + col), ref)) bad = true; }
        if (bad) atomicOr(flags, 8u);
    }
    if (sres == 6) {
        const float* saved = (const float*)(a.ws + WS_DBG + 65536);
        bool bad = false;
        if (tid < 40) { const int ri = blk; const int row = (int)(dbg_hash(blk + 4242) % (unsigned)NLAT); const int col = ((tid % 40) * 53 + blk) % DM; const int bi = row >> 13;
            float ss = 0.f; for (int k = 0; k < DM; ++k) ss += saved[ri * DM + k] * saved[ri * DM + k];
            const float ref = saved[ri * DM + col] * rsqrtf(ss / DM + 1e-6f) * (1.0f + mod[(size_t)bi * NADA + 4 * DM + col]) + mod[(size_t)bi * NADA + 3 * DM + col];
            if (dbg_bad(dbg_bf(H, (size_t)row * DM + col), ref)) bad = true; }
        if (bad) atomicOr(flags, 64u);
    }
    if (sres == 6 && l == 0 && blk == 10) {
        LAS float* sc = (LAS float*)lds; LAS float* outv = sc + 8448; LAS float* red = outv + 256;
        const int b = 2, hd = 1; const long qrow = (long)NLAT + b * CTXL + 200;
        auto krow = [=](int i) -> long { return (long)NLAT + b * CTXL + i; };
        auto bias = [=](int i) -> float { return 0.f; };
        dbg_attn(Z, qrow, hd * 64, 256 + hd * 64, 512 + hd * 64, 64, 256, krow, bias, sc, outv, red, tid);
        bool bad = false;
        if (tid < 64 && dbg_bad(dbg_bf(O, (size_t)qrow * DM + hd * 64 + tid), outv[tid])) bad = true;
        if (bad) atomicOr(flags, 8u);
    }
}
__device__ __forceinline__ void dbg_save(const Args& a, const float* src, int tid) {
    float* saved = (float*)(a.ws + WS_DBG + 65536);
    { const int row = (int)(dbg_hash(blockIdx.x + 4242) % (unsigned)NLAT); for (int i = tid; i < DM; i += 512) saved[blockIdx.x * DM + i] = src[(size_t)row * DM + i]; }
}
__device__ __forceinline__ void dbg_save2(const Args& a, const float* src, int tid) {
    float* saved = (float*)(a.ws + WS_DBG + 2 * MiB);
    { const int row = (int)(dbg_hash(blockIdx.x + 777) % (unsigned)NLAT); for (int i = tid; i < DM; i += 512) saved[blockIdx.x * DM + i] = src[(size_t)row * DM + i]; }
}
__device__ __forceinline__ void dbg_check2(const Args& a, int tid) {
    const float* saved = (const float*)(a.ws + WS_DBG + 2 * MiB) + blockIdx.x * DM; unsigned* flags = (unsigned*)(a.ws + WS_DBG);
    const int row = (int)(dbg_hash(blockIdx.x + 777) % (unsigned)NLAT);
    float ss = 0.f; for (int k = 0; k < DM; ++k) ss += saved[k] * saved[k];
    bool bad = false;
    for (int c = tid; c < DM; c += 512) { const float ref = saved[c] * rsqrtf(ss / DM + 1e-6f) * a.in[I_FNORM][c]; if (dbg_bad(a.out[(size_t)row * DM + c], ref, 0.01f)) bad = true; }
    if (bad) atomicOr(flags, 64u);
}
__device__ __forceinline__ void dbg_fill(const Args& a, int tid, int G) {
    const unsigned mask = *(const volatile unsigned*)(a.ws + WS_DBG);
    const float c = __builtin_amdgcn_exp2f(0.5f * (float)(mask + 1));
    for (size_t i = (size_t)blockIdx.x * 512 + tid; i < (size_t)NLAT * DM; i += (size_t)G * 512) a.out[i] = c;
}
#endif

#define XB_TMO      128
#define XB_XCNT(j)  (256  + 64 * (j))
#define XB_XSUB(j)  (1280 + 64 * (j))
#define XB_XGEN(j)  (2304 + 64 * (j))
#define XB_TOP      3328
#define XB_TOPGEN   3392
#define XCD_BAR_WORDS 3456
#define XB_SPIN_CAP (1u << 24)

__device__ __forceinline__ unsigned xb_ld(unsigned* p)              { return __hip_atomic_load(p, __ATOMIC_RELAXED, __HIP_MEMORY_SCOPE_AGENT); }
__device__ __forceinline__ unsigned xb_add(unsigned* p, unsigned v) { return __hip_atomic_fetch_add(p, v, __ATOMIC_RELAXED, __HIP_MEMORY_SCOPE_AGENT); }
__device__ __forceinline__ unsigned xb_xcc_id() { return (unsigned)__builtin_amdgcn_s_getreg((3 << 11) | 20) & 0xFu; }
#define XB_SPIN(cond, bar) do { unsigned _sp = 0; while (cond) { __builtin_amdgcn_s_sleep(1); \
    if ((++_sp & 255u) == 0u) { if (xb_ld(&(bar)[XB_TMO])) break; if (_sp > XB_SPIN_CAP) { atomicAdd(&(bar)[XB_TMO], 1u); break; } } } } while (0)

struct XcdBarrier {
    unsigned* bar; unsigned x;
    volatile LAS unsigned* st;
};

__device__ __forceinline__ XcdBarrier xcd_barrier_post(unsigned* bar, volatile LAS unsigned* st) {
    XcdBarrier b; b.bar = bar; b.x = xb_xcc_id(); b.st = st;
    if (threadIdx.x == 0) (void)xb_add(&bar[XB_XCNT(b.x)], 1u);
    return b;
}
__device__ __forceinline__ void xcd_barrier_complete(unsigned* bar, unsigned x, unsigned& nloc, unsigned& nx) {
    const unsigned G = gridDim.x * gridDim.y * gridDim.z;
    unsigned sum, cnt, mine, sp = 0u;
    for (;;) {
        sum = 0u; cnt = 0u; mine = 0u;
#pragma unroll
        for (unsigned j = 0; j < 16; ++j) { const unsigned c = xb_ld(&bar[XB_XCNT(j)]); sum += c; cnt += (c > 0u) ? 1u : 0u; mine = (j == x) ? c : mine; }
        if (sum == G) break;
        __builtin_amdgcn_s_sleep(1);
        if ((++sp & 255u) == 0u) { if (xb_ld(&bar[XB_TMO])) break; if (sp > XB_SPIN_CAP) { atomicAdd(&bar[XB_TMO], 1u); break; } }
    }
    nloc = mine > 0u ? mine : 1u; nx = cnt > 0u ? cnt : 1u;
}

__device__ __forceinline__ void xcd_barrier(const XcdBarrier& b) {
    asm volatile("s_waitcnt vmcnt(0)" ::: "memory");
    __syncthreads();
    if (threadIdx.x == 0) {
        unsigned* bar = b.bar;
        __builtin_amdgcn_s_waitcnt(0);
        unsigned nloc = b.st[0], nx = b.st[1];
        if (nloc == 0u) { xcd_barrier_complete(bar, b.x, nloc, nx); b.st[0] = nloc; b.st[1] = nx; }
        const unsigned old = xb_add(&bar[XB_XSUB(b.x)], 1u);
        const unsigned gen = old / nloc;
        if (old + 1u == (gen + 1u) * nloc) {
            __builtin_amdgcn_fence(__ATOMIC_RELEASE, "agent");
            asm volatile("s_waitcnt vmcnt(0)" ::: "memory");
            const unsigned og = xb_add(&bar[XB_TOP], 1u);
            const unsigned tg = og / nx;
            if (og + 1u == (tg + 1u) * nx) xb_add(&bar[XB_TOPGEN], 1u);
            else XB_SPIN(xb_ld(&bar[XB_TOPGEN]) == tg, bar);
            __builtin_amdgcn_fence(__ATOMIC_ACQUIRE, "agent");
            xb_add(&bar[XB_XGEN(b.x)], 1u);
            asm volatile("s_waitcnt vmcnt(0)" ::: "memory");
        } else {
            XB_SPIN(xb_ld(&bar[XB_XGEN(b.x)]) == gen, bar);
            __builtin_amdgcn_fence(__ATOMIC_ACQUIRE, "agent");
            asm volatile("s_waitcnt vmcnt(0)" ::: "memory");
        }
    }
    __syncthreads();
}

constexpr size_t WS_BAR = 6 * MiB;
__global__ void __launch_bounds__(512, 2) mega_fwd(Args a) {
    extern __shared__ __attribute__((aligned(16))) unsigned char lds_raw[];
    LAS unsigned char* lds = (LAS unsigned char*)lds_raw;
    const int tid0 = threadIdx.x, G = gridDim.x;
    volatile LAS unsigned* MISC = (volatile LAS unsigned*)(lds + 131072 + 512);
    if (tid0 < 2) MISC[tid0] = 0u;
    __syncthreads();
    unsigned* barw = (unsigned*)(a.ws + WS_BAR);
    XcdBarrier xbar; xbar.bar = barw; xbar.x = 0; xbar.st = MISC;
    float* XL = a.out; float* XC = (float*)(a.ws + WS_XC);
    bf16_t* H = (bf16_t*)(a.ws + WS_H); bf16_t* O = (bf16_t*)(a.ws + WS_O); bf16_t* GB = (bf16_t*)(a.ws + WS_G);
    const float* mod = (const float*)(a.ws + WS_MOD);
    for (int step = a.ph_lo; step < a.ph_hi; ++step) {
        int tid = tid0; asm volatile("" : "+v"(tid));
#if DBG_CHECK
        if (step == 100) { dbg_check(a, lds, tid, G, (DBG_STOP - 1) / 10, (DBG_STOP - 1) % 10); continue; }
        if (step == 103) { dbg_save2(a, XL, tid); continue; }
        if (step == 104) { dbg_check2(a, tid); continue; }
        if (step == 102) { dbg_save(a, (DBG_STOP <= 3) ? a.in[I_X] : XL, tid); continue; }
        if (step == 101) { if (DBG_FILL) dbg_fill(a, tid, G); continue; }
        if (step == 0 && blockIdx.x == 0 && tid == 0) *(unsigned*)(a.ws + 5 * MiB) = 0u;
#endif
        if (step == 0) { if (blockIdx.x == 0) for (int i = tid; i < XCD_BAR_WORDS; i += 512) barw[i] = 0u; if (PH_MASK & 1) prologue(a, lds, tid, G); }
        else if (step == NSTEPS - 1) { if (PH_MASK & 2) final_norm_phase(DBG_IDENT ? a.in[I_X] : XL, XL, a.in[I_FNORM], tid, G); }
        else {
            const int l = (step - 1) / 10, s = (step - 1) % 10;
            if (((DBG_SKIP >> s) & 1) && ((DBG_SKIP_LAYERS >> l) & 1)) continue;
            const float* modl = mod + (size_t)l * 5 * NADA;
            const unsigned char* wl = a.ws + WS_W + (size_t)l * WS_WLAYER;
            const bool first = (l == 0 && s <= 2);
            const float* srcL = first ? a.in[I_X] : XL; const float* srcC = first ? a.in[I_CTX] : XC;
            const bool lat_only = (l == 1 && s >= 6);
            const int Mrows = lat_only ? NLAT : MT;
            if (s == 0 || s == 3 || s == 7) { if (PH_MASK & 4)
                modulate_phase(srcL, srcC, H, modl, s == 0 ? 0 : (s == 3 ? 3 : 6), Mrows, tid, G);
            } else if (s == 1 || s == 8) { if (PH_MASK & 8) {
                pg8::Gemm g{H, (const bf16_t*)(wl + (s == 1 ? WO_UP1 : WO_UP2)), Mrows, 2 * DFF, DM}; pg8::StaticOrder S; S.init(Mrows, 2 * DFF, G, (int)blockIdx.x);
                pg8::EpiSwiGLU E{GB, DFF};
                pg8::gemm_phase<pg8::EpiSwiGLU, pg8::StaticOrder, true, true>(lds, g, S, E); }
            } else if (s == 2 || s == 6 || s == 9) { if (PH_MASK & 16) {
                const bf16_t* A = (s == 6) ? O : GB; const int K = (s == 6) ? DM : DFF;
                const bf16_t* Bt = (const bf16_t*)(wl + (s == 2 ? WO_DN1 : (s == 6 ? WO_OUT : WO_DN2)));
                pg8::Gemm g{A, Bt, Mrows, DM, K}; pg8::StaticOrder S; S.init(Mrows, DM, G, (int)blockIdx.x);
                pg8::EpiResid E{srcL, srcC, XL, XC, modl, s == 2 ? 2 : (s == 6 ? 5 : 8), s == 6 ? 1.0f : 0.5f};
                pg8::gemm_phase<pg8::EpiResid, pg8::StaticOrder, true, true>(lds, g, S, E); }
            } else if (s == 4) { if (PH_MASK & 32) {
                pg8::Gemm g{H, (const bf16_t*)(wl + WO_IN), MT, DIN, DM}; pg8::StaticOrder S; S.init(MT, DIN, G, (int)blockIdx.x);
                pg8::EpiInProj E{GB};
                pg8::gemm_phase<pg8::EpiInProj, pg8::StaticOrder, true, true>(lds, g, S, E); }
            } else {
                if (PH_MASK & 64) for (int rep_ = 0; rep_ < REP_MIX; ++rep_) mix_phase(a, lds, l, tid, G, rep_ == 0 ? 7 : REP_MASK);
            }
        }
        if (step + 1 < a.ph_hi) {
            if (step == a.ph_lo) { cg::this_grid().sync(); xbar = xcd_barrier_post(barw, MISC); }
            else xcd_barrier(xbar);
        }
    }
}

extern "C" void kernel_launch(void* const* d_in, const int* in_sizes, int n_in, void* d_out, int out_size, void* d_ws, size_t ws_size, hipStream_t stream) {
    static int grid = 0;
    if (grid == 0) {
        if (n_in != 24 || in_sizes[0] != NLAT * DM || out_size != NLAT * DM || ws_size < WS_END) { fprintf(stderr, "kernel_launch: unexpected shapes (n_in %d, in0 %d, out %d, ws %zu)\n", n_in, n_in > 0 ? in_sizes[0] : -1, out_size, ws_size); grid = -1; return; }
        int dev = 0, cus = 0, per_cu = 0;
        if (hipGetDevice(&dev) != hipSuccess || hipDeviceGetAttribute(&cus, hipDeviceAttributeMultiprocessorCount, dev) != hipSuccess) { grid = -1; return; }
        if (hipFuncSetAttribute((const void*)mega_fwd, hipFuncAttributeMaxDynamicSharedMemorySize, LDS_BYTES) != hipSuccess) { fprintf(stderr, "kernel_launch: hipFuncSetAttribute failed\n"); grid = -1; return; }
        if (hipOccupancyMaxActiveBlocksPerMultiprocessor(&per_cu, (const void*)mega_fwd, 512, LDS_BYTES) != hipSuccess || per_cu < 1) { fprintf(stderr, "kernel_launch: occupancy query gave %d\n", per_cu); per_cu = 1; }
        (void)hipGetLastError();
        grid = cus * (per_cu > 1 ? 1 : per_cu);
    }
    if (grid < 0) return;
    Args a{};
    for (int i = 0; i < 24; ++i) a.in[i] = (const float*)d_in[i];
    a.out = (float*)d_out; a.ws = (unsigned char*)d_ws;
#if ONE_LAUNCH
    a.ph_lo = 0; a.ph_hi = NSTEPS;
    void* args[] = {&a};
    hipError_t e = hipLaunchCooperativeKernel((const void*)mega_fwd, dim3(grid), dim3(512), args, LDS_BYTES, stream);
    if (e != hipSuccess) fprintf(stderr, "cooperative launch failed: %s (grid %d)\n", hipGetErrorString(e), grid);
#else
#if DBG_CHECK
    for (int st = 0; st < DBG_STOP + (DBG_STOP == 20 ? 7 : 4); ++st) { const int k_ = st - DBG_STOP; const int sid = st < DBG_STOP ? st : (k_ == 0 ? 102 : (k_ == 1 ? DBG_STOP : (k_ == 2 ? 100 : (DBG_STOP != 20 ? 101 : (k_ == 3 ? 103 : (k_ == 4 ? 21 : (k_ == 5 ? 104 : 101))))))); a.ph_lo = sid; a.ph_hi = sid + 1; hipLaunchKernelGGL(mega_fwd, dim3(grid), dim3(512), LDS_BYTES, stream, a); }
#else
    for (int st = 0; st < NSTEPS; ++st) { a.ph_lo = st; a.ph_hi = st + 1; hipLaunchKernelGGL(mega_fwd, dim3(grid), dim3(512), LDS_BYTES, stream, a); }
#endif
#endif
}
```

```cpp
#include <hip/hip_runtime.h>
#include <hip/hip_cooperative_groups.h>
#include <cstdio>
#include <cstdint>
namespace cg = cooperative_groups;
#ifndef ONE_LAUNCH
#define ONE_LAUNCH 1
#endif
namespace pg8 {
#define PG8_LAS __attribute__((address_space(3)))
typedef unsigned short bf16_t;
typedef short bf16x8 __attribute__((ext_vector_type(8)));
typedef float f32x4 __attribute__((ext_vector_type(4)));
typedef unsigned u32x4 __attribute__((ext_vector_type(4)));
constexpr int BM = 256, BK = 64, HALF = 128, HTB = HALF * BK * 2  , STAGE_BYTES = 8 * HTB, NXCD = 8, WGM = 8;

__host__ __device__ __forceinline__ int lds_byte(int r, int c) { const int st = (r >> 4) * 2 + (c >> 5), rr = r & 15, cc = c & 31, ob = rr * 64 + cc * 2; return st * 1024 + (ob ^ (((ob >> 9) & 1) << 5)); }
__host__ __device__ __forceinline__ void stage_rc(int b, int& R, int& C) { const int st = b / 1024, sb = b % 1024, swz = sb ^ (((sb >> 9) & 1) << 5); R = (st >> 1) * 16 + swz / 64; C = (st & 1) * 32 + (swz % 64) / 2; }
__host__ __device__ __forceinline__ int perm32(int rho) { const int n = rho >> 4, i = rho & 15; return 8 * (i >> 2) + 4 * n + (i & 3); }

struct Unit { int pm, pn; };
struct Gemm { const bf16_t* A; const bf16_t* Bt; int M, N, K; };

struct StaticOrder {
    int nM, nN, nwg, G, c;
    __host__ __device__ void init(int M, int N, int G_, int c_) { nM = M / BM; nN = N / BM; nwg = nM * nN; G = G_; c = c_; }
    __host__ __device__ bool next(int i, Unit& u) const {
        const long L = (long)i * G + c; if (L >= nwg) return false;
        int wgid = (int)L; { const int q = nwg / NXCD, r = nwg % NXCD, xcd = wgid % NXCD, off = wgid / NXCD; wgid = (xcd < r ? xcd * (q + 1) : r * (q + 1) + (xcd - r) * q) + off; }
        const int nig = WGM * nN, gid = wgid / nig, fm = gid * WGM, gsz = (nM - fm) < WGM ? (nM - fm) : WGM;
        u.pm = fm + ((wgid % nig) % gsz); u.pn = (wgid % nig) / gsz; return true;
    }
    __device__ __forceinline__ void a_ready(const Unit&) const {}
    __device__ __forceinline__ void done(const Unit&) const {}
};

__device__ __forceinline__ unsigned cvt_pk_bf16(float lo, float hi) { unsigned r; asm volatile("v_cvt_pk_bf16_f32 %0, %1, %2" : "=v"(r) : "v"(lo), "v"(hi)); return r; }
typedef float f32x2 __attribute__((ext_vector_type(2)));
__device__ __forceinline__ f32x2 gelu_pk(f32x2 v) {
    const f32x2 av = __builtin_elementwise_abs(v), d = av * 0.2316418882f + 1.0f;
    f32x2 t; t.x = __builtin_amdgcn_rcpf(d.x); t.y = __builtin_amdgcn_rcpf(d.y);
    f32x2 q = t * 0.5307027145f + (-0.7265760135f); q = q * t + 0.7107068705f; q = q * t + (-0.142248368f); q = q * t + 0.127414796f; q = q * t;
    const f32x2 s = (v * v) * (-0.72134752044f);
    f32x2 e; e.x = __builtin_amdgcn_exp2f(s.x); e.y = __builtin_amdgcn_exp2f(s.y);
    const f32x2 m = v * (q * e), r = v - m;
    f32x2 o; o.x = v.x < 0.f ? m.x : r.x; o.y = v.y < 0.f ? m.y : r.y; return o;
}


constexpr int NLAT_ROWS = 32768, DMODEL = 1024, NADA_COLS = 9216;
__device__ __forceinline__ float silu_f(float a) { return a * __builtin_amdgcn_rcpf(1.0f + __builtin_amdgcn_exp2f(-1.4426950408889634f * a)); }

struct EpiSwiGLU {
    static constexpr bool PERM = true, AFTER_DRAIN = false;
    bf16_t* G; int ldc;
    __device__ __forceinline__ void operator()(const f32x4 (&acc)[2][2][4][2], const Unit& u, int wr, int wc, int fr, int fq) const {
        const int row0 = u.pm * BM + wr * 64 + fr; const int col0 = u.pn * HALF + wc * 32 + 8 * fq;
#pragma unroll
        for (int ai = 0; ai < 2; ++ai)
#pragma unroll
            for (int m = 0; m < 4; ++m) {
                bf16_t* rowp = G + (size_t)(row0 + ai * HALF + m * 16) * ldc + col0;
                const f32x4 a0 = acc[ai][0][m][0], a1 = acc[ai][0][m][1], b0 = acc[ai][1][m][0], b1 = acc[ai][1][m][1];
                u32x4 w;
                w.x = cvt_pk_bf16(silu_f(a0[0]) * b0[0], silu_f(a0[1]) * b0[1]); w.y = cvt_pk_bf16(silu_f(a0[2]) * b0[2], silu_f(a0[3]) * b0[3]);
                w.z = cvt_pk_bf16(silu_f(a1[0]) * b1[0], silu_f(a1[1]) * b1[1]); w.w = cvt_pk_bf16(silu_f(a1[2]) * b1[2], silu_f(a1[3]) * b1[3]);
                *(u32x4*)rowp = w;
            }
    }
};

struct EpiInProj {
    static constexpr bool PERM = true, AFTER_DRAIN = false;
    bf16_t* Z;
    __device__ __forceinline__ void operator()(const f32x4 (&acc)[2][2][4][2], const Unit& u, int wr, int wc, int fr, int fq) const {
        const int pn = u.pn; const bool do_gelu = (pn == 3 || pn == 4); const bool do_rope = (pn >= 5 && pn <= 8 && u.pm < 128);
        const int row0 = u.pm * BM + wr * 64 + fr; const int colb = pn * 256 + 64 * wc + 8 * fq;
        float fq8[8];
#pragma unroll
        for (int i = 0; i < 8; ++i) fq8[i] = __builtin_amdgcn_exp2f(-(float)(8 * (fq & 1) + i) * 0.8304820237218406f);
#pragma unroll
        for (int ai = 0; ai < 2; ++ai)
#pragma unroll
            for (int m = 0; m < 4; ++m) {
                const int row = row0 + ai * HALF + m * 16;
                f32x4 a0 = acc[ai][0][m][0], a1 = acc[ai][0][m][1], b0 = acc[ai][1][m][0], b1 = acc[ai][1][m][1];
                if (do_gelu) {
                    f32x2 t;
                    t = gelu_pk((f32x2){a0[0], a0[1]}); a0[0] = t.x; a0[1] = t.y; t = gelu_pk((f32x2){a0[2], a0[3]}); a0[2] = t.x; a0[3] = t.y;
                    t = gelu_pk((f32x2){a1[0], a1[1]}); a1[0] = t.x; a1[1] = t.y; t = gelu_pk((f32x2){a1[2], a1[3]}); a1[2] = t.x; a1[3] = t.y;
                    t = gelu_pk((f32x2){b0[0], b0[1]}); b0[0] = t.x; b0[1] = t.y; t = gelu_pk((f32x2){b0[2], b0[3]}); b0[2] = t.x; b0[3] = t.y;
                    t = gelu_pk((f32x2){b1[0], b1[1]}); b1[0] = t.x; b1[1] = t.y; t = gelu_pk((f32x2){b1[2], b1[3]}); b1[2] = t.x; b1[3] = t.y;
                } else if (do_rope) {
                    const int t = row & 8191; const float fpos = (float)((fq < 2) ? (t >> 6) : (t & 63));
#pragma unroll
                    for (int e = 0; e < 4; ++e) {
                        { const float ang = fpos * fq8[e]; const float c = __cosf(ang), s = __sinf(ang); const float x1 = a0[e], x2 = b0[e]; a0[e] = x1 * c - x2 * s; b0[e] = x1 * s + x2 * c; }
                        { const float ang = fpos * fq8[4 + e]; const float c = __cosf(ang), s = __sinf(ang); const float x1 = a1[e], x2 = b1[e]; a1[e] = x1 * c - x2 * s; b1[e] = x1 * s + x2 * c; }
                    }
                }
                bf16_t* rowp = Z + (size_t)row * 2816 + colb;
                u32x4 w; w.x = cvt_pk_bf16(a0[0], a0[1]); w.y = cvt_pk_bf16(a0[2], a0[3]); w.z = cvt_pk_bf16(a1[0], a1[1]); w.w = cvt_pk_bf16(a1[2], a1[3]);
                *(u32x4*)rowp = w;
                u32x4 v; v.x = cvt_pk_bf16(b0[0], b0[1]); v.y = cvt_pk_bf16(b0[2], b0[3]); v.z = cvt_pk_bf16(b1[0], b1[1]); v.w = cvt_pk_bf16(b1[2], b1[3]);
                *(u32x4*)(rowp + 32) = v;
            }
    }
};

struct EpiResid {
    static constexpr bool PERM = true, AFTER_DRAIN = false;
    const float* srcL; const float* srcC; float* dstL; float* dstC; const float* modl; int gidx; float gscale;
    __device__ __forceinline__ void operator()(const f32x4 (&acc)[2][2][4][2], const Unit& u, int wr, int wc, int fr, int fq) const {
        const bool lat = u.pm < 128;
        const float* sb = lat ? srcL + (size_t)u.pm * BM * DMODEL : srcC + (size_t)(u.pm - 128) * BM * DMODEL;
        float* db = lat ? dstL + (size_t)u.pm * BM * DMODEL : dstC + (size_t)(u.pm - 128) * BM * DMODEL;
        const float* gate = modl + (size_t)(lat ? (u.pm >> 5) : 4) * NADA_COLS + gidx * DMODEL;
        const int col0 = u.pn * BM + wc * 32 + 8 * fq;
        f32x4 g4[2][2];
#pragma unroll
        for (int bj = 0; bj < 2; ++bj)
#pragma unroll
            for (int n = 0; n < 2; ++n) g4[bj][n] = *(const f32x4*)(gate + col0 + bj * HALF + n * 4) * gscale;
#pragma unroll
        for (int ai = 0; ai < 2; ++ai)
#pragma unroll
            for (int m = 0; m < 4; ++m) {
                const size_t off = (size_t)(ai * HALF + wr * 64 + m * 16 + fr) * DMODEL + col0;
#pragma unroll
                for (int bj = 0; bj < 2; ++bj)
#pragma unroll
                    for (int n = 0; n < 2; ++n) {
                        const f32x4 bs = *(const f32x4*)(sb + off + bj * HALF + n * 4);
                        *(f32x4*)(db + off + bj * HALF + n * 4) = bs + g4[bj][n] * acc[ai][bj][m][n];
                    }
                if (m & 1) asm volatile("" ::: "memory");
            }
    }
};
template <class Epi, class Sched, bool ALIGN_EPI = false, bool SP2 = false>
__device__ __forceinline__ void gemm_phase(PG8_LAS unsigned char* lds, const Gemm g, const Sched& S, const Epi& E) {
    int tid_ = threadIdx.x; asm volatile("" : "+v"(tid_));
    const int tid = tid_, wid = __builtin_amdgcn_readfirstlane(tid >> 6), lane = tid & 63, wr = wid >> 2, wc = wid & 3, fr = lane & 15, fq = lane >> 4;
    const int K = g.K, nt = K / BK;
    unsigned voffA[2], voffB[2];
#pragma unroll
    for (int i = 0; i < 2; ++i) { int R, C; stage_rc(tid * 16 + i * 8192, R, C); const int Rb = Epi::PERM ? ((R & ~31) + perm32(R & 31)) : R;
        voffA[i] = (unsigned)(R * K + C) * 2u; voffB[i] = (unsigned)(Rb * K + C) * 2u; }
    const size_t kstep = (size_t)(BK * 2);
    const size_t hstep = (size_t)HALF * K * 2;
    const size_t tstep = 2 * hstep;
    const unsigned ldsw = (unsigned)wid * 1024u;
    const int aoff = lds_byte(wr * 64 + fr, fq * 8), boff = lds_byte(wc * 32 + fr, fq * 8);
#define PG8_SA(b, h) (((b) * 2 + (h)) * HTB)
#define PG8_SB(b, h) ((4 + (b) * 2 + (h)) * HTB)
#define PG8_STAGE(bufoff, gbase, voff) do { _Pragma("unroll") for (int _i = 0; _i < 2; ++_i) \
        __builtin_amdgcn_global_load_lds((const unsigned*)((const char*)(gbase) + (voff)[_i]), (PG8_LAS unsigned*)(lds + (bufoff) + ldsw + _i * 8192), 16, 0, 0); } while (0)
#define PG8_LDA(dst, b, h) do { _Pragma("unroll") for (int m = 0; m < 4; ++m) _Pragma("unroll") for (int k = 0; k < 2; ++k) dst[m][k] = *(const PG8_LAS bf16x8*)(lds + PG8_SA(b, h) + aoff + m * 2048 + k * 1024); } while (0)
#define PG8_LDB(dst, b, h) do { _Pragma("unroll") for (int n = 0; n < 2; ++n) _Pragma("unroll") for (int k = 0; k < 2; ++k) dst[n][k] = *(const PG8_LAS bf16x8*)(lds + PG8_SB(b, h) + boff + n * 2048 + k * 1024); } while (0)
#define PG8_MMA(ai, bj, At, Bt) do { __builtin_amdgcn_s_setprio(1); _Pragma("unroll") for (int m = 0; m < 4; ++m) _Pragma("unroll") for (int n = 0; n < 2; ++n) _Pragma("unroll") for (int k = 0; k < 2; ++k) \
        acc[ai][bj][m][n] = __builtin_amdgcn_mfma_f32_16x16x32_bf16(Bt[n][k], At[m][k], acc[ai][bj][m][n], 0, 0, 0); __builtin_amdgcn_s_setprio(0); } while (0)
#define PG8_WAIT_V(n) asm volatile("s_waitcnt vmcnt(" #n ")" ::: "memory")
#define PG8_WAIT_L(n) asm volatile("s_waitcnt lgkmcnt(" #n ")" ::: "memory")
#define PG8_BAR __builtin_amdgcn_s_barrier()
#define PG8_SCHED __builtin_amdgcn_sched_barrier(0)
    Unit cur, nxt; int ui = 0;
    if (!S.next(0, cur)) return;
    f32x4 acc[2][2][4][2];
#pragma unroll
    for (int a = 0; a < 2; ++a)
#pragma unroll
        for (int b = 0; b < 2; ++b)
#pragma unroll
            for (int m = 0; m < 4; ++m)
#pragma unroll
                for (int n = 0; n < 2; ++n) acc[a][b][m][n] = (f32x4){0.f, 0.f, 0.f, 0.f};
    bf16x8 At[4][2], B0[2][2], B1[2][2];
    const char* cA = (const char*)g.A + (size_t)cur.pm * tstep; const char* cB = (const char*)g.Bt + (size_t)cur.pn * tstep;
    S.a_ready(cur);
    if constexpr (SP2) {
        PG8_STAGE(PG8_SB(0, 0), cB, voffB); PG8_STAGE(PG8_SB(0, 1), cB + hstep, voffB); PG8_STAGE(PG8_SA(0, 0), cA, voffA); PG8_STAGE(PG8_SA(0, 1), cA + hstep, voffA);
        if (wr == 1) PG8_BAR;
        PG8_WAIT_V(2); PG8_BAR;
        PG8_STAGE(PG8_SB(1, 0), cB + kstep, voffB); PG8_STAGE(PG8_SA(1, 0), cA + kstep, voffA); PG8_STAGE(PG8_SB(1, 1), cB + hstep + kstep, voffB);
        PG8_WAIT_V(6); PG8_BAR;
    } else {
        PG8_STAGE(PG8_SB(0, 0), cB, voffB); PG8_STAGE(PG8_SA(0, 0), cA, voffA); PG8_STAGE(PG8_SB(0, 1), cB + hstep, voffB); PG8_STAGE(PG8_SA(0, 1), cA + hstep, voffA);
        if (wr == 1) PG8_BAR;
        PG8_WAIT_V(4); PG8_BAR;
        PG8_STAGE(PG8_SB(1, 0), cB + kstep, voffB); PG8_STAGE(PG8_SA(1, 0), cA + kstep, voffA); PG8_STAGE(PG8_SB(1, 1), cB + hstep + kstep, voffB);
        PG8_WAIT_V(6); PG8_BAR;
    }
    for (;;) {
        const bool has_next = S.next(ui + 1, nxt);
        const char* nA = has_next ? (const char*)g.A + (size_t)nxt.pm * tstep : cA; const char* nB = has_next ? (const char*)g.Bt + (size_t)nxt.pn * tstep : cB;
        for (int t = 0; t < nt; t += 2) {
            const bool last = (t == nt - 2);
            const char* a1 = cA + (size_t)(t + 1) * kstep;
            const char* a2 = last ? nA : cA + (size_t)(t + 2) * kstep; const char* b2 = last ? nB : cB + (size_t)(t + 2) * kstep;
            const char* a3 = a2 + kstep; const char* b3 = b2 + kstep;
            if (last && has_next) S.a_ready(nxt);
            if constexpr (SP2) {
            PG8_LDB(B0, 0, 0); PG8_LDB(B1, 0, 1); PG8_SCHED; PG8_LDA(At, 0, 0); PG8_STAGE(PG8_SA(1, 1), a1 + hstep, voffA);
            PG8_WAIT_V(8); PG8_WAIT_L(0); PG8_BAR; PG8_MMA(0, 0, At, B0); PG8_MMA(0, 1, At, B1); PG8_BAR; PG8_SCHED;
            PG8_LDA(At, 0, 1); PG8_STAGE(PG8_SB(0, 0), b2, voffB); PG8_STAGE(PG8_SB(0, 1), b2 + hstep, voffB); PG8_STAGE(PG8_SA(0, 0), a2, voffA);
            PG8_WAIT_V(8); PG8_WAIT_L(0); PG8_BAR; PG8_MMA(1, 0, At, B0); PG8_MMA(1, 1, At, B1); PG8_BAR; PG8_SCHED;
            PG8_LDB(B0, 1, 0); PG8_LDB(B1, 1, 1); PG8_SCHED; PG8_LDA(At, 1, 0); PG8_STAGE(PG8_SA(0, 1), a2 + hstep, voffA);
            PG8_WAIT_V(8); PG8_WAIT_L(0); PG8_BAR; PG8_MMA(0, 0, At, B0); PG8_MMA(0, 1, At, B1); PG8_BAR; PG8_SCHED;
            PG8_LDA(At, 1, 1); PG8_STAGE(PG8_SB(1, 0), b3, voffB); PG8_STAGE(PG8_SB(1, 1), b3 + hstep, voffB); PG8_STAGE(PG8_SA(1, 0), a3, voffA);
            PG8_WAIT_V(8); PG8_WAIT_L(0); PG8_BAR; PG8_MMA(1, 0, At, B0); PG8_MMA(1, 1, At, B1); PG8_BAR; PG8_SCHED;
            } else {
            PG8_LDB(B0, 0, 0); PG8_SCHED; PG8_LDA(At, 0, 0); PG8_STAGE(PG8_SA(1, 1), a1 + hstep, voffA);
            PG8_WAIT_L(8); PG8_BAR; PG8_WAIT_L(0); PG8_MMA(0, 0, At, B0); PG8_BAR; PG8_SCHED;
            PG8_LDB(B1, 0, 1); PG8_STAGE(PG8_SB(0, 0), b2, voffB);
            PG8_BAR; PG8_WAIT_L(0); PG8_MMA(0, 1, At, B1); PG8_BAR;
            PG8_LDA(At, 0, 1); PG8_STAGE(PG8_SA(0, 0), a2, voffA);
            PG8_BAR; PG8_WAIT_L(0); PG8_MMA(1, 0, At, B0); PG8_BAR; PG8_SCHED;
            PG8_STAGE(PG8_SB(0, 1), b2 + hstep, voffB);
            PG8_WAIT_V(6); PG8_BAR; PG8_MMA(1, 1, At, B1); PG8_BAR;
            PG8_LDB(B0, 1, 0); PG8_SCHED; PG8_LDA(At, 1, 0); PG8_STAGE(PG8_SA(0, 1), a2 + hstep, voffA);
            PG8_WAIT_L(8); PG8_BAR; PG8_WAIT_L(0); PG8_MMA(0, 0, At, B0); PG8_BAR; PG8_SCHED;
            PG8_LDB(B1, 1, 1); PG8_STAGE(PG8_SB(1, 0), b3, voffB);
            PG8_BAR; PG8_WAIT_L(0); PG8_MMA(0, 1, At, B1); PG8_BAR;
            PG8_LDA(At, 1, 1); PG8_STAGE(PG8_SA(1, 0), a3, voffA);
            PG8_BAR; PG8_WAIT_L(0); PG8_MMA(1, 0, At, B0); PG8_BAR; PG8_SCHED;
            PG8_STAGE(PG8_SB(1, 1), b3 + hstep, voffB);
            PG8_WAIT_V(6); PG8_BAR; PG8_MMA(1, 1, At, B1); PG8_BAR;
            }
        }
        if constexpr (ALIGN_EPI) { if (wr == 0) PG8_BAR; }
        if constexpr (!Epi::AFTER_DRAIN) { E(acc, cur, wr, wc, fr, fq); S.done(cur); }
        if (!has_next) break;
#pragma unroll
        for (int a = 0; a < 2; ++a)
#pragma unroll
            for (int b = 0; b < 2; ++b)
#pragma unroll
                for (int m = 0; m < 4; ++m)
#pragma unroll
                    for (int n = 0; n < 2; ++n) acc[a][b][m][n] = (f32x4){0.f, 0.f, 0.f, 0.f};
        cur = nxt; cA = nA; cB = nB; ++ui;
        if constexpr (ALIGN_EPI) { if (wr == 1) PG8_BAR; }
    }
    PG8_WAIT_V(0);
    if constexpr (!ALIGN_EPI) { if (wr == 0) PG8_BAR; }
    PG8_BAR;
    if constexpr (Epi::AFTER_DRAIN) { E.fused(acc, cur, wr, wc, fr, fq, lds, wid, lane); S.done(cur); }
#undef PG8_SA
#undef PG8_SB
#undef PG8_STAGE
#undef PG8_LDA
#undef PG8_LDB
#undef PG8_MMA
#undef PG8_WAIT_V
#undef PG8_WAIT_L
#undef PG8_BAR
#undef PG8_SCHED
}
}

#define LAS __attribute__((address_space(3)))
typedef unsigned short bf16_t;
constexpr int DM = 1024, NBATCH = 4, SEQ = 8192, CTXL = 256, NLAT = NBATCH * SEQ, NCTX = NBATCH * CTXL, MT = NLAT + NCTX, DFF = 2816, DIN = 2816, NADA = 9216;
constexpr size_t MiB = 1u << 20;
constexpr size_t WS_MOD = 0, WS_XC = 1 * MiB, WS_W = 8 * MiB, WS_WLAYER = 41 * MiB, WS_H = 90 * MiB, WS_O = 156 * MiB, WS_G = 222 * MiB, WS_END = 404 * MiB;
constexpr size_t WO_UP1 = 0, WO_DN1 = 11534336, WO_IN = WO_DN1 + 5767168, WO_OUT = WO_IN + 5767168, WO_UP2 = WO_OUT + 2097152, WO_DN2 = WO_UP2 + 11534336;
static_assert(WO_DN2 + 5767168 <= WS_WLAYER, "weights per layer");
constexpr int LDS_BYTES = 135168;

#ifndef DBG_INJECT
#define DBG_INJECT 0.0f
#endif
namespace fa {
typedef short bf16x8 __attribute__((ext_vector_type(8)));
typedef short s16x4 __attribute__((ext_vector_type(4)));
typedef float f32x16 __attribute__((ext_vector_type(16)));
typedef float f32x4 __attribute__((ext_vector_type(4)));
typedef unsigned u32x4 __attribute__((ext_vector_type(4)));
typedef unsigned u32x2 __attribute__((ext_vector_type(2)));
typedef float f32x2_t __attribute__((ext_vector_type(2)));
typedef __bf16 bf16x2_t __attribute__((ext_vector_type(2)));
__device__ __forceinline__ unsigned cvtpk(float lo, float hi) { f32x2_t v = {lo, hi}; bf16x2_t b = __builtin_convertvector(v, bf16x2_t); return __builtin_bit_cast(unsigned, b); }
__device__ __forceinline__ float bf2f(unsigned short b) { return __uint_as_float(((unsigned)b) << 16); }
__device__ __forceinline__ float max3f(float a, float b, float c) { float r; asm("v_max3_f32 %0, %1, %2, %3" : "=v"(r) : "v"(a), "v"(b), "v"(c)); return r; }
__device__ __forceinline__ float xmax32(float v) { auto rr = __builtin_amdgcn_permlane32_swap(__float_as_uint(v), __float_as_uint(v), false, false); return fmaxf(__uint_as_float(rr[0]), __uint_as_float(rr[1])); }
__device__ __forceinline__ float xsum32(float v) { auto rr = __builtin_amdgcn_permlane32_swap(__float_as_uint(v), __float_as_uint(v), false, false); return __uint_as_float(rr[0]) + __uint_as_float(rr[1]); }
__device__ __forceinline__ s16x4 vtr(const LAS unsigned char* p) { return __builtin_bit_cast(s16x4, __builtin_amdgcn_ds_read_tr16_b64_v4i16((LAS s16x4*)p)); }
__device__ __forceinline__ float lane_xor(float v, int lane, int o) { return __builtin_bit_cast(float, __builtin_amdgcn_ds_bpermute((lane ^ o) << 2, __builtin_bit_cast(int, v))); }
__device__ __forceinline__ float wave_sum(float v, int lane) {
#pragma unroll
    for (int o = 1; o < 64; o <<= 1) v += lane_xor(v, lane, o);
    return v;
}

template <int KW, int VW> struct Geo {
    static constexpr int KSTR = KW * 2 + 16, VSTR = VW * 2 + 64;
    static constexpr int KBYTES = 64 * KSTR, VBYTES = 64 * VSTR, BUF = KBYTES + VBYTES;
    static constexpr int KCH = KW / 8, VCH = VW / 8;
    static constexpr int NCH = (64 * (KCH + VCH)) / 512;
};
template <int KW, int VW, int NCHP = Geo<KW, VW>::NCH>
__device__ __forceinline__ void st_load(u32x4 (&st)[NCHP], const bf16_t* Z, long rowbase, int kcol0, int vcol0, int tid) {
    using G = Geo<KW, VW>;
#pragma unroll
    for (int i = 0; i < G::NCH; ++i) {
        const int c = tid + i * 512;
        if (i * 512 < 64 * G::KCH) { const int key = c / G::KCH, ch = c % G::KCH; st[i] = *(const u32x4*)(Z + (size_t)(rowbase + key) * DIN + kcol0 + ch * 8); }
        else { const int c2 = c - 64 * G::KCH; const int key = c2 / G::VCH, ch = c2 % G::VCH; st[i] = *(const u32x4*)(Z + (size_t)(rowbase + key) * DIN + vcol0 + ch * 8); }
    }
}
template <int KW, int VW, int NCHP = Geo<KW, VW>::NCH>
__device__ __forceinline__ void st_store(LAS unsigned char* buf, const u32x4 (&st)[NCHP], int tid) {
    using G = Geo<KW, VW>;
#pragma unroll
    for (int i = 0; i < G::NCH; ++i) {
        const int c = tid + i * 512;
        if (i * 512 < 64 * G::KCH) { const int key = c / G::KCH, ch = c % G::KCH; *(LAS u32x4*)(buf + key * G::KSTR + ch * 16) = st[i]; }
        else { const int c2 = c - 64 * G::KCH; const int key = c2 / G::VCH, ch = c2 % G::VCH; *(LAS u32x4*)(buf + G::KBYTES + key * G::VSTR + ch * 16) = st[i]; }
    }
}
__device__ __forceinline__ f32x16 qk32(const LAS unsigned char* kp, const bf16x8 (&qf)[4]) {
    f32x16 s = {0.f, 0.f, 0.f, 0.f, 0.f, 0.f, 0.f, 0.f, 0.f, 0.f, 0.f, 0.f, 0.f, 0.f, 0.f, 0.f};
#pragma unroll
    for (int ks = 0; ks < 4; ++ks) { const bf16x8 kf = *(const LAS bf16x8*)(kp + ks * 32); s = __builtin_amdgcn_mfma_f32_32x32x16_bf16(kf, qf[ks], s, 0, 0, 0); }
    return s;
}
template <int NDB, int VSTR>
__device__ __forceinline__ void pv32(f32x16 (&o)[NDB], const LAS unsigned char* vp, const f32x16& p) {
#pragma unroll
    for (int s = 0; s < 2; ++s) {
        u32x4 w; w.x = cvtpk(p[8 * s + 0], p[8 * s + 1]); w.y = cvtpk(p[8 * s + 2], p[8 * s + 3]); w.z = cvtpk(p[8 * s + 4], p[8 * s + 5]); w.w = cvtpk(p[8 * s + 6], p[8 * s + 7]);
        const bf16x8 pf = __builtin_bit_cast(bf16x8, w);
#pragma unroll
        for (int db = 0; db < NDB; ++db) {
            const s16x4 lo = vtr(vp + (16 * s) * VSTR + 64 * db), hi = vtr(vp + (16 * s + 8) * VSTR + 64 * db);
            const bf16x8 vf = {lo[0], lo[1], lo[2], lo[3], hi[0], hi[1], hi[2], hi[3]};
            o[db] = __builtin_amdgcn_mfma_f32_32x32x16_bf16(vf, pf, o[db], 0, 0, 0);
        }
    }
}
template <int NDB>
__device__ __forceinline__ void sm_update(f32x16& s0, f32x16& s1, float& m, float& l, f32x16 (&o)[NDB]) {
    float pm = fmaxf(s0[0], s1[0]);
#pragma unroll
    for (int r = 1; r < 16; ++r) pm = fmaxf(pm, fmaxf(s0[r], s1[r]));
    pm = xmax32(pm);
    if (!__all(pm - m <= 8.0f)) {
        const float mn = fmaxf(m, pm); const float alpha = __builtin_amdgcn_exp2f(m - mn); m = mn; l *= alpha;
#pragma unroll
        for (int db = 0; db < NDB; ++db)
#pragma unroll
            for (int r = 0; r < 16; ++r) o[db][r] *= alpha;
    }
    float ps = 0.f;
#pragma unroll
    for (int r = 0; r < 16; ++r) { s0[r] = __builtin_amdgcn_exp2f(s0[r] - m); s1[r] = __builtin_amdgcn_exp2f(s1[r] - m); ps += s0[r] + s1[r]; }
    l += ps;
}
constexpr float QK_C = 0.125f * 1.4426950408889634f;

template <int NDB>
__device__ __forceinline__ void sm_update_raw(f32x16& s0, f32x16& s1, float& m, float& l, f32x16 (&o)[NDB]) {
    float pm = max3f(s0[0], s1[0], s0[1]);
    pm = max3f(pm, s1[1], s1[1]);
#pragma unroll
    for (int r = 2; r < 16; ++r) pm = max3f(pm, s0[r], s1[r]);
    pm = xmax32(pm) * QK_C;
    if (!__all(pm - m <= 8.0f)) {
        const float mn = fmaxf(m, pm); const float alpha = __builtin_amdgcn_exp2f(m - mn); m = mn; l *= alpha;
#pragma unroll
        for (int db = 0; db < NDB; ++db)
#pragma unroll
            for (int r = 0; r < 16; ++r) o[db][r] *= alpha;
    }
    const float nm = -m; float ps = 0.f;
#pragma unroll
    for (int r = 0; r < 16; ++r) { s0[r] = __builtin_amdgcn_exp2f(fmaf(s0[r], QK_C, nm)); s1[r] = __builtin_amdgcn_exp2f(fmaf(s1[r], QK_C, nm)); ps += s0[r] + s1[r]; }
    l += ps;
}

__device__ __forceinline__ void glds16(const void* gsrc, unsigned lds_dst) { unsigned keep;
    asm volatile("s_mov_b32 %0, m0\n\ts_mov_b32 m0, %2\n\ts_nop 0\n\tglobal_load_lds_dwordx4 %1, off\n\ts_mov_b32 m0, %0" : "=&s"(keep) : "v"(gsrc), "s"(lds_dst) : "memory"); }
#define FA_WAIT_BAR(N) asm volatile("s_waitcnt vmcnt(" #N ") lgkmcnt(0)\n\ts_barrier" ::: "memory")
__device__ __forceinline__ f32x16 qk32s(const LAS unsigned char* kslot, const int (&ko)[4], const bf16x8 (&qf)[4]) {
    f32x16 s = {0.f, 0.f, 0.f, 0.f, 0.f, 0.f, 0.f, 0.f, 0.f, 0.f, 0.f, 0.f, 0.f, 0.f, 0.f, 0.f};
#pragma unroll
    for (int ks = 0; ks < 4; ++ks) { const bf16x8 kf = *(const LAS bf16x8*)(kslot + ko[ks]); s = __builtin_amdgcn_mfma_f32_32x32x16_bf16(kf, qf[ks], s, 0, 0, 0); }
    return s;
}
__device__ __forceinline__ void pv32d(f32x16 (&o)[4], const LAS unsigned char* vp, const f32x16& p) {
#pragma unroll
    for (int s = 0; s < 2; ++s) {
        u32x4 w; w.x = cvtpk(p[8 * s + 0], p[8 * s + 1]); w.y = cvtpk(p[8 * s + 2], p[8 * s + 3]); w.z = cvtpk(p[8 * s + 4], p[8 * s + 5]); w.w = cvtpk(p[8 * s + 6], p[8 * s + 7]);
        const bf16x8 pf = __builtin_bit_cast(bf16x8, w);
#pragma unroll
        for (int db = 0; db < 4; ++db) {
            const s16x4 lo = vtr(vp + (16 * s) * 64 + 4096 * db), hi = vtr(vp + (16 * s + 8) * 64 + 4096 * db);
            const bf16x8 vf = {lo[0], lo[1], lo[2], lo[3], hi[0], hi[1], hi[2], hi[3]};
            o[db] = __builtin_amdgcn_mfma_f32_32x32x16_bf16(vf, pf, o[db], 0, 0, 0);
        }
    }
}
__device__ __forceinline__ void diff_unit(LAS unsigned char* lds, const bf16_t* Z, bf16_t* O, int b, int hd, int q0row, int nlat_tiles, float lam, float oscale, const float* subln, int tid) {
    constexpr int KSLOT = 16384, VRING = 4 * KSLOT;
    const int lane = tid & 63, w = __builtin_amdgcn_readfirstlane(tid >> 6), r32 = lane & 31, h = lane >> 5;
    const int comp = w & 1, qblk = w >> 1;
    const int kcol0 = 1792 + hd * 128, vcol0 = 2304 + hd * 128;
    const unsigned lds0 = (unsigned)(size_t)lds;
    long kg[2], vg[2];
#pragma unroll
    for (int i = 0; i < 2; ++i) {
        const int krow = 8 * w + 4 * i + (lane >> 4);
        kg[i] = ((long)krow * DIN + kcol0 + (((lane & 15) ^ (krow & 7)) * 8)) * 2;
        const int vkey = 32 * (w & 1) + 16 * i + (lane >> 2);
        vg[i] = ((long)vkey * DIN + vcol0 + 32 * (w >> 1) + 8 * (lane & 3)) * 2;
    }
    const unsigned kdst = lds0 + (unsigned)(2 * w) * 1024u, vdst = lds0 + VRING + (unsigned)(2 * w) * 1024u;
#define DIFF_TROW(t) ((t) < nlat_tiles ? (long)b * SEQ + 64 * (t) : (long)NLAT + b * CTXL + 64 * ((t) - nlat_tiles))
#define DIFF_DMA(t) do { const char* tb_ = (const char*)Z + DIFF_TROW(t) * (long)(DIN * 2); const unsigned sl_ = (unsigned)(((t) & 3) * KSLOT); \
        glds16(tb_ + kg[0], (unsigned)__builtin_amdgcn_readfirstlane(kdst + sl_)); glds16(tb_ + kg[1], (unsigned)__builtin_amdgcn_readfirstlane(kdst + sl_ + 1024u)); \
        glds16(tb_ + vg[0], (unsigned)__builtin_amdgcn_readfirstlane(vdst + sl_)); glds16(tb_ + vg[1], (unsigned)__builtin_amdgcn_readfirstlane(vdst + sl_ + 1024u)); } while (0)
    const int NT = nlat_tiles + 4;
    DIFF_DMA(0); DIFF_DMA(1); DIFF_DMA(2);
    bf16x8 qf[4];
    { const bf16_t* qp = Z + (size_t)(q0row + 32 * qblk + r32) * DIN + 1280 + hd * 128 + comp * 64 + 8 * h;
#pragma unroll
      for (int ks = 0; ks < 4; ++ks) qf[ks] = *(const bf16x8*)(qp + 16 * ks); }
    f32x16 o[4];
#pragma unroll
    for (int db = 0; db < 4; ++db)
#pragma unroll
        for (int r = 0; r < 16; ++r) o[db][r] = 0.f;
    float m = -1e30f, l = 0.f;
    int ko[4];
#pragma unroll
    for (int ks = 0; ks < 4; ++ks) ko[ks] = r32 * 256 + (((comp * 8 + 2 * ks + h) ^ (r32 & 7)) << 4);
    const int voff = VRING + (4 * h + ((lane & 15) >> 2)) * 64 + (16 * ((lane >> 4) & 1) + 4 * (lane & 3)) * 2;
    asm volatile("s_waitcnt vmcnt(0)" ::: "memory");
    FA_WAIT_BAR(0);
    for (int t = 0; t < NT; ++t) {
        if (t + 3 < NT) DIFF_DMA(t + 3);
        const LAS unsigned char* kslot = lds + (t & 3) * KSLOT;
        bf16x8 kf[8];
#pragma unroll
        for (int i = 0; i < 8; ++i) kf[i] = *(const LAS bf16x8*)(kslot + ko[i & 3] + (i >> 2) * 8192);
        const LAS unsigned char* vs = lds + voff + (t & 3) * KSLOT;
        s16x4 va[8], vb[8];
#define DIFF_VLD(dst, g) do { _Pragma("unroll") for (int db = 0; db < 4; ++db) { dst[2 * db] = vtr(vs + (16 * (g)) * 64 + 4096 * db); dst[2 * db + 1] = vtr(vs + (16 * (g) + 8) * 64 + 4096 * db); } } while (0)
        DIFF_VLD(va, 0);
        DIFF_VLD(vb, 1);
        __builtin_amdgcn_sched_barrier(0);
        f32x16 s0 = {0.f, 0.f, 0.f, 0.f, 0.f, 0.f, 0.f, 0.f, 0.f, 0.f, 0.f, 0.f, 0.f, 0.f, 0.f, 0.f}, s1 = s0;
#pragma unroll
        for (int ks = 0; ks < 4; ++ks) { s0 = __builtin_amdgcn_mfma_f32_32x32x16_bf16(kf[ks], qf[ks], s0, 0, 0, 0); s1 = __builtin_amdgcn_mfma_f32_32x32x16_bf16(kf[4 + ks], qf[ks], s1, 0, 0, 0); }
        __builtin_amdgcn_sched_barrier(0);
        sm_update_raw<4>(s0, s1, m, l, o);
        bf16x8 pf[4];
#pragma unroll
        for (int g = 0; g < 4; ++g) { const f32x16& p = (g < 2) ? s0 : s1; const int e = 8 * (g & 1);
            u32x4 wv; wv.x = cvtpk(p[e + 0], p[e + 1]); wv.y = cvtpk(p[e + 2], p[e + 3]); wv.z = cvtpk(p[e + 4], p[e + 5]); wv.w = cvtpk(p[e + 6], p[e + 7]); pf[g] = __builtin_bit_cast(bf16x8, wv); }
        __builtin_amdgcn_sched_barrier(0);
#define DIFF_PV(src, g) do { _Pragma("unroll") for (int db = 0; db < 4; ++db) { const bf16x8 vf = {src[2 * db][0], src[2 * db][1], src[2 * db][2], src[2 * db][3], src[2 * db + 1][0], src[2 * db + 1][1], src[2 * db + 1][2], src[2 * db + 1][3]}; \
            o[db] = __builtin_amdgcn_mfma_f32_32x32x16_bf16(vf, pf[g], o[db], 0, 0, 0); } } while (0)
        DIFF_PV(va, 0);  __builtin_amdgcn_sched_barrier(0);
        DIFF_VLD(va, 2); __builtin_amdgcn_sched_barrier(0);
        DIFF_PV(vb, 1);  __builtin_amdgcn_sched_barrier(0);
        DIFF_VLD(vb, 3); __builtin_amdgcn_sched_barrier(0);
        DIFF_PV(va, 2);  __builtin_amdgcn_sched_barrier(0);
        DIFF_PV(vb, 3);  __builtin_amdgcn_sched_barrier(0);
#undef DIFF_VLD
#undef DIFF_PV
        if (t + 3 < NT) FA_WAIT_BAR(8); else if (t + 2 < NT) FA_WAIT_BAR(4); else FA_WAIT_BAR(0);
    }
#undef DIFF_TROW
#undef DIFF_DMA
    int tid_e = tid; asm volatile("" : "+v"(tid_e));
    const int lane_e = tid_e & 63, r32e = lane_e & 31, he = lane_e >> 5;
    l = xsum32(l); const float inv = 1.0f / l;
    LAS float* ex = (LAS float*)lds + qblk * 4096;
    if (comp == 1) {
#pragma unroll
        for (int db = 0; db < 4; ++db)
#pragma unroll
            for (int r = 0; r < 16; ++r) ex[(db * 16 + r) * 64 + lane_e] = o[db][r] * inv;
    }
    __syncthreads();
    if (comp == 0) {
        float ss = 0.f;
#pragma unroll
        for (int db = 0; db < 4; ++db)
#pragma unroll
            for (int r = 0; r < 16; ++r) { const float v = o[db][r] * inv - lam * ex[(db * 16 + r) * 64 + lane_e]; o[db][r] = v; ss += v * v; }
        ss = xsum32(ss);
        const float rstd = rsqrtf(ss * (1.0f / 128.0f) + 1e-6f) * oscale;
        bf16_t* op = O + (size_t)(q0row + 32 * qblk + r32e) * DM + 512 + hd * 128 + 4 * he;
#pragma unroll
        for (int db = 0; db < 4; ++db)
#pragma unroll
            for (int i = 0; i < 4; ++i) {
                const f32x4 g = *(const f32x4*)(subln + 32 * db + 8 * i + 4 * he);
                u32x2 wv; wv.x = cvtpk(o[db][4 * i + 0] * rstd * g[0], o[db][4 * i + 1] * rstd * g[1]); wv.y = cvtpk(o[db][4 * i + 2] * rstd * g[2], o[db][4 * i + 3] * rstd * g[3]);
                *(u32x2*)(op + 32 * db + 8 * i) = wv;
            }
    }
    __syncthreads();
}

constexpr int NA_RPB_OFF = 49152;
__device__ __forceinline__ void na_unit(LAS unsigned char* lds, const bf16_t* Z, bf16_t* O, const float* rpb_h, int b, int hd, int r0, int ctxq, int tid) {
    using G = Geo<64, 64>;
    const int lane = tid & 63, w = __builtin_amdgcn_readfirstlane(tid >> 6), r32 = lane & 31, h = lane >> 5;
    const int gr = r0 + (w >> 1), hh = w & 1;
    const int kcol0 = 256 + hd * 64, vcol0 = 512 + hd * 64;
    const long qrow = ctxq ? (long)NLAT + b * CTXL + 32 * w + r32 : (long)b * SEQ + gr * 64 + 32 * hh + r32;
    LAS float* rpbL = (LAS float*)(lds + NA_RPB_OFF);
    if (tid < 465) rpbL[tid] = rpb_h[tid] * 1.4426950408889634f;
    bf16x8 qf[4];
    { const bf16_t* qp = Z + (size_t)qrow * DIN + hd * 64 + 8 * h;
#pragma unroll
      for (int ks = 0; ks < 4; ++ks) qf[ks] = *(const bf16x8*)(qp + 16 * ks); }
    f32x16 o[2];
#pragma unroll
    for (int db = 0; db < 2; ++db)
#pragma unroll
        for (int r = 0; r < 16; ++r) o[db][r] = 0.f;
    float m = -1e30f, l = 0.f;
    int kr_lo = r0 - 4; kr_lo = kr_lo < 0 ? 0 : (kr_lo > 120 ? 120 : kr_lo);
    int kr_hi = r0 + 3 - 4; kr_hi = (kr_hi < 0 ? 0 : (kr_hi > 120 ? 120 : kr_hi)) + 7;
    const int NT = ctxq ? 4 : 4 + (kr_hi - kr_lo + 1);
    int ks0 = gr - 4; ks0 = ks0 < 0 ? 0 : (ks0 > 120 ? 120 : ks0);
    const int qcol = 32 * hh + r32; int w0 = qcol - 8; w0 = w0 < 0 ? 0 : (w0 > 48 ? 48 : w0);
    const int koff = r32 * G::KSTR + 16 * h;
    const int voff = G::KBYTES + (4 * h + ((lane & 15) >> 2)) * G::VSTR + (16 * ((lane >> 4) & 1) + 4 * (lane & 3)) * 2;
    u32x4 st[G::NCH];
#define NA_TROW(t) ((t) < 4 ? (long)NLAT + b * CTXL + 64 * (t) : (long)b * SEQ + (kr_lo + (t) - 4) * 64)
    u32x4 stB[G::NCH];
    st_load<64, 64>(st, Z, NA_TROW(0), kcol0, vcol0, tid);
    st_store<64, 64>(lds, st, tid);
    st_load<64, 64>(st, Z, NA_TROW(1), kcol0, vcol0, tid);
    __syncthreads();
    for (int t0 = 0; t0 < NT; t0 += 2) {
#pragma unroll
    for (int u = 0; u < 2; ++u) {
        const int t = t0 + u;
        if (t < NT) {
        LAS unsigned char* cur = lds + (t & 1) * G::BUF; LAS unsigned char* nxt = lds + ((t + 1) & 1) * G::BUF;
        if (t + 2 < NT) { if (u == 0) st_load<64, 64>(stB, Z, NA_TROW(t + 2), kcol0, vcol0, tid); else st_load<64, 64>(st, Z, NA_TROW(t + 2), kcol0, vcol0, tid); }
        const int kr = kr_lo + t - 4;
        const bool active = (t < 4) || (kr >= ks0 && kr < ks0 + 8);
        if (active) {
            f32x16 s0 = qk32(cur + koff, qf), s1 = qk32(cur + koff + 32 * G::KSTR, qf);
            if (t < 4) {
#pragma unroll
                for (int r = 0; r < 16; ++r) { s0[r] *= QK_C; s1[r] *= QK_C; }
            } else {
                const LAS float* brow = rpbL + (kr - gr + 7) * 31;
                int hq = 4 * h - qcol + 15, hw = 4 * h - w0;
                asm volatile("" : "+v"(hq), "+v"(hw));
#pragma unroll
                for (int r = 0; r < 16; ++r) {
                    const int cr = (r & 3) + 8 * (r >> 2);
                    { const int d = cr + hq; const int dc = d < 0 ? 0 : (d > 30 ? 30 : d); const bool ok = (unsigned)(cr + hw) < 16u; const float bias = brow[dc]; s0[r] = ok ? fmaf(s0[r], QK_C, bias) : -1e30f; }
                    { const int d = cr + 32 + hq; const int dc = d < 0 ? 0 : (d > 30 ? 30 : d); const bool ok = (unsigned)(cr + 32 + hw) < 16u; const float bias = brow[dc]; s1[r] = ok ? fmaf(s1[r], QK_C, bias) : -1e30f; }
                }
            }
            sm_update<2>(s0, s1, m, l, o);
            pv32<2, G::VSTR>(o, cur + voff, s0);
            pv32<2, G::VSTR>(o, cur + voff + 32 * G::VSTR, s1);
        }
        if (t + 1 < NT) { if (u == 0) st_store<64, 64>(nxt, st, tid); else st_store<64, 64>(nxt, stB, tid); }
        __syncthreads();
        }
    }
    }
#undef NA_TROW
    l = xsum32(l); const float inv = 1.0f / l;
    bf16_t* op = O + (size_t)qrow * DM + hd * 64 + 4 * h;
#pragma unroll
    for (int db = 0; db < 2; ++db)
#pragma unroll
        for (int i = 0; i < 4; ++i) {
            u32x2 wv; wv.x = cvtpk(o[db][4 * i + 0] * inv, o[db][4 * i + 1] * inv); wv.y = cvtpk(o[db][4 * i + 2] * inv, o[db][4 * i + 3] * inv);
            *(u32x2*)(op + 32 * db + 8 * i) = wv;
        }
    __syncthreads();
}

__device__ __forceinline__ void gmlp_unit(LAS unsigned char* lds, const bf16_t* Z, bf16_t* O, const float* ws_g  , const float* bs_g  , const float* gn_g  , long row0, int g, int tid) {
    constexpr int STR = 272;
    LAS unsigned char* WsL = lds; LAS unsigned char* vnT = lds + 128 * STR;
    const int lane = tid & 63, w = __builtin_amdgcn_readfirstlane(tid >> 6), r32 = lane & 31, h = lane >> 5;
#pragma unroll
    for (int i = 0; i < 8; ++i) {
        const int c = tid + i * 512; const int p = c >> 5, q4 = c & 31;
        const f32x4 v = *(const f32x4*)(ws_g + p * 128 + q4 * 4);
        u32x2 wv; wv.x = cvtpk(v[0], v[1]); wv.y = cvtpk(v[2], v[3]);
        *(LAS u32x2*)(WsL + p * STR + q4 * 8) = wv;
    }
    {
        const int q = tid >> 2, part = tid & 3;
        const bf16_t* vp = Z + (size_t)(row0 + q) * DIN + 1024 + 64 * g + 16 * part;
        const u32x4 x0 = *(const u32x4*)vp, x1 = *(const u32x4*)(vp + 8);
        float f[16];
#pragma unroll
        for (int e = 0; e < 4; ++e) { f[2 * e] = __uint_as_float(x0[e] << 16); f[2 * e + 1] = __uint_as_float(x0[e] & 0xffff0000u); f[8 + 2 * e] = __uint_as_float(x1[e] << 16); f[8 + 2 * e + 1] = __uint_as_float(x1[e] & 0xffff0000u); }
        float ss = 0.f;
#pragma unroll
        for (int e = 0; e < 16; ++e) ss += f[e] * f[e];
        ss += lane_xor(ss, lane, 1); ss += lane_xor(ss, lane, 2);
        const float rstd = rsqrtf(ss * (1.0f / 64.0f) + 1e-6f);
#pragma unroll
        for (int e = 0; e < 16; ++e) {
            const int wc = 16 * part + e; const float y = f[e] * rstd * gn_g[wc];
            *(LAS unsigned short*)(vnT + wc * STR + q * 2) = (unsigned short)(cvtpk(y, 0.f) & 0xffffu);
        }
    }
    __syncthreads();
    const int pb = w >> 1, wb = w & 1;
    f32x16 acc = {0.f, 0.f, 0.f, 0.f, 0.f, 0.f, 0.f, 0.f, 0.f, 0.f, 0.f, 0.f, 0.f, 0.f, 0.f, 0.f};
#pragma unroll
    for (int ks = 0; ks < 8; ++ks) {
        const bf16x8 a = *(const LAS bf16x8*)(WsL + (32 * pb + r32) * STR + (16 * ks + 8 * h) * 2);
        const bf16x8 bq = *(const LAS bf16x8*)(vnT + (32 * wb + r32) * STR + (16 * ks + 8 * h) * 2);
        acc = __builtin_amdgcn_mfma_f32_32x32x16_bf16(a, bq, acc, 0, 0, 0);
    }
    const int wcol = 32 * wb + r32;
#pragma unroll
    for (int r = 0; r < 16; ++r) {
        const int p = 32 * pb + (r & 3) + 8 * (r >> 2) + 4 * h;
        const float s = acc[r] + bs_g[p];
        const float uval = bf2f(Z[(size_t)(row0 + p) * DIN + 768 + 64 * g + wcol]);
        O[(size_t)(row0 + p) * DM + 256 + 64 * g + wcol] = (unsigned short)(cvtpk(uval * s, 0.f) & 0xffffu);
    }
    __syncthreads();
}
}

typedef float f32x4 __attribute__((ext_vector_type(4)));
typedef unsigned v4u __attribute__((ext_vector_type(4)));
typedef unsigned v2u __attribute__((ext_vector_type(2)));
#ifndef DBG_SKIP
#define DBG_SKIP 0
#endif
#ifndef REP_MASK
#define REP_MASK 7
#endif
#ifndef REP_MIX
#define REP_MIX 1
#endif
#ifndef DBG_SKIP_LAYERS
#define DBG_SKIP_LAYERS 3
#endif
#ifndef DBG_FILL
#define DBG_FILL 1
#endif
#ifndef DBG_CHECK
#define DBG_CHECK 0
#endif
#ifndef DBG_STOP
#define DBG_STOP 17
#endif
#ifndef DBG_IDENT
#define DBG_IDENT 0
#endif
#ifndef MIX_MASK
#define MIX_MASK 0xff
#endif
#ifndef PH_MASK
#define PH_MASK 0xff
#endif
constexpr int NSTEPS = 22;

struct Args { const float* in[24]; float* out; unsigned char* ws; int ph_lo, ph_hi; };
enum { I_X = 0, I_C, I_CTX, I_CCTX, I_WADA, I_BADA, I_F1W1, I_F1W3, I_F1W2, I_WIN, I_WOUT, I_RPB, I_GMWS, I_GMBS, I_GMNORM, I_LQ1, I_LK1, I_LQ2, I_LK2, I_SUBLN, I_F2W1, I_F2W3, I_F2W2, I_FNORM };

__device__ __forceinline__ void transpose_item(const float* W, int K, int N, bf16_t* WT, int dst_row0, int k0, int n0, LAS float* scr, int lane) {
#pragma unroll 8
    for (int i = 0; i < 32; ++i) { const int kk = 2 * i + (lane >> 5); scr[kk * 33 + (lane & 31)] = W[(size_t)(k0 + kk) * N + n0 + (lane & 31)]; }
    asm volatile("s_waitcnt lgkmcnt(0)" ::: "memory");
    const int c = lane & 7;
#pragma unroll
    for (int j = 0; j < 4; ++j) { const int n = (lane >> 3) + 8 * j; const LAS float* s = scr + (8 * c) * 33 + n;
        v4u o; o.x = fa::cvtpk(s[0 * 33], s[1 * 33]); o.y = fa::cvtpk(s[2 * 33], s[3 * 33]); o.z = fa::cvtpk(s[4 * 33], s[5 * 33]); o.w = fa::cvtpk(s[6 * 33], s[7 * 33]);
        *(v4u*)(WT + (size_t)(dst_row0 + n) * K + k0 + 8 * c) = o; }
    asm volatile("s_waitcnt lgkmcnt(0)" ::: "memory");
}

__device__ __forceinline__ void prologue(const Args& a, LAS unsigned char* lds, int tid, int G) {
    const int lane = tid & 63, wave = __builtin_amdgcn_readfirstlane(tid >> 6);
    float* mod = (float*)(a.ws + WS_MOD);
    if ((int)blockIdx.x < 288) {
        LAS float* sv = (LAS float*)lds; LAS float* red = sv + 5120;
        for (int i = tid; i < 5120; i += 512) { const int ci = i >> 10, k = i & 1023; const float c = ci < 4 ? a.in[I_C][ci * 1024 + k] : a.in[I_CCTX][k]; sv[i] = c / (1.0f + __expf(-c)); }
        __syncthreads();
        for (int it = blockIdx.x; it < 288; it += G) {
            const int l = it / 144, j0 = (it % 144) * 64;
            const float* W = a.in[I_WADA] + (size_t)l * 1024 * NADA + j0 + lane;
            float a0 = 0.f, a1 = 0.f, a2 = 0.f, a3 = 0.f, a4 = 0.f;
#pragma unroll 16
            for (int kk = 0; kk < 128; ++kk) { const int k = wave * 128 + kk; const float wv = W[(size_t)k * NADA];
                a0 += sv[k] * wv; a1 += sv[1024 + k] * wv; a2 += sv[2048 + k] * wv; a3 += sv[3072 + k] * wv; a4 += sv[4096 + k] * wv; }
            red[(wave * 5 + 0) * 64 + lane] = a0; red[(wave * 5 + 1) * 64 + lane] = a1; red[(wave * 5 + 2) * 64 + lane] = a2; red[(wave * 5 + 3) * 64 + lane] = a3; red[(wave * 5 + 4) * 64 + lane] = a4;
            __syncthreads();
            if (tid < 320) { const int i = tid >> 6, ln = tid & 63; float s = 0.f;
#pragma unroll
                for (int ww = 0; ww < 8; ++ww) s += red[(ww * 5 + i) * 64 + ln];
                mod[(size_t)(l * 5 + i) * NADA + j0 + ln] = s + a.in[I_BADA][l * NADA + j0 + ln]; }
            __syncthreads();
        }
    }
    __syncthreads();
    LAS float* scr = (LAS float*)(lds + wave * 16384);
    const int gw = blockIdx.x * 8 + wave, NGW = G * 8;
    constexpr int I_UP = 16 * 88, I_DN = 44 * 32, I_INP = 16 * 88, I_OUTP = 16 * 32;
    constexpr int PER_LAYER = 2 * I_UP + I_DN + I_INP + I_OUTP + 2 * I_UP + I_DN;
    for (int it = gw; it < 2 * PER_LAYER; it += NGW) {
        const int l = it / PER_LAYER; int r = it % PER_LAYER;
        unsigned char* wl = a.ws + WS_W + (size_t)l * WS_WLAYER;
        int which = 0;
        if (r < 2 * I_UP) which = 0; else { r -= 2 * I_UP; if (r < I_DN) which = 1; else { r -= I_DN; if (r < I_INP) which = 2; else { r -= I_INP; if (r < I_OUTP) which = 3; else { r -= I_OUTP; if (r < 2 * I_UP) which = 4; else { r -= 2 * I_UP; which = 5; } } } } }
        if (which == 0 || which == 4) {
            const int bj = r / I_UP; const int rr = r % I_UP; const int kb = rr / 88, nb = rr % 88; const int n0 = 32 * nb;
            const float* W = (which == 0 ? (bj ? a.in[I_F1W3] : a.in[I_F1W1]) : (bj ? a.in[I_F2W3] : a.in[I_F2W1])) + (size_t)l * 1024 * DFF;
            bf16_t* WT = (bf16_t*)(wl + (which == 0 ? WO_UP1 : WO_UP2));
            transpose_item(W, 1024, DFF, WT, 256 * (n0 / 128) + 128 * bj + (n0 % 128), 64 * kb, n0, scr, lane);
        } else if (which == 1 || which == 5) {
            const int kb = r / 32, nb = r % 32;
            const float* W = (which == 1 ? a.in[I_F1W2] : a.in[I_F2W2]) + (size_t)l * DFF * 1024;
            bf16_t* WT = (bf16_t*)(wl + (which == 1 ? WO_DN1 : WO_DN2));
            transpose_item(W, DFF, 1024, WT, 32 * nb, 64 * kb, 32 * nb, scr, lane);
        } else if (which == 2) {
            const int kb = r / 88, nb = r % 88; const int n0 = 32 * nb; const int pn = n0 / 256, rem = n0 % 256; const int comp = rem / 64, bj = (rem % 64) / 32;
            const float* W = a.in[I_WIN] + (size_t)l * 1024 * DIN;
            transpose_item(W, 1024, DIN, (bf16_t*)(wl + WO_IN), 256 * pn + 128 * bj + 32 * comp, 64 * kb, n0, scr, lane);
        } else {
            const int kb = r / 32, nb = r % 32;
            const float* W = a.in[I_WOUT] + (size_t)l * 1024 * 1024;
            transpose_item(W, 1024, 1024, (bf16_t*)(wl + WO_OUT), 32 * nb, 64 * kb, 32 * nb, scr, lane);
        }
    }
}

__device__ __forceinline__ void modulate_phase(const float* srcL, const float* srcC, bf16_t* H, const float* modl, int si, int nrows, int tid, int G) {
    const int lane = tid & 63, wave = tid >> 6; const int gw = blockIdx.x * 8 + wave, NGW = G * 8;
    for (int row = gw; row < nrows; row += NGW) {
        const bool lat = row < NLAT;
        const f32x4* xr = (const f32x4*)(lat ? srcL + (size_t)row * DM : srcC + (size_t)(row - NLAT) * DM) + lane;
        const float* sh = modl + (size_t)(lat ? (row >> 13) : 4) * NADA + si * DM;
        f32x4 v[4]; float ss = 0.f;
#pragma unroll
        for (int j = 0; j < 4; ++j) { v[j] = xr[64 * j]; ss += (v[j].x * v[j].x + v[j].y * v[j].y) + (v[j].z * v[j].z + v[j].w * v[j].w); }
        ss = fa::wave_sum(ss, lane);
        const float rstd = rsqrtf(ss * (1.0f / DM) + 1e-6f);
        v2u* o8 = (v2u*)(H + (size_t)row * DM) + lane;
#pragma unroll
        for (int j = 0; j < 4; ++j) {
            const f32x4 h4 = ((const f32x4*)sh)[lane + 64 * j], s4 = ((const f32x4*)(sh + DM))[lane + 64 * j];
            const f32x4 y = v[j] * rstd * (s4 + 1.0f) + h4;
            v2u wv; wv.x = fa::cvtpk(y.x, y.y); wv.y = fa::cvtpk(y.z, y.w); o8[64 * j] = wv;
        }
    }
}
__device__ __forceinline__ void final_norm_phase(const float* Xs, float* X, const float* gain, int tid, int G) {
    const int lane = tid & 63, wave = tid >> 6; const int gw = blockIdx.x * 8 + wave, NGW = G * 8;
    for (int row = gw; row < NLAT; row += NGW) {
        f32x4* xr = (f32x4*)(X + (size_t)row * DM) + lane; const f32x4* xs = (const f32x4*)(Xs + (size_t)row * DM) + lane;
        f32x4 v[4]; float ss = 0.f;
#pragma unroll
        for (int j = 0; j < 4; ++j) { v[j] = xs[64 * j]; ss += (v[j].x * v[j].x + v[j].y * v[j].y) + (v[j].z * v[j].z + v[j].w * v[j].w); }
        ss = fa::wave_sum(ss, lane);
        const float rstd = rsqrtf(ss * (1.0f / DM) + 1e-6f);
#pragma unroll
        for (int j = 0; j < 4; ++j) { const f32x4 g = ((const f32x4*)gain)[lane + 64 * j]; xr[64 * j] = v[j] * rstd * g; }
    }
}

__device__ __forceinline__ void mix_phase(const Args& a, LAS unsigned char* lds, int l, int tid, int G, const int umask) {
    const bf16_t* Z = (const bf16_t*)(a.ws + WS_G); bf16_t* O = (bf16_t*)(a.ws + WS_O);
    const int lane = tid & 63;
    const float linit = (l == 0) ? 0.2f : 0.35550906759f;
    float lam;
    { const float d1 = fa::wave_sum(a.in[I_LQ1][l * 64 + lane] * a.in[I_LK1][l * 64 + lane], lane); const float d2 = fa::wave_sum(a.in[I_LQ2][l * 64 + lane] * a.in[I_LK2][l * 64 + lane], lane);
      lam = __expf(d1) - __expf(d2) + linit; }
    const float* subln = a.in[I_SUBLN] + l * 128;
    const int n_diff = 1024, n_na = 512, n_gm = (l == 0) ? 1056 : 1024, n_nac = (l == 0) ? 16 : 0, n_dc = (l == 0) ? 32 : 0;
    const int total = n_diff + n_na + n_gm + n_nac + n_dc;
    const int tid_m = tid;
    for (int it = blockIdx.x; it < total; it += G) {
        int tid = tid_m; asm volatile("" : "+v"(tid));
        int r = it;
        const bool is_dl = r < n_diff, is_dc = r >= n_diff + n_na + n_gm + n_nac;
        const bool is_nl = !is_dl && r < n_diff + n_na, is_nc = !is_dc && r >= n_diff + n_na + n_gm;
        if (is_dl || is_dc) {
            int b, hd, q0row, nlat;
            if (is_dl) { const int blk = r & 255, k = r >> 8; const int xcd = blk & 7, slot = blk >> 3; const int jj = k * 32 + slot; const int bh = 2 * xcd + (jj >> 6), qb = jj & 63;
                b = bh >> 2; hd = bh & 3; q0row = b * SEQ + qb * 128; nlat = 128; }
            else { const int rr = r - (n_diff + n_na + n_gm + n_nac); b = rr >> 3; hd = (rr >> 1) & 3; q0row = NLAT + b * CTXL + (rr & 1) * 128; nlat = 0; }
            if (umask & 1) fa::diff_unit(lds, Z, O, b, hd, q0row, nlat, lam, 1.0f - linit, subln, tid);
        } else if (is_nl || is_nc) {
            int b, hd, r0, ctxq;
            if (is_nl) { const int rr = r - n_diff; b = rr >> 7; hd = (rr >> 5) & 3; r0 = 4 * (rr & 31); ctxq = 0; }
            else { const int rr = r - (n_diff + n_na + n_gm); b = rr >> 2; hd = rr & 3; r0 = 0; ctxq = 1; }
            if (umask & 2) fa::na_unit(lds, Z, O, a.in[I_RPB] + (size_t)(l * 4 + hd) * 465, b, hd, r0, ctxq, tid);
        } else {
            const int rr = r - (n_diff + n_na); const int chunk = rr >> 2, g = rr & 3;
            const long row0 = chunk < 256 ? (long)chunk * 128 : (long)NLAT + (chunk - 256) * 128;
            if (umask & 4) fa::gmlp_unit(lds, Z, O, a.in[I_GMWS] + (size_t)(l * 4 + g) * 16384, a.in[I_GMBS] + (l * 4 + g) * 128, a.in[I_GMNORM] + (l * 4 + g) * 64, row0, g, tid);
        }
    }
}


#if DBG_CHECK
constexpr size_t WS_DBG = 5 * MiB, WS_XC2 = 404 * MiB;
__device__ __forceinline__ float dbg_bf(const bf16_t* p, size_t i) { return __uint_as_float(((unsigned)p[i]) << 16); }
__device__ __forceinline__ unsigned dbg_hash(unsigned x) { x ^= x >> 16; x *= 0x7feb352du; x ^= x >> 15; x *= 0x846ca68bu; x ^= x >> 16; return x; }
__device__ __forceinline__ bool dbg_bad(float got, float ref, float atol = 0.03f) { return !(fabsf(got - ref) <= atol + 0.03f * fabsf(ref)); }
__device__ __forceinline__ float dbg_block_sum(float v, LAS float* red, int tid) {
    v = fa::wave_sum(v, tid & 63); __syncthreads(); if ((tid & 63) == 0) red[tid >> 6] = v; __syncthreads();
    float s = 0.f; for (int i = 0; i < 8; ++i) s += red[i]; __syncthreads(); return s;
}
__device__ __forceinline__ float dbg_block_max(float v, LAS float* red, int tid) {
    for (int o = 1; o < 64; o <<= 1) v = fmaxf(v, __shfl_xor(v, o));
    __syncthreads(); if ((tid & 63) == 0) red[tid >> 6] = v; __syncthreads();
    float s = red[0]; for (int i = 1; i < 8; ++i) s = fmaxf(s, red[i]); __syncthreads(); return s;
}
template <class KR, class BI>
__device__ __forceinline__ void dbg_attn(const bf16_t* Z, long qrow, int qcol, int kcol, int vcol, int dv, int nk, KR krow, BI bias, LAS float* sc, LAS float* outv, LAS float* red, int tid) {
    float lm = -3e38f;
    for (int i = tid; i < nk; i += 512) { const long kr = krow(i); float s = 0.f; for (int d = 0; d < 64; ++d) s += dbg_bf(Z, (size_t)qrow * DIN + qcol + d) * dbg_bf(Z, (size_t)kr * DIN + kcol + d); s = s * 0.125f + bias(i); sc[i] = s; lm = fmaxf(lm, s); }
    const float m = dbg_block_max(lm, red, tid);
    float ls = 0.f;
    for (int i = tid; i < nk; i += 512) { const float p = __expf(sc[i] - m); sc[i] = p; ls += p; }
    const float tot = dbg_block_sum(ls, red, tid);
    const int d = tid & 127, part = tid >> 7;
    float acc = 0.f;
    if (d < dv) for (int i = part; i < nk; i += 4) acc += sc[i] * dbg_bf(Z, (size_t)krow(i) * DIN + vcol + d);
    __syncthreads();
    LAS float* tmp = red + 16;
    tmp[part * 128 + d] = acc; __syncthreads();
    if (tid < dv) outv[tid] = (tmp[tid] + tmp[128 + tid] + tmp[256 + tid] + tmp[384 + tid]) / tot;
    __syncthreads();
}
__device__ __forceinline__ void dbg_check(const Args& a, LAS unsigned char* lds, int tid, int G, const int l, const int sres) {
    unsigned* flags = (unsigned*)(a.ws + WS_DBG);
    const bf16_t* H = (const bf16_t*)(a.ws + WS_H); const bf16_t* Z = (const bf16_t*)(a.ws + WS_G); const bf16_t* O = (const bf16_t*)(a.ws + WS_O);
    const float* mod = (const float*)(a.ws + WS_MOD) + (size_t)l * 5 * NADA;
    const int blk = blockIdx.x;
    if (blk == 7 && tid == 0) atomicOr(flags, 1u);
    if (sres == 6) {
    {
        const int rows[8] = {0, 77, 8192, 20000, 32767, 32768, 33000, 33791};
        bool bad = false;
        for (int sidx = tid; sidx < 8 * 70; sidx += 512) {
            int ri = sidx / 70; const int row = (int)(dbg_hash(blk * 8 + ri + 1000) % (unsigned)MT); const int col = ((sidx % 70) * 37 + blk) % DIN;
            const bool rope = (col >= 1280 && col < 2304 && row < NLAT);
            const int c1 = rope ? (col & ~63) + (col & 31) : col; const int c2 = c1 + 32;
            float x1 = 0.f, x2 = 0.f;
            for (int k = 0; k < 1024; ++k) { const float hv = dbg_bf(H, (size_t)row * DM + k); x1 += hv * a.in[I_WIN][(size_t)l * 1024 * DIN + (size_t)k * DIN + c1]; if (rope) x2 += hv * a.in[I_WIN][(size_t)l * 1024 * DIN + (size_t)k * DIN + c2]; }
            float ref = x1;
            if (col >= 768 && col < 1280) ref = 0.5f * x1 * (1.0f + erff(x1 * 0.70710678f));
            if (rope) { const int t = row & 8191; const int j = col & 31; const float pos = (j < 16) ? (float)(t >> 6) : (float)(t & 63); const float fr = __builtin_amdgcn_exp2f(-(float)(j & 15) * 0.8304820237218406f);
                const float ang = pos * fr; const float c = __cosf(ang), s = __sinf(ang); ref = ((col & 63) < 32) ? x1 * c - x2 * s : x1 * s + x2 * c; }
            if (dbg_bad(dbg_bf(Z, (size_t)row * DIN + col), ref)) bad = true;
        }
        (void)rows;
        if (bad) atomicOr(flags, 2u);
    }
    {
        bool bad = false;
        if (tid < 144) {
            const int ci = tid / 36, g = (tid / 9) & 3, pi = (tid / 3) % 3, wi = tid % 3;
            const long row0 = 128L * (dbg_hash(blk * 4 + ci + 77) % (l == 0 ? 264u : 256u)); const int p = (int)(dbg_hash(blk * 16 + pi + 5) % 128u); const int w = (int)(dbg_hash(blk * 16 + wi + 11) % 64u);
            float s = 0.f;
            for (int q = 0; q < 128; ++q) { float ss = 0.f; for (int e = 0; e < 64; ++e) { const float v = dbg_bf(Z, (size_t)(row0 + q) * DIN + 1024 + 64 * g + e); ss += v * v; }
                const float vn = dbg_bf(Z, (size_t)(row0 + q) * DIN + 1024 + 64 * g + w) * rsqrtf(ss / 64.f + 1e-6f) * a.in[I_GMNORM][(l * 4 + g) * 64 + w];
                s += a.in[I_GMWS][(size_t)(l * 4 + g) * 16384 + p * 128 + q] * vn; }
            s += a.in[I_GMBS][(l * 4 + g) * 128 + p];
            const float ref = dbg_bf(Z, (size_t)(row0 + p) * DIN + 768 + 64 * g + w) * s;
            if (dbg_bad(dbg_bf(O, (size_t)(row0 + p) * DM + 256 + 64 * g + w), ref)) bad = true;
        }
        if (bad) atomicOr(flags, 4u);
    }
    for (int pass = 2; pass <= 3; ++pass) {
        LAS float* sc = (LAS float*)lds; LAS float* outv = sc + 8448; LAS float* outv2 = outv + 128; LAS float* red = outv2 + 128;
        bool bad = false;
        for (int smp = 0; smp < 2; ++smp) {
            if (pass == 2) {
                const unsigned hh_ = dbg_hash(blk * 2 + smp + 333); const int b = hh_ & 3, hd = (hh_ >> 2) & 3; const int t = (hh_ >> 4) & 8191; const bool cq = false;
                const int gr = t >> 6, gc = t & 63; int ks = gr - 4; ks = ks < 0 ? 0 : (ks > 120 ? 120 : ks); int w0 = gc - 8; w0 = w0 < 0 ? 0 : (w0 > 48 ? 48 : w0);
                const long qrow = (long)b * SEQ + t; const float* rp = a.in[I_RPB] + (size_t)(l * 4 + hd) * 465;
                auto krow = [=](int i) -> long { return i < 128 ? (long)b * SEQ + (ks + (i >> 4)) * 64 + w0 + (i & 15) : (long)NLAT + b * CTXL + (i - 128); };
                auto bias = [=](int i) -> float { return i < 128 ? rp[(ks + (i >> 4) - gr + 7) * 31 + (w0 + (i & 15) - gc + 15)] : 0.f; };
                dbg_attn(Z, qrow, hd * 64, 256 + hd * 64, 512 + hd * 64, 64, 384, krow, bias, sc, outv, red, tid);
                if (tid < 64 && dbg_bad(dbg_bf(O, (size_t)qrow * DM + hd * 64 + tid), outv[tid], 0.01f)) bad = true;
                (void)cq;
            } else {
                const unsigned hh_ = dbg_hash(blk * 2 + smp + 999); const int b = hh_ & 3, hd = (hh_ >> 2) & 3; const bool cq = ((hh_ >> 20) & 15) == 0 && (l == 0);
                const long qrow = cq ? (long)NLAT + b * CTXL + ((hh_ >> 4) & 255) : (long)b * SEQ + ((hh_ >> 4) & 8191);
                const int nk = cq ? 256 : 8448;
                auto krow = [=](int i) -> long { return cq ? (long)NLAT + b * CTXL + i : (i < 8192 ? (long)b * SEQ + i : (long)NLAT + b * CTXL + (i - 8192)); };
                auto bias = [=](int i) -> float { return 0.f; };
                dbg_attn(Z, qrow, 1280 + hd * 128, 1792 + hd * 128, 2304 + hd * 128, 128, nk, krow, bias, sc, outv, red, tid);
                dbg_attn(Z, qrow, 1280 + hd * 128 + 64, 1792 + hd * 128 + 64, 2304 + hd * 128, 128, nk, krow, bias, sc, outv2, red, tid);
                float d1 = 0.f, d2 = 0.f; for (int e = 0; e < 64; ++e) { d1 += a.in[I_LQ1][l * 64 + e] * a.in[I_LK1][l * 64 + e]; d2 += a.in[I_LQ2][l * 64 + e] * a.in[I_LK2][l * 64 + e]; }
                const float linit = l == 0 ? 0.2f : 0.35550906759f; const float lam = __expf(d1) - __expf(d2) + linit;
                float ss = 0.f; for (int e = 0; e < 128; ++e) { const float v = outv[e] - lam * outv2[e]; ss += v * v; }
                if (tid < 128) { const float ref = (outv[tid] - lam * outv2[tid]) * rsqrtf(ss / 128.f + 1e-6f) * a.in[I_SUBLN][l * 128 + tid] * (1.0f - linit);
                    if (dbg_bad(dbg_bf(O, (size_t)qrow * DM + 512 + hd * 128 + tid), ref, 0.05f)) bad = true; }
                __syncthreads();
            }
        }
        if (bad) atomicOr(flags, pass == 2 ? 8u : 16u);
    }
    }
    if (sres != 6) {
        const bf16_t* Gb = (const bf16_t*)(a.ws + WS_G);
        const float* w1 = (sres == 2 ? a.in[I_F1W1] : a.in[I_F2W1]) + (size_t)l * 1024 * DFF; const float* w3 = (sres == 2 ? a.in[I_F1W3] : a.in[I_F2W3]) + (size_t)l * 1024 * DFF;
        bool bad = false;
        for (int sidx = tid; sidx < 6 * 60; sidx += 512) {
            const int ri = sidx / 60; const int row = (int)(dbg_hash(blk * 8 + ri + 31337) % (unsigned)NLAT); const int col = ((sidx % 60) * 47 + blk * 11) % DFF;
            float x1 = 0.f, x3 = 0.f;
            for (int k = 0; k < 1024; ++k) { const float hv = dbg_bf(H, (size_t)row * DM + k); x1 += hv * w1[(size_t)k * DFF + col]; x3 += hv * w3[(size_t)k * DFF + col]; }
            const float ref = x1 / (1.0f + __expf(-x1)) * x3;
            if (dbg_bad(dbg_bf(Gb, (size_t)row * DFF + col), ref)) bad = true;
        }
        if (bad) atomicOr(flags, 2u);
    }
    {
        const float* saved = (const float*)(a.ws + WS_DBG + 65536);
        const bf16_t* A = sres == 6 ? O : (const bf16_t*)(a.ws + WS_G); const int K = sres == 6 ? DM : DFF;
        const float* W = sres == 6 ? a.in[I_WOUT] + (size_t)l * DM * DM : (sres == 2 ? a.in[I_F1W2] : a.in[I_F2W2]) + (size_t)l * DFF * DM;
        const int gidx = sres == 2 ? 2 : (sres == 6 ? 5 : 8); const float gs = sres == 6 ? 1.0f : 0.5f;
        bool bad = false;
        for (int sidx = tid; sidx < 64; sidx += 512) {
            const int ri = blk; const int row = (int)(dbg_hash(blk + 4242) % (unsigned)NLAT); const int col = (sidx * 16 + blk) % DM;
            float acc = 0.f; for (int k = 0; k < K; ++k) acc += dbg_bf(A, (size_t)row * K + k) * W[(size_t)k * DM + col];
            const float ref = saved[ri * DM + col] + gs * mod[(size_t)(row >> 13) * NADA + gidx * DM + col] * acc;
            if (dbg_bad(a.out[(size_t)row * DM + col], ref)) bad = true;
        }
        if (bad) atomicOr(flags, 32u);
    }
    if (sres != 6 && blk == 8) {
        const float* modall = (const float*)(a.ws + WS_MOD);
        bool bad = false;
        if (tid < 100) { const int ll = tid & 1, i = (tid >> 1) % 5, j = (tid * 977) % NADA;
            float acc = 0.f; for (int k = 0; k < 1024; ++k) { const float c = i < 4 ? a.in[I_C][i * 1024 + k] : a.in[I_CCTX][k]; acc += c / (1.0f + __expf(-c)) * a.in[I_WADA][(size_t)ll * 1024 * NADA + (size_t)k * NADA + j]; }
            acc += a.in[I_BADA][ll * NADA + j];
            if (dbg_bad(modall[(size_t)(ll * 5 + i) * NADA + j], acc)) bad = true; }
        if (bad) atomicOr(flags, 4u);
    }
    if (sres == 2 && l == 0 && blk == 9) {
        bool bad = false;
        if (tid < 5 * 40) { const int ri = tid / 40; const int row = ri == 0 ? 0 : ri == 1 ? 12345 : ri == 2 ? 32767 : ri == 3 ? 32768 : 33791; const int col = ((tid % 40) * 53) % DM;
            const float* xr = row < NLAT ? a.in[I_X] + (size_t)row * DM : a.in[I_CTX] + (size_t)(row - NLAT) * DM; const int bi = row < NLAT ? row >> 13 : 4;
            float ss = 0.f; for (int k = 0; k < DM; ++k) ss += xr[k] * xr[k];
            const float ref = xr[col] * rsqrtf(ss / DM + 1e-6f) * (1.0f + mod[(size_t)bi * NADA + DM + col]) + mod[(size_t)bi * NADA + col];
            if (dbg_bad(dbg_bf(H, (size_t)row * DM + col), ref)) bad = true; }
        if (bad) atomicOr(flags, 8u);
    }
    if (sres == 6) {
        const float* saved = (const float*)(a.ws + WS_DBG + 65536);
        bool bad = false;
        if (tid < 40) { const int ri = blk; const int row = (int)(dbg_hash(blk + 4242) % (unsigned)NLAT); const int col = ((tid % 40) * 53 + blk) % DM; const int bi = row >> 13;
            float ss = 0.f; for (int k = 0; k < DM; ++k) ss += saved[ri * DM + k] * saved[ri * DM + k];
            const float ref = saved[ri * DM + col] * rsqrtf(ss / DM + 1e-6f) * (1.0f + mod[(size_t)bi * NADA + 4 * DM + col]) + mod[(size_t)bi * NADA + 3 * DM + col];
            if (dbg_bad(dbg_bf(H, (size_t)row * DM + col), ref)) bad = true; }
        if (bad) atomicOr(flags, 64u);
    }
    if (sres == 6 && l == 0 && blk == 10) {
        LAS float* sc = (LAS float*)lds; LAS float* outv = sc + 8448; LAS float* red = outv + 256;
        const int b = 2, hd = 1; const long qrow = (long)NLAT + b * CTXL + 200;
        auto krow = [=](int i) -> long { return (long)NLAT + b * CTXL + i; };
        auto bias = [=](int i) -> float { return 0.f; };
        dbg_attn(Z, qrow, hd * 64, 256 + hd * 64, 512 + hd * 64, 64, 256, krow, bias, sc, outv, red, tid);
        bool bad = false;
        if (tid < 64 && dbg_bad(dbg_bf(O, (size_t)qrow * DM + hd * 64 + tid), outv[tid])) bad = true;
        if (bad) atomicOr(flags, 8u);
    }
}
__device__ __forceinline__ void dbg_save(const Args& a, const float* src, int tid) {
    float* saved = (float*)(a.ws + WS_DBG + 65536);
    { const int row = (int)(dbg_hash(blockIdx.x + 4242) % (unsigned)NLAT); for (int i = tid; i < DM; i += 512) saved[blockIdx.x * DM + i] = src[(size_t)row * DM + i]; }
}
__device__ __forceinline__ void dbg_save2(const Args& a, const float* src, int tid) {
    float* saved = (float*)(a.ws + WS_DBG + 2 * MiB);
    { const int row = (int)(dbg_hash(blockIdx.x + 777) % (unsigned)NLAT); for (int i = tid; i < DM; i += 512) saved[blockIdx.x * DM + i] = src[(size_t)row * DM + i]; }
}
__device__ __forceinline__ void dbg_check2(const Args& a, int tid) {
    const float* saved = (const float*)(a.ws + WS_DBG + 2 * MiB) + blockIdx.x * DM; unsigned* flags = (unsigned*)(a.ws + WS_DBG);
    const int row = (int)(dbg_hash(blockIdx.x + 777) % (unsigned)NLAT);
    float ss = 0.f; for (int k = 0; k < DM; ++k) ss += saved[k] * saved[k];
    bool bad = false;
    for (int c = tid; c < DM; c += 512) { const float ref = saved[c] * rsqrtf(ss / DM + 1e-6f) * a.in[I_FNORM][c]; if (dbg_bad(a.out[(size_t)row * DM + c], ref, 0.01f)) bad = true; }
    if (bad) atomicOr(flags, 64u);
}
__device__ __forceinline__ void dbg_fill(const Args& a, int tid, int G) {
    const unsigned mask = *(const volatile unsigned*)(a.ws + WS_DBG);
    const float c = __builtin_amdgcn_exp2f(0.5f * (float)(mask + 1));
    for (size_t i = (size_t)blockIdx.x * 512 + tid; i < (size_t)NLAT * DM; i += (size_t)G * 512) a.out[i] = c;
}
#endif

#define XB_TMO      128
#define XB_XCNT(j)  (256  + 64 * (j))
#define XB_XSUB(j)  (1280 + 64 * (j))
#define XB_XGEN(j)  (2304 + 64 * (j))
#define XB_TOP      3328
#define XB_TOPGEN   3392
#define XCD_BAR_WORDS 3456
#define XB_SPIN_CAP (1u << 24)

__device__ __forceinline__ unsigned xb_ld(unsigned* p)              { return __hip_atomic_load(p, __ATOMIC_RELAXED, __HIP_MEMORY_SCOPE_AGENT); }
__device__ __forceinline__ unsigned xb_add(unsigned* p, unsigned v) { return __hip_atomic_fetch_add(p, v, __ATOMIC_RELAXED, __HIP_MEMORY_SCOPE_AGENT); }
__device__ __forceinline__ unsigned xb_xcc_id() { return (unsigned)__builtin_amdgcn_s_getreg((3 << 11) | 20) & 0xFu; }
#define XB_SPIN(cond, bar) do { unsigned _sp = 0; while (cond) { __builtin_amdgcn_s_sleep(1); \
    if ((++_sp & 255u) == 0u) { if (xb_ld(&(bar)[XB_TMO])) break; if (_sp > XB_SPIN_CAP) { atomicAdd(&(bar)[XB_TMO], 1u); break; } } } } while (0)

struct XcdBarrier {
    unsigned* bar; unsigned x;
    volatile LAS unsigned* st;
};

__device__ __forceinline__ XcdBarrier xcd_barrier_post(unsigned* bar, volatile LAS unsigned* st) {
    XcdBarrier b; b.bar = bar; b.x = xb_xcc_id(); b.st = st;
    if (threadIdx.x == 0) (void)xb_add(&bar[XB_XCNT(b.x)], 1u);
    return b;
}
__device__ __forceinline__ void xcd_barrier_complete(unsigned* bar, unsigned x, unsigned& nloc, unsigned& nx) {
    const unsigned G = gridDim.x * gridDim.y * gridDim.z;
    unsigned sum, cnt, mine, sp = 0u;
    for (;;) {
        sum = 0u; cnt = 0u; mine = 0u;
#pragma unroll
        for (unsigned j = 0; j < 16; ++j) { const unsigned c = xb_ld(&bar[XB_XCNT(j)]); sum += c; cnt += (c > 0u) ? 1u : 0u; mine = (j == x) ? c : mine; }
        if (sum == G) break;
        __builtin_amdgcn_s_sleep(1);
        if ((++sp & 255u) == 0u) { if (xb_ld(&bar[XB_TMO])) break; if (sp > XB_SPIN_CAP) { atomicAdd(&bar[XB_TMO], 1u); break; } }
    }
    nloc = mine > 0u ? mine : 1u; nx = cnt > 0u ? cnt : 1u;
}

__device__ __forceinline__ void xcd_barrier(const XcdBarrier& b) {
    asm volatile("s_waitcnt vmcnt(0)" ::: "memory");
    __syncthreads();
    if (threadIdx.x == 0) {
        unsigned* bar = b.bar;
        __builtin_amdgcn_s_waitcnt(0);
        unsigned nloc = b.st[0], nx = b.st[1];
        if (nloc == 0u) { xcd_barrier_complete(bar, b.x, nloc, nx); b.st[0] = nloc; b.st[1] = nx; }
        const unsigned old = xb_add(&bar[XB_XSUB(b.x)], 1u);
        const unsigned gen = old / nloc;
        if (old + 1u == (gen + 1u) * nloc) {
            __builtin_amdgcn_fence(__ATOMIC_RELEASE, "agent");
            asm volatile("s_waitcnt vmcnt(0)" ::: "memory");
            const unsigned og = xb_add(&bar[XB_TOP], 1u);
            const unsigned tg = og / nx;
            if (og + 1u == (tg + 1u) * nx) xb_add(&bar[XB_TOPGEN], 1u);
            else XB_SPIN(xb_ld(&bar[XB_TOPGEN]) == tg, bar);
            __builtin_amdgcn_fence(__ATOMIC_ACQUIRE, "agent");
            xb_add(&bar[XB_XGEN(b.x)], 1u);
            asm volatile("s_waitcnt vmcnt(0)" ::: "memory");
        } else {
            XB_SPIN(xb_ld(&bar[XB_XGEN(b.x)]) == gen, bar);
            __builtin_amdgcn_fence(__ATOMIC_ACQUIRE, "agent");
            asm volatile("s_waitcnt vmcnt(0)" ::: "memory");
        }
    }
    __syncthreads();
}

constexpr size_t WS_BAR = 6 * MiB;
__global__ void __launch_bounds__(512, 2) mega_fwd(Args a) {
    extern __shared__ __attribute__((aligned(16))) unsigned char lds_raw[];
    LAS unsigned char* lds = (LAS unsigned char*)lds_raw;
    const int tid0 = threadIdx.x, G = gridDim.x;
    volatile LAS unsigned* MISC = (volatile LAS unsigned*)(lds + 131072 + 512);
    if (tid0 < 2) MISC[tid0] = 0u;
    __syncthreads();
    unsigned* barw = (unsigned*)(a.ws + WS_BAR);
    XcdBarrier xbar; xbar.bar = barw; xbar.x = 0; xbar.st = MISC;
    float* XL = a.out; float* XC = (float*)(a.ws + WS_XC);
    bf16_t* H = (bf16_t*)(a.ws + WS_H); bf16_t* O = (bf16_t*)(a.ws + WS_O); bf16_t* GB = (bf16_t*)(a.ws + WS_G);
    const float* mod = (const float*)(a.ws + WS_MOD);
    for (int step = a.ph_lo; step < a.ph_hi; ++step) {
        int tid = tid0; asm volatile("" : "+v"(tid));
#if DBG_CHECK
        if (step == 100) { dbg_check(a, lds, tid, G, (DBG_STOP - 1) / 10, (DBG_STOP - 1) % 10); continue; }
        if (step == 103) { dbg_save2(a, XL, tid); continue; }
        if (step == 104) { dbg_check2(a, tid); continue; }
        if (step == 102) { dbg_save(a, (DBG_STOP <= 3) ? a.in[I_X] : XL, tid); continue; }
        if (step == 101) { if (DBG_FILL) dbg_fill(a, tid, G); continue; }
        if (step == 0 && blockIdx.x == 0 && tid == 0) *(unsigned*)(a.ws + 5 * MiB) = 0u;
#endif
        if (step == 0) { if (blockIdx.x == 0) for (int i = tid; i < XCD_BAR_WORDS; i += 512) barw[i] = 0u; if (PH_MASK & 1) prologue(a, lds, tid, G); }
        else if (step == NSTEPS - 1) { if (PH_MASK & 2) final_norm_phase(DBG_IDENT ? a.in[I_X] : XL, XL, a.in[I_FNORM], tid, G); }
        else {
            const int l = (step - 1) / 10, s = (step - 1) % 10;
            if (((DBG_SKIP >> s) & 1) && ((DBG_SKIP_LAYERS >> l) & 1)) continue;
            const float* modl = mod + (size_t)l * 5 * NADA;
            const unsigned char* wl = a.ws + WS_W + (size_t)l * WS_WLAYER;
            const bool first = (l == 0 && s <= 2);
            const float* srcL = first ? a.in[I_X] : XL; const float* srcC = first ? a.in[I_CTX] : XC;
            const bool lat_only = (l == 1 && s >= 6);
            const int Mrows = lat_only ? NLAT : MT;
            if (s == 0 || s == 3 || s == 7) { if (PH_MASK & 4)
                modulate_phase(srcL, srcC, H, modl, s == 0 ? 0 : (s == 3 ? 3 : 6), Mrows, tid, G);
            } else if (s == 1 || s == 8) { if (PH_MASK & 8) {
                pg8::Gemm g{H, (const bf16_t*)(wl + (s == 1 ? WO_UP1 : WO_UP2)), Mrows, 2 * DFF, DM}; pg8::StaticOrder S; S.init(Mrows, 2 * DFF, G, (int)blockIdx.x);
                pg8::EpiSwiGLU E{GB, DFF};
                pg8::gemm_phase<pg8::EpiSwiGLU, pg8::StaticOrder, true, true>(lds, g, S, E); }
            } else if (s == 2 || s == 6 || s == 9) { if (PH_MASK & 16) {
                const bf16_t* A = (s == 6) ? O : GB; const int K = (s == 6) ? DM : DFF;
                const bf16_t* Bt = (const bf16_t*)(wl + (s == 2 ? WO_DN1 : (s == 6 ? WO_OUT : WO_DN2)));
                pg8::Gemm g{A, Bt, Mrows, DM, K}; pg8::StaticOrder S; S.init(Mrows, DM, G, (int)blockIdx.x);
                pg8::EpiResid E{srcL, srcC, XL, XC, modl, s == 2 ? 2 : (s == 6 ? 5 : 8), s == 6 ? 1.0f : 0.5f};
                pg8::gemm_phase<pg8::EpiResid, pg8::StaticOrder, true, true>(lds, g, S, E); }
            } else if (s == 4) { if (PH_MASK & 32) {
                pg8::Gemm g{H, (const bf16_t*)(wl + WO_IN), MT, DIN, DM}; pg8::StaticOrder S; S.init(MT, DIN, G, (int)blockIdx.x);
                pg8::EpiInProj E{GB};
                pg8::gemm_phase<pg8::EpiInProj, pg8::StaticOrder, true, true>(lds, g, S, E); }
            } else {
                if (PH_MASK & 64) for (int rep_ = 0; rep_ < REP_MIX; ++rep_) mix_phase(a, lds, l, tid, G, rep_ == 0 ? 7 : REP_MASK);
            }
        }
        if (step + 1 < a.ph_hi) {
            if (step == a.ph_lo) { cg::this_grid().sync(); xbar = xcd_barrier_post(barw, MISC); }
            else xcd_barrier(xbar);
        }
    }
}

extern "C" void kernel_launch(void* const* d_in, const int* in_sizes, int n_in, void* d_out, int out_size, void* d_ws, size_t ws_size, hipStream_t stream) {
    static int grid = 0;
    if (grid == 0) {
        if (n_in != 24 || in_sizes[0] != NLAT * DM || out_size != NLAT * DM || ws_size < WS_END) { fprintf(stderr, "kernel_launch: unexpected shapes (n_in %d, in0 %d, out %d, ws %zu)\n", n_in, n_in > 0 ? in_sizes[0] : -1, out_size, ws_size); grid = -1; return; }
        int dev = 0, cus = 0, per_cu = 0;
        if (hipGetDevice(&dev) != hipSuccess || hipDeviceGetAttribute(&cus, hipDeviceAttributeMultiprocessorCount, dev) != hipSuccess) { grid = -1; return; }
        if (hipFuncSetAttribute((const void*)mega_fwd, hipFuncAttributeMaxDynamicSharedMemorySize, LDS_BYTES) != hipSuccess) { fprintf(stderr, "kernel_launch: hipFuncSetAttribute failed\n"); grid = -1; return; }
        if (hipOccupancyMaxActiveBlocksPerMultiprocessor(&per_cu, (const void*)mega_fwd, 512, LDS_BYTES) != hipSuccess || per_cu < 1) { fprintf(stderr, "kernel_launch: occupancy query gave %d\n", per_cu); per_cu = 1; }
        (void)hipGetLastError();
        grid = cus * (per_cu > 1 ? 1 : per_cu);
    }
    if (grid < 0) return;
    Args a{};
    for (int i = 0; i < 24; ++i) a.in[i] = (const float*)d_in[i];
    a.out = (float*)d_out; a.ws = (unsigned char*)d_ws;
#if ONE_LAUNCH
    a.ph_lo = 0; a.ph_hi = NSTEPS;
    void* args[] = {&a};
    hipError_t e = hipLaunchCooperativeKernel((const void*)mega_fwd, dim3(grid), dim3(512), args, LDS_BYTES, stream);
    if (e != hipSuccess) fprintf(stderr, "cooperative launch failed: %s (grid %d)\n", hipGetErrorString(e), grid);
#else
#if DBG_CHECK
    for (int st = 0; st < DBG_STOP + (DBG_STOP == 20 ? 7 : 4); ++st) { const int k_ = st - DBG_STOP; const int sid = st < DBG_STOP ? st : (k_ == 0 ? 102 : (k_ == 1 ? DBG_STOP : (k_ == 2 ? 100 : (DBG_STOP != 20 ? 101 : (k_ == 3 ? 103 : (k_ == 4 ? 21 : (k_ == 5 ? 104 : 101))))))); a.ph_lo = sid; a.ph_hi = sid + 1; hipLaunchKernelGGL(mega_fwd, dim3(grid), dim3(512), LDS_BYTES, stream, a); }
#else
    for (int st = 0; st < NSTEPS; ++st) { a.ph_lo = st; a.ph_hi = st + 1; hipLaunchKernelGGL(mega_fwd, dim3(grid), dim3(512), LDS_BYTES, stream, a); }
#endif
#endif
}
```

```cpp
#include <hip/hip_runtime.h>
#include <hip/hip_cooperative_groups.h>
#include <cstdio>
#include <cstdint>
namespace cg = cooperative_groups;
#ifndef ONE_LAUNCH
#define ONE_LAUNCH 1
#endif
namespace pg8 {
#define PG8_LAS __attribute__((address_space(3)))
typedef unsigned short bf16_t;
typedef short bf16x8 __attribute__((ext_vector_type(8)));
typedef float f32x4 __attribute__((ext_vector_type(4)));
typedef unsigned u32x4 __attribute__((ext_vector_type(4)));
constexpr int BM = 256, BK = 64, HALF = 128, HTB = HALF * BK * 2  , STAGE_BYTES = 8 * HTB, NXCD = 8, WGM = 8;

__host__ __device__ __forceinline__ int lds_byte(int r, int c) { const int st = (r >> 4) * 2 + (c >> 5), rr = r & 15, cc = c & 31, ob = rr * 64 + cc * 2; return st * 1024 + (ob ^ (((ob >> 9) & 1) << 5)); }
__host__ __device__ __forceinline__ void stage_rc(int b, int& R, int& C) { const int st = b / 1024, sb = b % 1024, swz = sb ^ (((sb >> 9) & 1) << 5); R = (st >> 1) * 16 + swz / 64; C = (st & 1) * 32 + (swz % 64) / 2; }
__host__ __device__ __forceinline__ int perm32(int rho) { const int n = rho >> 4, i = rho & 15; return 8 * (i >> 2) + 4 * n + (i & 3); }

struct Unit { int pm, pn; };
struct Gemm { const bf16_t* A; const bf16_t* Bt; int M, N, K; };

struct StaticOrder {
    int nM, nN, nwg, G, c;
    __host__ __device__ void init(int M, int N, int G_, int c_) { nM = M / BM; nN = N / BM; nwg = nM * nN; G = G_; c = c_; }
    __host__ __device__ bool next(int i, Unit& u) const {
        const long L = (long)i * G + c; if (L >= nwg) return false;
        int wgid = (int)L; { const int q = nwg / NXCD, r = nwg % NXCD, xcd = wgid % NXCD, off = wgid / NXCD; wgid = (xcd < r ? xcd * (q + 1) : r * (q + 1) + (xcd - r) * q) + off; }
        const int nig = WGM * nN, gid = wgid / nig, fm = gid * WGM, gsz = (nM - fm) < WGM ? (nM - fm) : WGM;
        u.pm = fm + ((wgid % nig) % gsz); u.pn = (wgid % nig) / gsz; return true;
    }
    __device__ __forceinline__ void a_ready(const Unit&) const {}
    __device__ __forceinline__ void done(const Unit&) const {}
};

__device__ __forceinline__ unsigned cvt_pk_bf16(float lo, float hi) { unsigned r; asm volatile("v_cvt_pk_bf16_f32 %0, %1, %2" : "=v"(r) : "v"(lo), "v"(hi)); return r; }
typedef float f32x2 __attribute__((ext_vector_type(2)));
__device__ __forceinline__ f32x2 gelu_pk(f32x2 v) {
    const f32x2 av = __builtin_elementwise_abs(v), d = av * 0.2316418882f + 1.0f;
    f32x2 t; t.x = __builtin_amdgcn_rcpf(d.x); t.y = __builtin_amdgcn_rcpf(d.y);
    f32x2 q = t * 0.5307027145f + (-0.7265760135f); q = q * t + 0.7107068705f; q = q * t + (-0.142248368f); q = q * t + 0.127414796f; q = q * t;
    const f32x2 s = (v * v) * (-0.72134752044f);
    f32x2 e; e.x = __builtin_amdgcn_exp2f(s.x); e.y = __builtin_amdgcn_exp2f(s.y);
    const f32x2 m = v * (q * e), r = v - m;
    f32x2 o; o.x = v.x < 0.f ? m.x : r.x; o.y = v.y < 0.f ? m.y : r.y; return o;
}


constexpr int NLAT_ROWS = 32768, DMODEL = 1024, NADA_COLS = 9216;
__device__ __forceinline__ float silu_f(float a) { return a * __builtin_amdgcn_rcpf(1.0f + __builtin_amdgcn_exp2f(-1.4426950408889634f * a)); }

struct EpiSwiGLU {
    static constexpr bool PERM = true, AFTER_DRAIN = false;
    bf16_t* G; int ldc;
    __device__ __forceinline__ void operator()(const f32x4 (&acc)[2][2][4][2], const Unit& u, int wr, int wc, int fr, int fq) const {
        const int row0 = u.pm * BM + wr * 64 + fr; const int col0 = u.pn * HALF + wc * 32 + 8 * fq;
#pragma unroll
        for (int ai = 0; ai < 2; ++ai)
#pragma unroll
            for (int m = 0; m < 4; ++m) {
                bf16_t* rowp = G + (size_t)(row0 + ai * HALF + m * 16) * ldc + col0;
                const f32x4 a0 = acc[ai][0][m][0], a1 = acc[ai][0][m][1], b0 = acc[ai][1][m][0], b1 = acc[ai][1][m][1];
                u32x4 w;
                w.x = cvt_pk_bf16(silu_f(a0[0]) * b0[0], silu_f(a0[1]) * b0[1]); w.y = cvt_pk_bf16(silu_f(a0[2]) * b0[2], silu_f(a0[3]) * b0[3]);
                w.z = cvt_pk_bf16(silu_f(a1[0]) * b1[0], silu_f(a1[1]) * b1[1]); w.w = cvt_pk_bf16(silu_f(a1[2]) * b1[2], silu_f(a1[3]) * b1[3]);
                *(u32x4*)rowp = w;
            }
    }
};

struct EpiInProj {
    static constexpr bool PERM = true, AFTER_DRAIN = false;
    bf16_t* Z;
    __device__ __forceinline__ void operator()(const f32x4 (&acc)[2][2][4][2], const Unit& u, int wr, int wc, int fr, int fq) const {
        const int pn = u.pn; const bool do_gelu = (pn == 3 || pn == 4); const bool do_rope = (pn >= 5 && pn <= 8 && u.pm < 128);
        const int row0 = u.pm * BM + wr * 64 + fr; const int colb = pn * 256 + 64 * wc + 8 * fq;
        float fq8[8];
#pragma unroll
        for (int i = 0; i < 8; ++i) fq8[i] = __builtin_amdgcn_exp2f(-(float)(8 * (fq & 1) + i) * 0.8304820237218406f);
#pragma unroll
        for (int ai = 0; ai < 2; ++ai)
#pragma unroll
            for (int m = 0; m < 4; ++m) {
                const int row = row0 + ai * HALF + m * 16;
                f32x4 a0 = acc[ai][0][m][0], a1 = acc[ai][0][m][1], b0 = acc[ai][1][m][0], b1 = acc[ai][1][m][1];
                if (do_gelu) {
                    f32x2 t;
                    t = gelu_pk((f32x2){a0[0], a0[1]}); a0[0] = t.x; a0[1] = t.y; t = gelu_pk((f32x2){a0[2], a0[3]}); a0[2] = t.x; a0[3] = t.y;
                    t = gelu_pk((f32x2){a1[0], a1[1]}); a1[0] = t.x; a1[1] = t.y; t = gelu_pk((f32x2){a1[2], a1[3]}); a1[2] = t.x; a1[3] = t.y;
                    t = gelu_pk((f32x2){b0[0], b0[1]}); b0[0] = t.x; b0[1] = t.y; t = gelu_pk((f32x2){b0[2], b0[3]}); b0[2] = t.x; b0[3] = t.y;
                    t = gelu_pk((f32x2){b1[0], b1[1]}); b1[0] = t.x; b1[1] = t.y; t = gelu_pk((f32x2){b1[2], b1[3]}); b1[2] = t.x; b1[3] = t.y;
                } else if (do_rope) {
                    const int t = row & 8191; const float fpos = (float)((fq < 2) ? (t >> 6) : (t & 63));
#pragma unroll
                    for (int e = 0; e < 4; ++e) {
                        { const float ang = fpos * fq8[e]; const float c = __cosf(ang), s = __sinf(ang); const float x1 = a0[e], x2 = b0[e]; a0[e] = x1 * c - x2 * s; b0[e] = x1 * s + x2 * c; }
                        { const float ang = fpos * fq8[4 + e]; const float c = __cosf(ang), s = __sinf(ang); const float x1 = a1[e], x2 = b1[e]; a1[e] = x1 * c - x2 * s; b1[e] = x1 * s + x2 * c; }
                    }
                }
                bf16_t* rowp = Z + (size_t)row * 2816 + colb;
                u32x4 w; w.x = cvt_pk_bf16(a0[0], a0[1]); w.y = cvt_pk_bf16(a0[2], a0[3]); w.z = cvt_pk_bf16(a1[0], a1[1]); w.w = cvt_pk_bf16(a1[2], a1[3]);
                *(u32x4*)rowp = w;
                u32x4 v; v.x = cvt_pk_bf16(b0[0], b0[1]); v.y = cvt_pk_bf16(b0[2], b0[3]); v.z = cvt_pk_bf16(b1[0], b1[1]); v.w = cvt_pk_bf16(b1[2], b1[3]);
                *(u32x4*)(rowp + 32) = v;
            }
    }
};

struct EpiResid {
    static constexpr bool PERM = true, AFTER_DRAIN = false;
    const float* srcL; const float* srcC; float* dstL; float* dstC; const float* modl; int gidx; float gscale;
    __device__ __forceinline__ void operator()(const f32x4 (&acc)[2][2][4][2], const Unit& u, int wr, int wc, int fr, int fq) const {
        const bool lat = u.pm < 128;
        const float* sb = lat ? srcL + (size_t)u.pm * BM * DMODEL : srcC + (size_t)(u.pm - 128) * BM * DMODEL;
        float* db = lat ? dstL + (size_t)u.pm * BM * DMODEL : dstC + (size_t)(u.pm - 128) * BM * DMODEL;
        const float* gate = modl + (size_t)(lat ? (u.pm >> 5) : 4) * NADA_COLS + gidx * DMODEL;
        const int col0 = u.pn * BM + wc * 32 + 8 * fq;
        f32x4 g4[2][2];
#pragma unroll
        for (int bj = 0; bj < 2; ++bj)
#pragma unroll
            for (int n = 0; n < 2; ++n) g4[bj][n] = *(const f32x4*)(gate + col0 + bj * HALF + n * 4) * gscale;
#pragma unroll
        for (int ai = 0; ai < 2; ++ai)
#pragma unroll
            for (int m = 0; m < 4; ++m) {
                const size_t off = (size_t)(ai * HALF + wr * 64 + m * 16 + fr) * DMODEL + col0;
#pragma unroll
                for (int bj = 0; bj < 2; ++bj)
#pragma unroll
                    for (int n = 0; n < 2; ++n) {
                        const f32x4 bs = *(const f32x4*)(sb + off + bj * HALF + n * 4);
                        *(f32x4*)(db + off + bj * HALF + n * 4) = bs + g4[bj][n] * acc[ai][bj][m][n];
                    }
                if (m & 1) asm volatile("" ::: "memory");
            }
    }
};
template <class Epi, class Sched, bool ALIGN_EPI = false, bool SP2 = false>
__device__ __forceinline__ void gemm_phase(PG8_LAS unsigned char* lds, const Gemm g, const Sched& S, const Epi& E) {
    int tid_ = threadIdx.x; asm volatile("" : "+v"(tid_));
    const int tid = tid_, wid = __builtin_amdgcn_readfirstlane(tid >> 6), lane = tid & 63, wr = wid >> 2, wc = wid & 3, fr = lane & 15, fq = lane >> 4;
    const int K = g.K, nt = K / BK;
    unsigned voffA[2], voffB[2];
#pragma unroll
    for (int i = 0; i < 2; ++i) { int R, C; stage_rc(tid * 16 + i * 8192, R, C); const int Rb = Epi::PERM ? ((R & ~31) + perm32(R & 31)) : R;
        voffA[i] = (unsigned)(R * K + C) * 2u; voffB[i] = (unsigned)(Rb * K + C) * 2u; }
    const size_t kstep = (size_t)(BK * 2);
    const size_t hstep = (size_t)HALF * K * 2;
    const size_t tstep = 2 * hstep;
    const unsigned ldsw = (unsigned)wid * 1024u;
    const int aoff = lds_byte(wr * 64 + fr, fq * 8), boff = lds_byte(wc * 32 + fr, fq * 8);
#define PG8_SA(b, h) (((b) * 2 + (h)) * HTB)
#define PG8_SB(b, h) ((4 + (b) * 2 + (h)) * HTB)
#define PG8_STAGE(bufoff, gbase, voff) do { _Pragma("unroll") for (int _i = 0; _i < 2; ++_i) \
        __builtin_amdgcn_global_load_lds((const unsigned*)((const char*)(gbase) + (voff)[_i]), (PG8_LAS unsigned*)(lds + (bufoff) + ldsw + _i * 8192), 16, 0, 0); } while (0)
#define PG8_LDA(dst, b, h) do { _Pragma("unroll") for (int m = 0; m < 4; ++m) _Pragma("unroll") for (int k = 0; k < 2; ++k) dst[m][k] = *(const PG8_LAS bf16x8*)(lds + PG8_SA(b, h) + aoff + m * 2048 + k * 1024); } while (0)
#define PG8_LDB(dst, b, h) do { _Pragma("unroll") for (int n = 0; n < 2; ++n) _Pragma("unroll") for (int k = 0; k < 2; ++k) dst[n][k] = *(const PG8_LAS bf16x8*)(lds + PG8_SB(b, h) + boff + n * 2048 + k * 1024); } while (0)
#define PG8_MMA(ai, bj, At, Bt) do { __builtin_amdgcn_s_setprio(1); _Pragma("unroll") for (int m = 0; m < 4; ++m) _Pragma("unroll") for (int n = 0; n < 2; ++n) _Pragma("unroll") for (int k = 0; k < 2; ++k) \
        acc[ai][bj][m][n] = __builtin_amdgcn_mfma_f32_16x16x32_bf16(Bt[n][k], At[m][k], acc[ai][bj][m][n], 0, 0, 0); __builtin_amdgcn_s_setprio(0); } while (0)
#define PG8_WAIT_V(n) asm volatile("s_waitcnt vmcnt(" #n ")" ::: "memory")
#define PG8_WAIT_L(n) asm volatile("s_waitcnt lgkmcnt(" #n ")" ::: "memory")
#define PG8_BAR __builtin_amdgcn_s_barrier()
#define PG8_SCHED __builtin_amdgcn_sched_barrier(0)
    Unit cur, nxt; int ui = 0;
    if (!S.next(0, cur)) return;
    f32x4 acc[2][2][4][2];
#pragma unroll
    for (int a = 0; a < 2; ++a)
#pragma unroll
        for (int b = 0; b < 2; ++b)
#pragma unroll
            for (int m = 0; m < 4; ++m)
#pragma unroll
                for (int n = 0; n < 2; ++n) acc[a][b][m][n] = (f32x4){0.f, 0.f, 0.f, 0.f};
    bf16x8 At[4][2], B0[2][2], B1[2][2];
    const char* cA = (const char*)g.A + (size_t)cur.pm * tstep; const char* cB = (const char*)g.Bt + (size_t)cur.pn * tstep;
    S.a_ready(cur);
    if constexpr (SP2) {
        PG8_STAGE(PG8_SB(0, 0), cB, voffB); PG8_STAGE(PG8_SB(0, 1), cB + hstep, voffB); PG8_STAGE(PG8_SA(0, 0), cA, voffA); PG8_STAGE(PG8_SA(0, 1), cA + hstep, voffA);
        if (wr == 1) PG8_BAR;
        PG8_WAIT_V(2); PG8_BAR;
        PG8_STAGE(PG8_SB(1, 0), cB + kstep, voffB); PG8_STAGE(PG8_SA(1, 0), cA + kstep, voffA); PG8_STAGE(PG8_SB(1, 1), cB + hstep + kstep, voffB);
        PG8_WAIT_V(6); PG8_BAR;
    } else {
        PG8_STAGE(PG8_SB(0, 0), cB, voffB); PG8_STAGE(PG8_SA(0, 0), cA, voffA); PG8_STAGE(PG8_SB(0, 1), cB + hstep, voffB); PG8_STAGE(PG8_SA(0, 1), cA + hstep, voffA);
        if (wr == 1) PG8_BAR;
        PG8_WAIT_V(4); PG8_BAR;
        PG8_STAGE(PG8_SB(1, 0), cB + kstep, voffB); PG8_STAGE(PG8_SA(1, 0), cA + kstep, voffA); PG8_STAGE(PG8_SB(1, 1), cB + hstep + kstep, voffB);
        PG8_WAIT_V(6); PG8_BAR;
    }
    for (;;) {
        const bool has_next = S.next(ui + 1, nxt);
        const char* nA = has_next ? (const char*)g.A + (size_t)nxt.pm * tstep : cA; const char* nB = has_next ? (const char*)g.Bt + (size_t)nxt.pn * tstep : cB;
        for (int t = 0; t < nt; t += 2) {
            const bool last = (t == nt - 2);
            const char* a1 = cA + (size_t)(t + 1) * kstep;
            const char* a2 = last ? nA : cA + (size_t)(t + 2) * kstep; const char* b2 = last ? nB : cB + (size_t)(t + 2) * kstep;
            const char* a3 = a2 + kstep; const char* b3 = b2 + kstep;
            if (last && has_next) S.a_ready(nxt);
            if constexpr (SP2) {
            PG8_LDB(B0, 0, 0); PG8_LDB(B1, 0, 1); PG8_SCHED; PG8_LDA(At, 0, 0); PG8_STAGE(PG8_SA(1, 1), a1 + hstep, voffA);
            PG8_WAIT_V(8); PG8_WAIT_L(0); PG8_BAR; PG8_MMA(0, 0, At, B0); PG8_MMA(0, 1, At, B1); PG8_BAR; PG8_SCHED;
            PG8_LDA(At, 0, 1); PG8_STAGE(PG8_SB(0, 0), b2, voffB); PG8_STAGE(PG8_SB(0, 1), b2 + hstep, voffB); PG8_STAGE(PG8_SA(0, 0), a2, voffA);
            PG8_WAIT_V(8); PG8_WAIT_L(0); PG8_BAR; PG8_MMA(1, 0, At, B0); PG8_MMA(1, 1, At, B1); PG8_BAR; PG8_SCHED;
            PG8_LDB(B0, 1, 0); PG8_LDB(B1, 1, 1); PG8_SCHED; PG8_LDA(At, 1, 0); PG8_STAGE(PG8_SA(0, 1), a2 + hstep, voffA);
            PG8_WAIT_V(8); PG8_WAIT_L(0); PG8_BAR; PG8_MMA(0, 0, At, B0); PG8_MMA(0, 1, At, B1); PG8_BAR; PG8_SCHED;
            PG8_LDA(At, 1, 1); PG8_STAGE(PG8_SB(1, 0), b3, voffB); PG8_STAGE(PG8_SB(1, 1), b3 + hstep, voffB); PG8_STAGE(PG8_SA(1, 0), a3, voffA);
            PG8_WAIT_V(8); PG8_WAIT_L(0); PG8_BAR; PG8_MMA(1, 0, At, B0); PG8_MMA(1, 1, At, B1); PG8_BAR; PG8_SCHED;
            } else {
            PG8_LDB(B0, 0, 0); PG8_SCHED; PG8_LDA(At, 0, 0); PG8_STAGE(PG8_SA(1, 1), a1 + hstep, voffA);
            PG8_WAIT_L(8); PG8_BAR; PG8_WAIT_L(0); PG8_MMA(0, 0, At, B0); PG8_BAR; PG8_SCHED;
            PG8_LDB(B1, 0, 1); PG8_STAGE(PG8_SB(0, 0), b2, voffB);
            PG8_BAR; PG8_WAIT_L(0); PG8_MMA(0, 1, At, B1); PG8_BAR;
            PG8_LDA(At, 0, 1); PG8_STAGE(PG8_SA(0, 0), a2, voffA);
            PG8_BAR; PG8_WAIT_L(0); PG8_MMA(1, 0, At, B0); PG8_BAR; PG8_SCHED;
            PG8_STAGE(PG8_SB(0, 1), b2 + hstep, voffB);
            PG8_WAIT_V(6); PG8_BAR; PG8_MMA(1, 1, At, B1); PG8_BAR;
            PG8_LDB(B0, 1, 0); PG8_SCHED; PG8_LDA(At, 1, 0); PG8_STAGE(PG8_SA(0, 1), a2 + hstep, voffA);
            PG8_WAIT_L(8); PG8_BAR; PG8_WAIT_L(0); PG8_MMA(0, 0, At, B0); PG8_BAR; PG8_SCHED;
            PG8_LDB(B1, 1, 1); PG8_STAGE(PG8_SB(1, 0), b3, voffB);
            PG8_BAR; PG8_WAIT_L(0); PG8_MMA(0, 1, At, B1); PG8_BAR;
            PG8_LDA(At, 1, 1); PG8_STAGE(PG8_SA(1, 0), a3, voffA);
            PG8_BAR; PG8_WAIT_L(0); PG8_MMA(1, 0, At, B0); PG8_BAR; PG8_SCHED;
            PG8_STAGE(PG8_SB(1, 1), b3 + hstep, voffB);
            PG8_WAIT_V(6); PG8_BAR; PG8_MMA(1, 1, At, B1); PG8_BAR;
            }
        }
        if constexpr (ALIGN_EPI) { if (wr == 0) PG8_BAR; }
        if constexpr (!Epi::AFTER_DRAIN) { E(acc, cur, wr, wc, fr, fq); S.done(cur); }
        if (!has_next) break;
#pragma unroll
        for (int a = 0; a < 2; ++a)
#pragma unroll
            for (int b = 0; b < 2; ++b)
#pragma unroll
                for (int m = 0; m < 4; ++m)
#pragma unroll
                    for (int n = 0; n < 2; ++n) acc[a][b][m][n] = (f32x4){0.f, 0.f, 0.f, 0.f};
        cur = nxt; cA = nA; cB = nB; ++ui;
        if constexpr (ALIGN_EPI) { if (wr == 1) PG8_BAR; }
    }
    PG8_WAIT_V(0);
    if constexpr (!ALIGN_EPI) { if (wr == 0) PG8_BAR; }
    PG8_BAR;
    if constexpr (Epi::AFTER_DRAIN) { E.fused(acc, cur, wr, wc, fr, fq, lds, wid, lane); S.done(cur); }
#undef PG8_SA
#undef PG8_SB
#undef PG8_STAGE
#undef PG8_LDA
#undef PG8_LDB
#undef PG8_MMA
#undef PG8_WAIT_V
#undef PG8_WAIT_L
#undef PG8_BAR
#undef PG8_SCHED
}
}

#define LAS __attribute__((address_space(3)))
typedef unsigned short bf16_t;
constexpr int DM = 1024, NBATCH = 4, SEQ = 8192, CTXL = 256, NLAT = NBATCH * SEQ, NCTX = NBATCH * CTXL, MT = NLAT + NCTX, DFF = 2816, DIN = 2816, NADA = 9216;
constexpr size_t MiB = 1u << 20;
constexpr size_t WS_MOD = 0, WS_XC = 1 * MiB, WS_W = 8 * MiB, WS_WLAYER = 41 * MiB, WS_H = 90 * MiB, WS_O = 156 * MiB, WS_G = 222 * MiB, WS_END = 404 * MiB;
constexpr size_t WO_UP1 = 0, WO_DN1 = 11534336, WO_IN = WO_DN1 + 5767168, WO_OUT = WO_IN + 5767168, WO_UP2 = WO_OUT + 2097152, WO_DN2 = WO_UP2 + 11534336;
static_assert(WO_DN2 + 5767168 <= WS_WLAYER, "weights per layer");
constexpr int LDS_BYTES = 135168;

#ifndef DBG_INJECT
#define DBG_INJECT 0.0f
#endif
namespace fa {
typedef short bf16x8 __attribute__((ext_vector_type(8)));
typedef short s16x4 __attribute__((ext_vector_type(4)));
typedef float f32x16 __attribute__((ext_vector_type(16)));
typedef float f32x4 __attribute__((ext_vector_type(4)));
typedef unsigned u32x4 __attribute__((ext_vector_type(4)));
typedef unsigned u32x2 __attribute__((ext_vector_type(2)));
typedef float f32x2_t __attribute__((ext_vector_type(2)));
typedef __bf16 bf16x2_t __attribute__((ext_vector_type(2)));
__device__ __forceinline__ unsigned cvtpk(float lo, float hi) { f32x2_t v = {lo, hi}; bf16x2_t b = __builtin_convertvector(v, bf16x2_t); return __builtin_bit_cast(unsigned, b); }
__device__ __forceinline__ float bf2f(unsigned short b) { return __uint_as_float(((unsigned)b) << 16); }
__device__ __forceinline__ float max3f(float a, float b, float c) { float r; asm("v_max3_f32 %0, %1, %2, %3" : "=v"(r) : "v"(a), "v"(b), "v"(c)); return r; }
__device__ __forceinline__ float xmax32(float v) { auto rr = __builtin_amdgcn_permlane32_swap(__float_as_uint(v), __float_as_uint(v), false, false); return fmaxf(__uint_as_float(rr[0]), __uint_as_float(rr[1])); }
__device__ __forceinline__ float xsum32(float v) { auto rr = __builtin_amdgcn_permlane32_swap(__float_as_uint(v), __float_as_uint(v), false, false); return __uint_as_float(rr[0]) + __uint_as_float(rr[1]); }
__device__ __forceinline__ s16x4 vtr(const LAS unsigned char* p) { return __builtin_bit_cast(s16x4, __builtin_amdgcn_ds_read_tr16_b64_v4i16((LAS s16x4*)p)); }
__device__ __forceinline__ float lane_xor(float v, int lane, int o) { return __builtin_bit_cast(float, __builtin_amdgcn_ds_bpermute((lane ^ o) << 2, __builtin_bit_cast(int, v))); }
__device__ __forceinline__ float wave_sum(float v, int lane) {
#pragma unroll
    for (int o = 1; o < 64; o <<= 1) v += lane_xor(v, lane, o);
    return v;
}

template <int KW, int VW> struct Geo {
    static constexpr int KSTR = KW * 2 + 16, VSTR = VW * 2 + 64;
    static constexpr int KBYTES = 64 * KSTR, VBYTES = 64 * VSTR, BUF = KBYTES + VBYTES;
    static constexpr int KCH = KW / 8, VCH = VW / 8;
    static constexpr int NCH = (64 * (KCH + VCH)) / 512;
};
template <int KW, int VW, int NCHP = Geo<KW, VW>::NCH>
__device__ __forceinline__ void st_load(u32x4 (&st)[NCHP], const bf16_t* Z, long rowbase, int kcol0, int vcol0, int tid) {
    using G = Geo<KW, VW>;
#pragma unroll
    for (int i = 0; i < G::NCH; ++i) {
        const int c = tid + i * 512;
        if (i * 512 < 64 * G::KCH) { const int key = c / G::KCH, ch = c % G::KCH; st[i] = *(const u32x4*)(Z + (size_t)(rowbase + key) * DIN + kcol0 + ch * 8); }
        else { const int c2 = c - 64 * G::KCH; const int key = c2 / G::VCH, ch = c2 % G::VCH; st[i] = *(const u32x4*)(Z + (size_t)(rowbase + key) * DIN + vcol0 + ch * 8); }
    }
}
template <int KW, int VW, int NCHP = Geo<KW, VW>::NCH>
__device__ __forceinline__ void st_store(LAS unsigned char* buf, const u32x4 (&st)[NCHP], int tid) {
    using G = Geo<KW, VW>;
#pragma unroll
    for (int i = 0; i < G::NCH; ++i) {
        const int c = tid + i * 512;
        if (i * 512 < 64 * G::KCH) { const int key = c / G::KCH, ch = c % G::KCH; *(LAS u32x4*)(buf + key * G::KSTR + ch * 16) = st[i]; }
        else { const int c2 = c - 64 * G::KCH; const int key = c2 / G::VCH, ch = c2 % G::VCH; *(LAS u32x4*)(buf + G::KBYTES + key * G::VSTR + ch * 16) = st[i]; }
    }
}
__device__ __forceinline__ f32x16 qk32(const LAS unsigned char* kp, const bf16x8 (&qf)[4]) {
    f32x16 s = {0.f, 0.f, 0.f, 0.f, 0.f, 0.f, 0.f, 0.f, 0.f, 0.f, 0.f, 0.f, 0.f, 0.f, 0.f, 0.f};
#pragma unroll
    for (int ks = 0; ks < 4; ++ks) { const bf16x8 kf = *(const LAS bf16x8*)(kp + ks * 32); s = __builtin_amdgcn_mfma_f32_32x32x16_bf16(kf, qf[ks], s, 0, 0, 0); }
    return s;
}
template <int NDB, int VSTR>
__device__ __forceinline__ void pv32(f32x16 (&o)[NDB], const LAS unsigned char* vp, const f32x16& p) {
#pragma unroll
    for (int s = 0; s < 2; ++s) {
        u32x4 w; w.x = cvtpk(p[8 * s + 0], p[8 * s + 1]); w.y = cvtpk(p[8 * s + 2], p[8 * s + 3]); w.z = cvtpk(p[8 * s + 4], p[8 * s + 5]); w.w = cvtpk(p[8 * s + 6], p[8 * s + 7]);
        const bf16x8 pf = __builtin_bit_cast(bf16x8, w);
#pragma unroll
        for (int db = 0; db < NDB; ++db) {
            const s16x4 lo = vtr(vp + (16 * s) * VSTR + 64 * db), hi = vtr(vp + (16 * s + 8) * VSTR + 64 * db);
            const bf16x8 vf = {lo[0], lo[1], lo[2], lo[3], hi[0], hi[1], hi[2], hi[3]};
            o[db] = __builtin_amdgcn_mfma_f32_32x32x16_bf16(vf, pf, o[db], 0, 0, 0);
        }
    }
}
template <int NDB>
__device__ __forceinline__ void sm_update(f32x16& s0, f32x16& s1, float& m, float& l, f32x16 (&o)[NDB]) {
    float pm = fmaxf(s0[0], s1[0]);
#pragma unroll
    for (int r = 1; r < 16; ++r) pm = fmaxf(pm, fmaxf(s0[r], s1[r]));
    pm = xmax32(pm);
    if (!__all(pm - m <= 8.0f)) {
        const float mn = fmaxf(m, pm); const float alpha = __builtin_amdgcn_exp2f(m - mn); m = mn; l *= alpha;
#pragma unroll
        for (int db = 0; db < NDB; ++db)
#pragma unroll
            for (int r = 0; r < 16; ++r) o[db][r] *= alpha;
    }
    float ps = 0.f;
#pragma unroll
    for (int r = 0; r < 16; ++r) { s0[r] = __builtin_amdgcn_exp2f(s0[r] - m); s1[r] = __builtin_amdgcn_exp2f(s1[r] - m); ps += s0[r] + s1[r]; }
    l += ps;
}
constexpr float QK_C = 0.125f * 1.4426950408889634f;

template <int NDB>
__device__ __forceinline__ void sm_update_raw(f32x16& s0, f32x16& s1, float& m, float& l, f32x16 (&o)[NDB]) {
    float pm = max3f(s0[0], s1[0], s0[1]);
    pm = max3f(pm, s1[1], s1[1]);
#pragma unroll
    for (int r = 2; r < 16; ++r) pm = max3f(pm, s0[r], s1[r]);
    pm = xmax32(pm) * QK_C;
    if (!__all(pm - m <= 8.0f)) {
        const float mn = fmaxf(m, pm); const float alpha = __builtin_amdgcn_exp2f(m - mn); m = mn; l *= alpha;
#pragma unroll
        for (int db = 0; db < NDB; ++db)
#pragma unroll
            for (int r = 0; r < 16; ++r) o[db][r] *= alpha;
    }
    const float nm = -m; float ps = 0.f;
#pragma unroll
    for (int r = 0; r < 16; ++r) { s0[r] = __builtin_amdgcn_exp2f(fmaf(s0[r], QK_C, nm)); s1[r] = __builtin_amdgcn_exp2f(fmaf(s1[r], QK_C, nm)); ps += s0[r] + s1[r]; }
    l += ps;
}

__device__ __forceinline__ void glds16(const void* gsrc, unsigned lds_dst) { unsigned keep;
    asm volatile("s_mov_b32 %0, m0\n\ts_mov_b32 m0, %2\n\ts_nop 0\n\tglobal_load_lds_dwordx4 %1, off\n\ts_mov_b32 m0, %0" : "=&s"(keep) : "v"(gsrc), "s"(lds_dst) : "memory"); }
#define FA_WAIT_BAR(N) asm volatile("s_waitcnt vmcnt(" #N ") lgkmcnt(0)\n\ts_barrier" ::: "memory")
__device__ __forceinline__ f32x16 qk32s(const LAS unsigned char* kslot, const int (&ko)[4], const bf16x8 (&qf)[4]) {
    f32x16 s = {0.f, 0.f, 0.f, 0.f, 0.f, 0.f, 0.f, 0.f, 0.f, 0.f, 0.f, 0.f, 0.f, 0.f, 0.f, 0.f};
#pragma unroll
    for (int ks = 0; ks < 4; ++ks) { const bf16x8 kf = *(const LAS bf16x8*)(kslot + ko[ks]); s = __builtin_amdgcn_mfma_f32_32x32x16_bf16(kf, qf[ks], s, 0, 0, 0); }
    return s;
}
__device__ __forceinline__ void pv32d(f32x16 (&o)[4], const LAS unsigned char* vp, const f32x16& p) {
#pragma unroll
    for (int s = 0; s < 2; ++s) {
        u32x4 w; w.x = cvtpk(p[8 * s + 0], p[8 * s + 1]); w.y = cvtpk(p[8 * s + 2], p[8 * s + 3]); w.z = cvtpk(p[8 * s + 4], p[8 * s + 5]); w.w = cvtpk(p[8 * s + 6], p[8 * s + 7]);
        const bf16x8 pf = __builtin_bit_cast(bf16x8, w);
#pragma unroll
        for (int db = 0; db < 4; ++db) {
            const s16x4 lo = vtr(vp + (16 * s) * 64 + 4096 * db), hi = vtr(vp + (16 * s + 8) * 64 + 4096 * db);
            const bf16x8 vf = {lo[0], lo[1], lo[2], lo[3], hi[0], hi[1], hi[2], hi[3]};
            o[db] = __builtin_amdgcn_mfma_f32_32x32x16_bf16(vf, pf, o[db], 0, 0, 0);
        }
    }
}
__device__ __forceinline__ void diff_unit(LAS unsigned char* lds, const bf16_t* Z, bf16_t* O, int b, int hd, int q0row, int nlat_tiles, float lam, float oscale, const float* subln, int tid) {
    constexpr int KSLOT = 16384, VRING = 4 * KSLOT;
    const int lane = tid & 63, w = __builtin_amdgcn_readfirstlane(tid >> 6), r32 = lane & 31, h = lane >> 5;
    const int comp = w & 1, qblk = w >> 1;
    const int kcol0 = 1792 + hd * 128, vcol0 = 2304 + hd * 128;
    const unsigned lds0 = (unsigned)(size_t)lds;
    long kg[2], vg[2];
#pragma unroll
    for (int i = 0; i < 2; ++i) {
        const int krow = 8 * w + 4 * i + (lane >> 4);
        kg[i] = ((long)krow * DIN + kcol0 + (((lane & 15) ^ (krow & 7)) * 8)) * 2;
        const int vkey = 32 * (w & 1) + 16 * i + (lane >> 2);
        vg[i] = ((long)vkey * DIN + vcol0 + 32 * (w >> 1) + 8 * (lane & 3)) * 2;
    }
    const unsigned kdst = lds0 + (unsigned)(2 * w) * 1024u, vdst = lds0 + VRING + (unsigned)(2 * w) * 1024u;
#define DIFF_TROW(t) ((t) < nlat_tiles ? (long)b * SEQ + 64 * (t) : (long)NLAT + b * CTXL + 64 * ((t) - nlat_tiles))
#define DIFF_DMA(t) do { const char* tb_ = (const char*)Z + DIFF_TROW(t) * (long)(DIN * 2); const unsigned sl_ = (unsigned)(((t) & 3) * KSLOT); \
        glds16(tb_ + kg[0], (unsigned)__builtin_amdgcn_readfirstlane(kdst + sl_)); glds16(tb_ + kg[1], (unsigned)__builtin_amdgcn_readfirstlane(kdst + sl_ + 1024u)); \
        glds16(tb_ + vg[0], (unsigned)__builtin_amdgcn_readfirstlane(vdst + sl_)); glds16(tb_ + vg[1], (unsigned)__builtin_amdgcn_readfirstlane(vdst + sl_ + 1024u)); } while (0)
    const int NT = nlat_tiles + 4;
    DIFF_DMA(0); DIFF_DMA(1); DIFF_DMA(2);
    bf16x8 qf[4];
    { const bf16_t* qp = Z + (size_t)(q0row + 32 * qblk + r32) * DIN + 1280 + hd * 128 + comp * 64 + 8 * h;
#pragma unroll
      for (int ks = 0; ks < 4; ++ks) qf[ks] = *(const bf16x8*)(qp + 16 * ks); }
    f32x16 o[4];
#pragma unroll
    for (int db = 0; db < 4; ++db)
#pragma unroll
        for (int r = 0; r < 16; ++r) o[db][r] = 0.f;
    float m = -1e30f, l = 0.f;
    int ko[4];
#pragma unroll
    for (int ks = 0; ks < 4; ++ks) ko[ks] = r32 * 256 + (((comp * 8 + 2 * ks + h) ^ (r32 & 7)) << 4);
    const int voff = VRING + (4 * h + ((lane & 15) >> 2)) * 64 + (16 * ((lane >> 4) & 1) + 4 * (lane & 3)) * 2;
    asm volatile("s_waitcnt vmcnt(0)" ::: "memory");
    FA_WAIT_BAR(0);
    for (int t = 0; t < NT; ++t) {
        if (t + 3 < NT) DIFF_DMA(t + 3);
        const LAS unsigned char* kslot = lds + (t & 3) * KSLOT;
        bf16x8 kf[8];
#pragma unroll
        for (int i = 0; i < 8; ++i) kf[i] = *(const LAS bf16x8*)(kslot + ko[i & 3] + (i >> 2) * 8192);
        const LAS unsigned char* vs = lds + voff + (t & 3) * KSLOT;
        s16x4 va[8], vb[8];
#define DIFF_VLD(dst, g) do { _Pragma("unroll") for (int db = 0; db < 4; ++db) { dst[2 * db] = vtr(vs + (16 * (g)) * 64 + 4096 * db); dst[2 * db + 1] = vtr(vs + (16 * (g) + 8) * 64 + 4096 * db); } } while (0)
        DIFF_VLD(va, 0);
        DIFF_VLD(vb, 1);
        __builtin_amdgcn_sched_barrier(0);
        f32x16 s0 = {0.f, 0.f, 0.f, 0.f, 0.f, 0.f, 0.f, 0.f, 0.f, 0.f, 0.f, 0.f, 0.f, 0.f, 0.f, 0.f}, s1 = s0;
        __builtin_amdgcn_s_setprio(1);
#pragma unroll
        for (int ks = 0; ks < 4; ++ks) { s0 = __builtin_amdgcn_mfma_f32_32x32x16_bf16(kf[ks], qf[ks], s0, 0, 0, 0); s1 = __builtin_amdgcn_mfma_f32_32x32x16_bf16(kf[4 + ks], qf[ks], s1, 0, 0, 0); }
        __builtin_amdgcn_s_setprio(0);
        __builtin_amdgcn_sched_barrier(0);
        sm_update_raw<4>(s0, s1, m, l, o);
        bf16x8 pf[4];
#pragma unroll
        for (int g = 0; g < 4; ++g) { const f32x16& p = (g < 2) ? s0 : s1; const int e = 8 * (g & 1);
            u32x4 wv; wv.x = cvtpk(p[e + 0], p[e + 1]); wv.y = cvtpk(p[e + 2], p[e + 3]); wv.z = cvtpk(p[e + 4], p[e + 5]); wv.w = cvtpk(p[e + 6], p[e + 7]); pf[g] = __builtin_bit_cast(bf16x8, wv); }
        __builtin_amdgcn_sched_barrier(0);
#define DIFF_PV(src, g) do { __builtin_amdgcn_s_setprio(1); _Pragma("unroll") for (int db = 0; db < 4; ++db) { const bf16x8 vf = {src[2 * db][0], src[2 * db][1], src[2 * db][2], src[2 * db][3], src[2 * db + 1][0], src[2 * db + 1][1], src[2 * db + 1][2], src[2 * db + 1][3]}; \
            o[db] = __builtin_amdgcn_mfma_f32_32x32x16_bf16(vf, pf[g], o[db], 0, 0, 0); } __builtin_amdgcn_s_setprio(0); } while (0)
        DIFF_PV(va, 0);  __builtin_amdgcn_sched_barrier(0);
        DIFF_VLD(va, 2); __builtin_amdgcn_sched_barrier(0);
        DIFF_PV(vb, 1);  __builtin_amdgcn_sched_barrier(0);
        DIFF_VLD(vb, 3); __builtin_amdgcn_sched_barrier(0);
        DIFF_PV(va, 2);  __builtin_amdgcn_sched_barrier(0);
        DIFF_PV(vb, 3);  __builtin_amdgcn_sched_barrier(0);
#undef DIFF_VLD
#undef DIFF_PV
        if (t + 3 < NT) FA_WAIT_BAR(8); else if (t + 2 < NT) FA_WAIT_BAR(4); else FA_WAIT_BAR(0);
    }
#undef DIFF_TROW
#undef DIFF_DMA
    int tid_e = tid; asm volatile("" : "+v"(tid_e));
    const int lane_e = tid_e & 63, r32e = lane_e & 31, he = lane_e >> 5;
    l = xsum32(l); const float inv = 1.0f / l;
    LAS float* ex = (LAS float*)lds + qblk * 4096;
    if (comp == 1) {
#pragma unroll
        for (int db = 0; db < 4; ++db)
#pragma unroll
            for (int r = 0; r < 16; ++r) ex[(db * 16 + r) * 64 + lane_e] = o[db][r] * inv;
    }
    __syncthreads();
    if (comp == 0) {
        float ss = 0.f;
#pragma unroll
        for (int db = 0; db < 4; ++db)
#pragma unroll
            for (int r = 0; r < 16; ++r) { const float v = o[db][r] * inv - lam * ex[(db * 16 + r) * 64 + lane_e]; o[db][r] = v; ss += v * v; }
        ss = xsum32(ss);
        const float rstd = rsqrtf(ss * (1.0f / 128.0f) + 1e-6f) * oscale;
        bf16_t* op = O + (size_t)(q0row + 32 * qblk + r32e) * DM + 512 + hd * 128 + 4 * he;
#pragma unroll
        for (int db = 0; db < 4; ++db)
#pragma unroll
            for (int i = 0; i < 4; ++i) {
                const f32x4 g = *(const f32x4*)(subln + 32 * db + 8 * i + 4 * he);
                u32x2 wv; wv.x = cvtpk(o[db][4 * i + 0] * rstd * g[0], o[db][4 * i + 1] * rstd * g[1]); wv.y = cvtpk(o[db][4 * i + 2] * rstd * g[2], o[db][4 * i + 3] * rstd * g[3]);
                *(u32x2*)(op + 32 * db + 8 * i) = wv;
            }
    }
    __syncthreads();
}

constexpr int NA_RPB_OFF = 49152;
__device__ __forceinline__ void na_unit(LAS unsigned char* lds, const bf16_t* Z, bf16_t* O, const float* rpb_h, int b, int hd, int r0, int ctxq, int tid) {
    using G = Geo<64, 64>;
    const int lane = tid & 63, w = __builtin_amdgcn_readfirstlane(tid >> 6), r32 = lane & 31, h = lane >> 5;
    const int gr = r0 + (w >> 1), hh = w & 1;
    const int kcol0 = 256 + hd * 64, vcol0 = 512 + hd * 64;
    const long qrow = ctxq ? (long)NLAT + b * CTXL + 32 * w + r32 : (long)b * SEQ + gr * 64 + 32 * hh + r32;
    LAS float* rpbL = (LAS float*)(lds + NA_RPB_OFF);
    if (tid < 465) rpbL[tid] = rpb_h[tid] * 1.4426950408889634f;
    bf16x8 qf[4];
    { const bf16_t* qp = Z + (size_t)qrow * DIN + hd * 64 + 8 * h;
#pragma unroll
      for (int ks = 0; ks < 4; ++ks) qf[ks] = *(const bf16x8*)(qp + 16 * ks); }
    f32x16 o[2];
#pragma unroll
    for (int db = 0; db < 2; ++db)
#pragma unroll
        for (int r = 0; r < 16; ++r) o[db][r] = 0.f;
    float m = -1e30f, l = 0.f;
    int kr_lo = r0 - 4; kr_lo = kr_lo < 0 ? 0 : (kr_lo > 120 ? 120 : kr_lo);
    int kr_hi = r0 + 3 - 4; kr_hi = (kr_hi < 0 ? 0 : (kr_hi > 120 ? 120 : kr_hi)) + 7;
    const int NT = ctxq ? 4 : 4 + (kr_hi - kr_lo + 1);
    int ks0 = gr - 4; ks0 = ks0 < 0 ? 0 : (ks0 > 120 ? 120 : ks0);
    const int qcol = 32 * hh + r32; int w0 = qcol - 8; w0 = w0 < 0 ? 0 : (w0 > 48 ? 48 : w0);
    const int koff = r32 * G::KSTR + 16 * h;
    const int voff = G::KBYTES + (4 * h + ((lane & 15) >> 2)) * G::VSTR + (16 * ((lane >> 4) & 1) + 4 * (lane & 3)) * 2;
    u32x4 st[G::NCH];
#define NA_TROW(t) ((t) < 4 ? (long)NLAT + b * CTXL + 64 * (t) : (long)b * SEQ + (kr_lo + (t) - 4) * 64)
    u32x4 stB[G::NCH];
    st_load<64, 64>(st, Z, NA_TROW(0), kcol0, vcol0, tid);
    st_store<64, 64>(lds, st, tid);
    st_load<64, 64>(st, Z, NA_TROW(1), kcol0, vcol0, tid);
    __syncthreads();
    for (int t0 = 0; t0 < NT; t0 += 2) {
#pragma unroll
    for (int u = 0; u < 2; ++u) {
        const int t = t0 + u;
        if (t < NT) {
        LAS unsigned char* cur = lds + (t & 1) * G::BUF; LAS unsigned char* nxt = lds + ((t + 1) & 1) * G::BUF;
        if (t + 2 < NT) { if (u == 0) st_load<64, 64>(stB, Z, NA_TROW(t + 2), kcol0, vcol0, tid); else st_load<64, 64>(st, Z, NA_TROW(t + 2), kcol0, vcol0, tid); }
        const int kr = kr_lo + t - 4;
        const bool active = (t < 4) || (kr >= ks0 && kr < ks0 + 8);
        if (active) {
            f32x16 s0 = qk32(cur + koff, qf), s1 = qk32(cur + koff + 32 * G::KSTR, qf);
            if (t < 4) {
#pragma unroll
                for (int r = 0; r < 16; ++r) { s0[r] *= QK_C; s1[r] *= QK_C; }
            } else {
                const LAS float* brow = rpbL + (kr - gr + 7) * 31;
                int hq = 4 * h - qcol + 15, hw = 4 * h - w0;
                asm volatile("" : "+v"(hq), "+v"(hw));
#pragma unroll
                for (int r = 0; r < 16; ++r) {
                    const int cr = (r & 3) + 8 * (r >> 2);
                    { const int d = cr + hq; const int dc = d < 0 ? 0 : (d > 30 ? 30 : d); const bool ok = (unsigned)(cr + hw) < 16u; const float bias = brow[dc]; s0[r] = ok ? fmaf(s0[r], QK_C, bias) : -1e30f; }
                    { const int d = cr + 32 + hq; const int dc = d < 0 ? 0 : (d > 30 ? 30 : d); const bool ok = (unsigned)(cr + 32 + hw) < 16u; const float bias = brow[dc]; s1[r] = ok ? fmaf(s1[r], QK_C, bias) : -1e30f; }
                }
            }
            sm_update<2>(s0, s1, m, l, o);
            pv32<2, G::VSTR>(o, cur + voff, s0);
            pv32<2, G::VSTR>(o, cur + voff + 32 * G::VSTR, s1);
        }
        if (t + 1 < NT) { if (u == 0) st_store<64, 64>(nxt, st, tid); else st_store<64, 64>(nxt, stB, tid); }
        __syncthreads();
        }
    }
    }
#undef NA_TROW
    l = xsum32(l); const float inv = 1.0f / l;
    bf16_t* op = O + (size_t)qrow * DM + hd * 64 + 4 * h;
#pragma unroll
    for (int db = 0; db < 2; ++db)
#pragma unroll
        for (int i = 0; i < 4; ++i) {
            u32x2 wv; wv.x = cvtpk(o[db][4 * i + 0] * inv, o[db][4 * i + 1] * inv); wv.y = cvtpk(o[db][4 * i + 2] * inv, o[db][4 * i + 3] * inv);
            *(u32x2*)(op + 32 * db + 8 * i) = wv;
        }
    __syncthreads();
}

__device__ __forceinline__ void gmlp_unit(LAS unsigned char* lds, const bf16_t* Z, bf16_t* O, const float* ws_g  , const float* bs_g  , const float* gn_g  , long row0, int g, int tid) {
    constexpr int STR = 272;
    LAS unsigned char* WsL = lds; LAS unsigned char* vnT = lds + 128 * STR;
    const int lane = tid & 63, w = __builtin_amdgcn_readfirstlane(tid >> 6), r32 = lane & 31, h = lane >> 5;
#pragma unroll
    for (int i = 0; i < 8; ++i) {
        const int c = tid + i * 512; const int p = c >> 5, q4 = c & 31;
        const f32x4 v = *(const f32x4*)(ws_g + p * 128 + q4 * 4);
        u32x2 wv; wv.x = cvtpk(v[0], v[1]); wv.y = cvtpk(v[2], v[3]);
        *(LAS u32x2*)(WsL + p * STR + q4 * 8) = wv;
    }
    {
        const int q = tid >> 2, part = tid & 3;
        const bf16_t* vp = Z + (size_t)(row0 + q) * DIN + 1024 + 64 * g + 16 * part;
        const u32x4 x0 = *(const u32x4*)vp, x1 = *(const u32x4*)(vp + 8);
        float f[16];
#pragma unroll
        for (int e = 0; e < 4; ++e) { f[2 * e] = __uint_as_float(x0[e] << 16); f[2 * e + 1] = __uint_as_float(x0[e] & 0xffff0000u); f[8 + 2 * e] = __uint_as_float(x1[e] << 16); f[8 + 2 * e + 1] = __uint_as_float(x1[e] & 0xffff0000u); }
        float ss = 0.f;
#pragma unroll
        for (int e = 0; e < 16; ++e) ss += f[e] * f[e];
        ss += lane_xor(ss, lane, 1); ss += lane_xor(ss, lane, 2);
        const float rstd = rsqrtf(ss * (1.0f / 64.0f) + 1e-6f);
#pragma unroll
        for (int e = 0; e < 16; ++e) {
            const int wc = 16 * part + e; const float y = f[e] * rstd * gn_g[wc];
            *(LAS unsigned short*)(vnT + wc * STR + q * 2) = (unsigned short)(cvtpk(y, 0.f) & 0xffffu);
        }
    }
    __syncthreads();
    const int pb = w >> 1, wb = w & 1;
    f32x16 acc = {0.f, 0.f, 0.f, 0.f, 0.f, 0.f, 0.f, 0.f, 0.f, 0.f, 0.f, 0.f, 0.f, 0.f, 0.f, 0.f};
#pragma unroll
    for (int ks = 0; ks < 8; ++ks) {
        const bf16x8 a = *(const LAS bf16x8*)(WsL + (32 * pb + r32) * STR + (16 * ks + 8 * h) * 2);
        const bf16x8 bq = *(const LAS bf16x8*)(vnT + (32 * wb + r32) * STR + (16 * ks + 8 * h) * 2);
        acc = __builtin_amdgcn_mfma_f32_32x32x16_bf16(a, bq, acc, 0, 0, 0);
    }
    const int wcol = 32 * wb + r32;
#pragma unroll
    for (int r = 0; r < 16; ++r) {
        const int p = 32 * pb + (r & 3) + 8 * (r >> 2) + 4 * h;
        const float s = acc[r] + bs_g[p];
        const float uval = bf2f(Z[(size_t)(row0 + p) * DIN + 768 + 64 * g + wcol]);
        O[(size_t)(row0 + p) * DM + 256 + 64 * g + wcol] = (unsigned short)(cvtpk(uval * s, 0.f) & 0xffffu);
    }
    __syncthreads();
}
}

typedef float f32x4 __attribute__((ext_vector_type(4)));
typedef unsigned v4u __attribute__((ext_vector_type(4)));
typedef unsigned v2u __attribute__((ext_vector_type(2)));
#ifndef DBG_SKIP
#define DBG_SKIP 0
#endif
#ifndef REP_MASK
#define REP_MASK 7
#endif
#ifndef REP_MIX
#define REP_MIX 1
#endif
#ifndef DBG_SKIP_LAYERS
#define DBG_SKIP_LAYERS 3
#endif
#ifndef DBG_FILL
#define DBG_FILL 1
#endif
#ifndef DBG_CHECK
#define DBG_CHECK 0
#endif
#ifndef DBG_STOP
#define DBG_STOP 17
#endif
#ifndef DBG_IDENT
#define DBG_IDENT 0
#endif
#ifndef MIX_MASK
#define MIX_MASK 0xff
#endif
#ifndef PH_MASK
#define PH_MASK 0xff
#endif
constexpr int NSTEPS = 22;

struct Args { const float* in[24]; float* out; unsigned char* ws; int ph_lo, ph_hi; };
enum { I_X = 0, I_C, I_CTX, I_CCTX, I_WADA, I_BADA, I_F1W1, I_F1W3, I_F1W2, I_WIN, I_WOUT, I_RPB, I_GMWS, I_GMBS, I_GMNORM, I_LQ1, I_LK1, I_LQ2, I_LK2, I_SUBLN, I_F2W1, I_F2W3, I_F2W2, I_FNORM };

__device__ __forceinline__ void transpose_item(const float* W, int K, int N, bf16_t* WT, int dst_row0, int k0, int n0, LAS float* scr, int lane) {
#pragma unroll 8
    for (int i = 0; i < 32; ++i) { const int kk = 2 * i + (lane >> 5); scr[kk * 33 + (lane & 31)] = W[(size_t)(k0 + kk) * N + n0 + (lane & 31)]; }
    asm volatile("s_waitcnt lgkmcnt(0)" ::: "memory");
    const int c = lane & 7;
#pragma unroll
    for (int j = 0; j < 4; ++j) { const int n = (lane >> 3) + 8 * j; const LAS float* s = scr + (8 * c) * 33 + n;
        v4u o; o.x = fa::cvtpk(s[0 * 33], s[1 * 33]); o.y = fa::cvtpk(s[2 * 33], s[3 * 33]); o.z = fa::cvtpk(s[4 * 33], s[5 * 33]); o.w = fa::cvtpk(s[6 * 33], s[7 * 33]);
        *(v4u*)(WT + (size_t)(dst_row0 + n) * K + k0 + 8 * c) = o; }
    asm volatile("s_waitcnt lgkmcnt(0)" ::: "memory");
}

__device__ __forceinline__ void prologue(const Args& a, LAS unsigned char* lds, int tid, int G) {
    const int lane = tid & 63, wave = __builtin_amdgcn_readfirstlane(tid >> 6);
    float* mod = (float*)(a.ws + WS_MOD);
    if ((int)blockIdx.x < 288) {
        LAS float* sv = (LAS float*)lds; LAS float* red = sv + 5120;
        for (int i = tid; i < 5120; i += 512) { const int ci = i >> 10, k = i & 1023; const float c = ci < 4 ? a.in[I_C][ci * 1024 + k] : a.in[I_CCTX][k]; sv[i] = c / (1.0f + __expf(-c)); }
        __syncthreads();
        for (int it = blockIdx.x; it < 288; it += G) {
            const int l = it / 144, j0 = (it % 144) * 64;
            const float* W = a.in[I_WADA] + (size_t)l * 1024 * NADA + j0 + lane;
            float a0 = 0.f, a1 = 0.f, a2 = 0.f, a3 = 0.f, a4 = 0.f;
#pragma unroll 16
            for (int kk = 0; kk < 128; ++kk) { const int k = wave * 128 + kk; const float wv = W[(size_t)k * NADA];
                a0 += sv[k] * wv; a1 += sv[1024 + k] * wv; a2 += sv[2048 + k] * wv; a3 += sv[3072 + k] * wv; a4 += sv[4096 + k] * wv; }
            red[(wave * 5 + 0) * 64 + lane] = a0; red[(wave * 5 + 1) * 64 + lane] = a1; red[(wave * 5 + 2) * 64 + lane] = a2; red[(wave * 5 + 3) * 64 + lane] = a3; red[(wave * 5 + 4) * 64 + lane] = a4;
            __syncthreads();
            if (tid < 320) { const int i = tid >> 6, ln = tid & 63; float s = 0.f;
#pragma unroll
                for (int ww = 0; ww < 8; ++ww) s += red[(ww * 5 + i) * 64 + ln];
                mod[(size_t)(l * 5 + i) * NADA + j0 + ln] = s + a.in[I_BADA][l * NADA + j0 + ln]; }
            __syncthreads();
        }
    }
    __syncthreads();
    LAS float* scr = (LAS float*)(lds + wave * 16384);
    const int gw = blockIdx.x * 8 + wave, NGW = G * 8;
    constexpr int I_UP = 16 * 88, I_DN = 44 * 32, I_INP = 16 * 88, I_OUTP = 16 * 32;
    constexpr int PER_LAYER = 2 * I_UP + I_DN + I_INP + I_OUTP + 2 * I_UP + I_DN;
    for (int it = gw; it < 2 * PER_LAYER; it += NGW) {
        const int l = it / PER_LAYER; int r = it % PER_LAYER;
        unsigned char* wl = a.ws + WS_W + (size_t)l * WS_WLAYER;
        int which = 0;
        if (r < 2 * I_UP) which = 0; else { r -= 2 * I_UP; if (r < I_DN) which = 1; else { r -= I_DN; if (r < I_INP) which = 2; else { r -= I_INP; if (r < I_OUTP) which = 3; else { r -= I_OUTP; if (r < 2 * I_UP) which = 4; else { r -= 2 * I_UP; which = 5; } } } } }
        if (which == 0 || which == 4) {
            const int bj = r / I_UP; const int rr = r % I_UP; const int kb = rr / 88, nb = rr % 88; const int n0 = 32 * nb;
            const float* W = (which == 0 ? (bj ? a.in[I_F1W3] : a.in[I_F1W1]) : (bj ? a.in[I_F2W3] : a.in[I_F2W1])) + (size_t)l * 1024 * DFF;
            bf16_t* WT = (bf16_t*)(wl + (which == 0 ? WO_UP1 : WO_UP2));
            transpose_item(W, 1024, DFF, WT, 256 * (n0 / 128) + 128 * bj + (n0 % 128), 64 * kb, n0, scr, lane);
        } else if (which == 1 || which == 5) {
            const int kb = r / 32, nb = r % 32;
            const float* W = (which == 1 ? a.in[I_F1W2] : a.in[I_F2W2]) + (size_t)l * DFF * 1024;
            bf16_t* WT = (bf16_t*)(wl + (which == 1 ? WO_DN1 : WO_DN2));
            transpose_item(W, DFF, 1024, WT, 32 * nb, 64 * kb, 32 * nb, scr, lane);
        } else if (which == 2) {
            const int kb = r / 88, nb = r % 88; const int n0 = 32 * nb; const int pn = n0 / 256, rem = n0 % 256; const int comp = rem / 64, bj = (rem % 64) / 32;
            const float* W = a.in[I_WIN] + (size_t)l * 1024 * DIN;
            transpose_item(W, 1024, DIN, (bf16_t*)(wl + WO_IN), 256 * pn + 128 * bj + 32 * comp, 64 * kb, n0, scr, lane);
        } else {
            const int kb = r / 32, nb = r % 32;
            const float* W = a.in[I_WOUT] + (size_t)l * 1024 * 1024;
            transpose_item(W, 1024, 1024, (bf16_t*)(wl + WO_OUT), 32 * nb, 64 * kb, 32 * nb, scr, lane);
        }
    }
}

__device__ __forceinline__ void modulate_phase(const float* srcL, const float* srcC, bf16_t* H, const float* modl, int si, int nrows, int tid, int G) {
    const int lane = tid & 63, wave = tid >> 6; const int gw = blockIdx.x * 8 + wave, NGW = G * 8;
    for (int row = gw; row < nrows; row += NGW) {
        const bool lat = row < NLAT;
        const f32x4* xr = (const f32x4*)(lat ? srcL + (size_t)row * DM : srcC + (size_t)(row - NLAT) * DM) + lane;
        const float* sh = modl + (size_t)(lat ? (row >> 13) : 4) * NADA + si * DM;
        f32x4 v[4]; float ss = 0.f;
#pragma unroll
        for (int j = 0; j < 4; ++j) { v[j] = xr[64 * j]; ss += (v[j].x * v[j].x + v[j].y * v[j].y) + (v[j].z * v[j].z + v[j].w * v[j].w); }
        ss = fa::wave_sum(ss, lane);
        const float rstd = rsqrtf(ss * (1.0f / DM) + 1e-6f);
        v2u* o8 = (v2u*)(H + (size_t)row * DM) + lane;
#pragma unroll
        for (int j = 0; j < 4; ++j) {
            const f32x4 h4 = ((const f32x4*)sh)[lane + 64 * j], s4 = ((const f32x4*)(sh + DM))[lane + 64 * j];
            const f32x4 y = v[j] * rstd * (s4 + 1.0f) + h4;
            v2u wv; wv.x = fa::cvtpk(y.x, y.y); wv.y = fa::cvtpk(y.z, y.w); o8[64 * j] = wv;
        }
    }
}
__device__ __forceinline__ void final_norm_phase(const float* Xs, float* X, const float* gain, int tid, int G) {
    const int lane = tid & 63, wave = tid >> 6; const int gw = blockIdx.x * 8 + wave, NGW = G * 8;
    for (int row = gw; row < NLAT; row += NGW) {
        f32x4* xr = (f32x4*)(X + (size_t)row * DM) + lane; const f32x4* xs = (const f32x4*)(Xs + (size_t)row * DM) + lane;
        f32x4 v[4]; float ss = 0.f;
#pragma unroll
        for (int j = 0; j < 4; ++j) { v[j] = xs[64 * j]; ss += (v[j].x * v[j].x + v[j].y * v[j].y) + (v[j].z * v[j].z + v[j].w * v[j].w); }
        ss = fa::wave_sum(ss, lane);
        const float rstd = rsqrtf(ss * (1.0f / DM) + 1e-6f);
#pragma unroll
        for (int j = 0; j < 4; ++j) { const f32x4 g = ((const f32x4*)gain)[lane + 64 * j]; xr[64 * j] = v[j] * rstd * g; }
    }
}

__device__ __forceinline__ void mix_phase(const Args& a, LAS unsigned char* lds, int l, int tid, int G, const int umask) {
    const bf16_t* Z = (const bf16_t*)(a.ws + WS_G); bf16_t* O = (bf16_t*)(a.ws + WS_O);
    const int lane = tid & 63;
    const float linit = (l == 0) ? 0.2f : 0.35550906759f;
    float lam;
    { const float d1 = fa::wave_sum(a.in[I_LQ1][l * 64 + lane] * a.in[I_LK1][l * 64 + lane], lane); const float d2 = fa::wave_sum(a.in[I_LQ2][l * 64 + lane] * a.in[I_LK2][l * 64 + lane], lane);
      lam = __expf(d1) - __expf(d2) + linit; }
    const float* subln = a.in[I_SUBLN] + l * 128;
    const int n_diff = 1024, n_na = 512, n_gm = (l == 0) ? 1056 : 1024, n_nac = (l == 0) ? 16 : 0, n_dc = (l == 0) ? 32 : 0;
    const int total = n_diff + n_na + n_gm + n_nac + n_dc;
    const int tid_m = tid;
    for (int it = blockIdx.x; it < total; it += G) {
        int tid = tid_m; asm volatile("" : "+v"(tid));
        int r = it;
        const bool is_dl = r < n_diff, is_dc = r >= n_diff + n_na + n_gm + n_nac;
        const bool is_nl = !is_dl && r < n_diff + n_na, is_nc = !is_dc && r >= n_diff + n_na + n_gm;
        if (is_dl || is_dc) {
            int b, hd, q0row, nlat;
            if (is_dl) { const int blk = r & 255, k = r >> 8; const int xcd = blk & 7, slot = blk >> 3; const int jj = k * 32 + slot; const int bh = 2 * xcd + (jj >> 6), qb = jj & 63;
                b = bh >> 2; hd = bh & 3; q0row = b * SEQ + qb * 128; nlat = 128; }
            else { const int rr = r - (n_diff + n_na + n_gm + n_nac); b = rr >> 3; hd = (rr >> 1) & 3; q0row = NLAT + b * CTXL + (rr & 1) * 128; nlat = 0; }
            if (umask & 1) fa::diff_unit(lds, Z, O, b, hd, q0row, nlat, lam, 1.0f - linit, subln, tid);
        } else if (is_nl || is_nc) {
            int b, hd, r0, ctxq;
            if (is_nl) { const int rr = r - n_diff; b = rr >> 7; hd = (rr >> 5) & 3; r0 = 4 * (rr & 31); ctxq = 0; }
            else { const int rr = r - (n_diff + n_na + n_gm); b = rr >> 2; hd = rr & 3; r0 = 0; ctxq = 1; }
            if (umask & 2) fa::na_unit(lds, Z, O, a.in[I_RPB] + (size_t)(l * 4 + hd) * 465, b, hd, r0, ctxq, tid);
        } else {
            const int rr = r - (n_diff + n_na); const int chunk = rr >> 2, g = rr & 3;
            const long row0 = chunk < 256 ? (long)chunk * 128 : (long)NLAT + (chunk - 256) * 128;
            if (umask & 4) fa::gmlp_unit(lds, Z, O, a.in[I_GMWS] + (size_t)(l * 4 + g) * 16384, a.in[I_GMBS] + (l * 4 + g) * 128, a.in[I_GMNORM] + (l * 4 + g) * 64, row0, g, tid);
        }
    }
}


#if DBG_CHECK
constexpr size_t WS_DBG = 5 * MiB, WS_XC2 = 404 * MiB;
__device__ __forceinline__ float dbg_bf(const bf16_t* p, size_t i) { return __uint_as_float(((unsigned)p[i]) << 16); }
__device__ __forceinline__ unsigned dbg_hash(unsigned x) { x ^= x >> 16; x *= 0x7feb352du; x ^= x >> 15; x *= 0x846ca68bu; x ^= x >> 16; return x; }
__device__ __forceinline__ bool dbg_bad(float got, float ref, float atol = 0.03f) { return !(fabsf(got - ref) <= atol + 0.03f * fabsf(ref)); }
__device__ __forceinline__ float dbg_block_sum(float v, LAS float* red, int tid) {
    v = fa::wave_sum(v, tid & 63); __syncthreads(); if ((tid & 63) == 0) red[tid >> 6] = v; __syncthreads();
    float s = 0.f; for (int i = 0; i < 8; ++i) s += red[i]; __syncthreads(); return s;
}
__device__ __forceinline__ float dbg_block_max(float v, LAS float* red, int tid) {
    for (int o = 1; o < 64; o <<= 1) v = fmaxf(v, __shfl_xor(v, o));
    __syncthreads(); if ((tid & 63) == 0) red[tid >> 6] = v; __syncthreads();
    float s = red[0]; for (int i = 1; i < 8; ++i) s = fmaxf(s, red[i]); __syncthreads(); return s;
}
template <class KR, class BI>
__device__ __forceinline__ void dbg_attn(const bf16_t* Z, long qrow, int qcol, int kcol, int vcol, int dv, int nk, KR krow, BI bias, LAS float* sc, LAS float* outv, LAS float* red, int tid) {
    float lm = -3e38f;
    for (int i = tid; i < nk; i += 512) { const long kr = krow(i); float s = 0.f; for (int d = 0; d < 64; ++d) s += dbg_bf(Z, (size_t)qrow * DIN + qcol + d) * dbg_bf(Z, (size_t)kr * DIN + kcol + d); s = s * 0.125f + bias(i); sc[i] = s; lm = fmaxf(lm, s); }
    const float m = dbg_block_max(lm, red, tid);
    float ls = 0.f;
    for (int i = tid; i < nk; i += 512) { const float p = __expf(sc[i] - m); sc[i] = p; ls += p; }
    const float tot = dbg_block_sum(ls, red, tid);
    const int d = tid & 127, part = tid >> 7;
    float acc = 0.f;
    if (d < dv) for (int i = part; i < nk; i += 4) acc += sc[i] * dbg_bf(Z, (size_t)krow(i) * DIN + vcol + d);
    __syncthreads();
    LAS float* tmp = red + 16;
    tmp[part * 128 + d] = acc; __syncthreads();
    if (tid < dv) outv[tid] = (tmp[tid] + tmp[128 + tid] + tmp[256 + tid] + tmp[384 + tid]) / tot;
    __syncthreads();
}
__device__ __forceinline__ void dbg_check(const Args& a, LAS unsigned char* lds, int tid, int G, const int l, const int sres) {
    unsigned* flags = (unsigned*)(a.ws + WS_DBG);
    const bf16_t* H = (const bf16_t*)(a.ws + WS_H); const bf16_t* Z = (const bf16_t*)(a.ws + WS_G); const bf16_t* O = (const bf16_t*)(a.ws + WS_O);
    const float* mod = (const float*)(a.ws + WS_MOD) + (size_t)l * 5 * NADA;
    const int blk = blockIdx.x;
    if (blk == 7 && tid == 0) atomicOr(flags, 1u);
    if (sres == 6) {
    {
        const int rows[8] = {0, 77, 8192, 20000, 32767, 32768, 33000, 33791};
        bool bad = false;
        for (int sidx = tid; sidx < 8 * 70; sidx += 512) {
            int ri = sidx / 70; const int row = (int)(dbg_hash(blk * 8 + ri + 1000) % (unsigned)MT); const int col = ((sidx % 70) * 37 + blk) % DIN;
            const bool rope = (col >= 1280 && col < 2304 && row < NLAT);
            const int c1 = rope ? (col & ~63) + (col & 31) : col; const int c2 = c1 + 32;
            float x1 = 0.f, x2 = 0.f;
            for (int k = 0; k < 1024; ++k) { const float hv = dbg_bf(H, (size_t)row * DM + k); x1 += hv * a.in[I_WIN][(size_t)l * 1024 * DIN + (size_t)k * DIN + c1]; if (rope) x2 += hv * a.in[I_WIN][(size_t)l * 1024 * DIN + (size_t)k * DIN + c2]; }
            float ref = x1;
            if (col >= 768 && col < 1280) ref = 0.5f * x1 * (1.0f + erff(x1 * 0.70710678f));
            if (rope) { const int t = row & 8191; const int j = col & 31; const float pos = (j < 16) ? (float)(t >> 6) : (float)(t & 63); const float fr = __builtin_amdgcn_exp2f(-(float)(j & 15) * 0.8304820237218406f);
                const float ang = pos * fr; const float c = __cosf(ang), s = __sinf(ang); ref = ((col & 63) < 32) ? x1 * c - x2 * s : x1 * s + x2 * c; }
            if (dbg_bad(dbg_bf(Z, (size_t)row * DIN + col), ref)) bad = true;
        }
        (void)rows;
        if (bad) atomicOr(flags, 2u);
    }
    {
        bool bad = false;
        if (tid < 144) {
            const int ci = tid / 36, g = (tid / 9) & 3, pi = (tid / 3) % 3, wi = tid % 3;
            const long row0 = 128L * (dbg_hash(blk * 4 + ci + 77) % (l == 0 ? 264u : 256u)); const int p = (int)(dbg_hash(blk * 16 + pi + 5) % 128u); const int w = (int)(dbg_hash(blk * 16 + wi + 11) % 64u);
            float s = 0.f;
            for (int q = 0; q < 128; ++q) { float ss = 0.f; for (int e = 0; e < 64; ++e) { const float v = dbg_bf(Z, (size_t)(row0 + q) * DIN + 1024 + 64 * g + e); ss += v * v; }
                const float vn = dbg_bf(Z, (size_t)(row0 + q) * DIN + 1024 + 64 * g + w) * rsqrtf(ss / 64.f + 1e-6f) * a.in[I_GMNORM][(l * 4 + g) * 64 + w];
                s += a.in[I_GMWS][(size_t)(l * 4 + g) * 16384 + p * 128 + q] * vn; }
            s += a.in[I_GMBS][(l * 4 + g) * 128 + p];
            const float ref = dbg_bf(Z, (size_t)(row0 + p) * DIN + 768 + 64 * g + w) * s;
            if (dbg_bad(dbg_bf(O, (size_t)(row0 + p) * DM + 256 + 64 * g + w), ref)) bad = true;
        }
        if (bad) atomicOr(flags, 4u);
    }
    for (int pass = 2; pass <= 3; ++pass) {
        LAS float* sc = (LAS float*)lds; LAS float* outv = sc + 8448; LAS float* outv2 = outv + 128; LAS float* red = outv2 + 128;
        bool bad = false;
        for (int smp = 0; smp < 2; ++smp) {
            if (pass == 2) {
                const unsigned hh_ = dbg_hash(blk * 2 + smp + 333); const int b = hh_ & 3, hd = (hh_ >> 2) & 3; const int t = (hh_ >> 4) & 8191; const bool cq = false;
                const int gr = t >> 6, gc = t & 63; int ks = gr - 4; ks = ks < 0 ? 0 : (ks > 120 ? 120 : ks); int w0 = gc - 8; w0 = w0 < 0 ? 0 : (w0 > 48 ? 48 : w0);
                const long qrow = (long)b * SEQ + t; const float* rp = a.in[I_RPB] + (size_t)(l * 4 + hd) * 465;
                auto krow = [=](int i) -> long { return i < 128 ? (long)b * SEQ + (ks + (i >> 4)) * 64 + w0 + (i & 15) : (long)NLAT + b * CTXL + (i - 128); };
                auto bias = [=](int i) -> float { return i < 128 ? rp[(ks + (i >> 4) - gr + 7) * 31 + (w0 + (i & 15) - gc + 15)] : 0.f; };
                dbg_attn(Z, qrow, hd * 64, 256 + hd * 64, 512 + hd * 64, 64, 384, krow, bias, sc, outv, red, tid);
                if (tid < 64 && dbg_bad(dbg_bf(O, (size_t)qrow * DM + hd * 64 + tid), outv[tid], 0.01f)) bad = true;
                (void)cq;
            } else {
                const unsigned hh_ = dbg_hash(blk * 2 + smp + 999); const int b = hh_ & 3, hd = (hh_ >> 2) & 3; const bool cq = ((hh_ >> 20) & 15) == 0 && (l == 0);
                const long qrow = cq ? (long)NLAT + b * CTXL + ((hh_ >> 4) & 255) : (long)b * SEQ + ((hh_ >> 4) & 8191);
                const int nk = cq ? 256 : 8448;
                auto krow = [=](int i) -> long { return cq ? (long)NLAT + b * CTXL + i : (i < 8192 ? (long)b * SEQ + i : (long)NLAT + b * CTXL + (i - 8192)); };
                auto bias = [=](int i) -> float { return 0.f; };
                dbg_attn(Z, qrow, 1280 + hd * 128, 1792 + hd * 128, 2304 + hd * 128, 128, nk, krow, bias, sc, outv, red, tid);
                dbg_attn(Z, qrow, 1280 + hd * 128 + 64, 1792 + hd * 128 + 64, 2304 + hd * 128, 128, nk, krow, bias, sc, outv2, red, tid);
                float d1 = 0.f, d2 = 0.f; for (int e = 0; e < 64; ++e) { d1 += a.in[I_LQ1][l * 64 + e] * a.in[I_LK1][l * 64 + e]; d2 += a.in[I_LQ2][l * 64 + e] * a.in[I_LK2][l * 64 + e]; }
                const float linit = l == 0 ? 0.2f : 0.35550906759f; const float lam = __expf(d1) - __expf(d2) + linit;
                float ss = 0.f; for (int e = 0; e < 128; ++e) { const float v = outv[e] - lam * outv2[e]; ss += v * v; }
                if (tid < 128) { const float ref = (outv[tid] - lam * outv2[tid]) * rsqrtf(ss / 128.f + 1e-6f) * a.in[I_SUBLN][l * 128 + tid] * (1.0f - linit);
                    if (dbg_bad(dbg_bf(O, (size_t)qrow * DM + 512 + hd * 128 + tid), ref, 0.05f)) bad = true; }
                __syncthreads();
            }
        }
        if (bad) atomicOr(flags, pass == 2 ? 8u : 16u);
    }
    }
    if (sres != 6) {
        const bf16_t* Gb = (const bf16_t*)(a.ws + WS_G);
        const float* w1 = (sres == 2 ? a.in[I_F1W1] : a.in[I_F2W1]) + (size_t)l * 1024 * DFF; const float* w3 = (sres == 2 ? a.in[I_F1W3] : a.in[I_F2W3]) + (size_t)l * 1024 * DFF;
        bool bad = false;
        for (int sidx = tid; sidx < 6 * 60; sidx += 512) {
            const int ri = sidx / 60; const int row = (int)(dbg_hash(blk * 8 + ri + 31337) % (unsigned)NLAT); const int col = ((sidx % 60) * 47 + blk * 11) % DFF;
            float x1 = 0.f, x3 = 0.f;
            for (int k = 0; k < 1024; ++k) { const float hv = dbg_bf(H, (size_t)row * DM + k); x1 += hv * w1[(size_t)k * DFF + col]; x3 += hv * w3[(size_t)k * DFF + col]; }
            const float ref = x1 / (1.0f + __expf(-x1)) * x3;
            if (dbg_bad(dbg_bf(Gb, (size_t)row * DFF + col), ref)) bad = true;
        }
        if (bad) atomicOr(flags, 2u);
    }
    {
        const float* saved = (const float*)(a.ws + WS_DBG + 65536);
        const bf16_t* A = sres == 6 ? O : (const bf16_t*)(a.ws + WS_G); const int K = sres == 6 ? DM : DFF;
        const float* W = sres == 6 ? a.in[I_WOUT] + (size_t)l * DM * DM : (sres == 2 ? a.in[I_F1W2] : a.in[I_F2W2]) + (size_t)l * DFF * DM;
        const int gidx = sres == 2 ? 2 : (sres == 6 ? 5 : 8); const float gs = sres == 6 ? 1.0f : 0.5f;
        bool bad = false;
        for (int sidx = tid; sidx < 64; sidx += 512) {
            const int ri = blk; const int row = (int)(dbg_hash(blk + 4242) % (unsigned)NLAT); const int col = (sidx * 16 + blk) % DM;
            float acc = 0.f; for (int k = 0; k < K; ++k) acc += dbg_bf(A, (size_t)row * K + k) * W[(size_t)k * DM + col];
            const float ref = saved[ri * DM + col] + gs * mod[(size_t)(row >> 13) * NADA + gidx * DM + col] * acc;
            if (dbg_bad(a.out[(size_t)row * DM + col], ref)) bad = true;
        }
        if (bad) atomicOr(flags, 32u);
    }
    if (sres != 6 && blk == 8) {
        const float* modall = (const float*)(a.ws + WS_MOD);
        bool bad = false;
        if (tid < 100) { const int ll = tid & 1, i = (tid >> 1) % 5, j = (tid * 977) % NADA;
            float acc = 0.f; for (int k = 0; k < 1024; ++k) { const float c = i < 4 ? a.in[I_C][i * 1024 + k] : a.in[I_CCTX][k]; acc += c / (1.0f + __expf(-c)) * a.in[I_WADA][(size_t)ll * 1024 * NADA + (size_t)k * NADA + j]; }
            acc += a.in[I_BADA][ll * NADA + j];
            if (dbg_bad(modall[(size_t)(ll * 5 + i) * NADA + j], acc)) bad = true; }
        if (bad) atomicOr(flags, 4u);
    }
    if (sres == 2 && l == 0 && blk == 9) {
        bool bad = false;
        if (tid < 5 * 40) { const int ri = tid / 40; const int row = ri == 0 ? 0 : ri == 1 ? 12345 : ri == 2 ? 32767 : ri == 3 ? 32768 : 33791; const int col = ((tid % 40) * 53) % DM;
            const float* xr = row < NLAT ? a.in[I_X] + (size_t)row * DM : a.in[I_CTX] + (size_t)(row - NLAT) * DM; const int bi = row < NLAT ? row >> 13 : 4;
            float ss = 0.f; for (int k = 0; k < DM; ++k) ss += xr[k] * xr[k];
            const float ref = xr[col] * rsqrtf(ss / DM + 1e-6f) * (1.0f + mod[(size_t)bi * NADA + DM + col]) + mod[(size_t)bi * NADA + col];
            if (dbg_bad(dbg_bf(H, (size_t)row * DM + col), ref)) bad = true; }
        if (bad) atomicOr(flags, 8u);
    }
    if (sres == 6) {
        const float* saved = (const float*)(a.ws + WS_DBG + 65536);
        bool bad = false;
        if (tid < 40) { const int ri = blk; const int row = (int)(dbg_hash(blk + 4242) % (unsigned)NLAT); const int col = ((tid % 40) * 53 + blk) % DM; const int bi = row >> 13;
            float ss = 0.f; for (int k = 0; k < DM; ++k) ss += saved[ri * DM + k] * saved[ri * DM + k];
            const float ref = saved[ri * DM + col] * rsqrtf(ss / DM + 1e-6f) * (1.0f + mod[(size_t)bi * NADA + 4 * DM + col]) + mod[(size_t)bi * NADA + 3 * DM + col];
            if (dbg_bad(dbg_bf(H, (size_t)row * DM + col), ref)) bad = true; }
        if (bad) atomicOr(flags, 64u);
    }
    if (sres == 6 && l == 0 && blk == 10) {
        LAS float* sc = (LAS float*)lds; LAS float* outv = sc + 8448; LAS float* red = outv + 256;
        const int b = 2, hd = 1; const long qrow = (long)NLAT + b * CTXL + 200;
        auto krow = [=](int i) -> long { return (long)NLAT + b * CTXL + i; };
        auto bias = [=](int i) -> float { return 0.f; };
        dbg_attn(Z, qrow, hd * 64, 256 + hd * 64, 512 + hd * 64, 64, 256, krow, bias, sc, outv, red, tid);
        bool bad = false;
        if (tid < 64 && dbg_bad(dbg_bf(O, (size_t)qrow * DM + hd * 64 + tid), outv[tid])) bad = true;
        if (bad) atomicOr(flags, 8u);
    }
}
__device__ __forceinline__ void dbg_save(const Args& a, const float* src, int tid) {
    float* saved = (float*)(a.ws + WS_DBG + 65536);
    { const int row = (int)(dbg_hash(blockIdx.x + 4242) % (unsigned)NLAT); for (int i = tid; i < DM; i += 512) saved[blockIdx.x * DM + i] = src[(size_t)row * DM + i]; }
}
__device__ __forceinline__ void dbg_save2(const Args& a, const float* src, int tid) {
    float* saved = (float*)(a.ws + WS_DBG + 2 * MiB);
    { const int row = (int)(dbg_hash(blockIdx.x + 777) % (unsigned)NLAT); for (int i = tid; i < DM; i += 512) saved[blockIdx.x * DM + i] = src[(size_t)row * DM + i]; }
}
__device__ __forceinline__ void dbg_check2(const Args& a, int tid) {
    const float* saved = (const float*)(a.ws + WS_DBG + 2 * MiB) + blockIdx.x * DM; unsigned* flags = (unsigned*)(a.ws + WS_DBG);
    const int row = (int)(dbg_hash(blockIdx.x + 777) % (unsigned)NLAT);
    float ss = 0.f; for (int k = 0; k < DM; ++k) ss += saved[k] * saved[k];
    bool bad = false;
    for (int c = tid; c < DM; c += 512) { const float ref = saved[c] * rsqrtf(ss / DM + 1e-6f) * a.in[I_FNORM][c]; if (dbg_bad(a.out[(size_t)row * DM + c], ref, 0.01f)) bad = true; }
    if (bad) atomicOr(flags, 64u);
}
__device__ __forceinline__ void dbg_fill(const Args& a, int tid, int G) {
    const unsigned mask = *(const volatile unsigned*)(a.ws + WS_DBG);
    const float c = __builtin_amdgcn_exp2f(0.5f * (float)(mask + 1));
    for (size_t i = (size_t)blockIdx.x * 512 + tid; i < (size_t)NLAT * DM; i += (size_t)G * 512) a.out[i] = c;
}
#endif

#define XB_TMO      128
#define XB_XCNT(j)  (256  + 64 * (j))
#define XB_XSUB(j)  (1280 + 64 * (j))
#define XB_XGEN(j)  (2304 + 64 * (j))
#define XB_TOP      3328
#define XB_TOPGEN   3392
#define XCD_BAR_WORDS 3456
#define XB_SPIN_CAP (1u << 24)

__device__ __forceinline__ unsigned xb_ld(unsigned* p)              { return __hip_atomic_load(p, __ATOMIC_RELAXED, __HIP_MEMORY_SCOPE_AGENT); }
__device__ __forceinline__ unsigned xb_add(unsigned* p, unsigned v) { return __hip_atomic_fetch_add(p, v, __ATOMIC_RELAXED, __HIP_MEMORY_SCOPE_AGENT); }
__device__ __forceinline__ unsigned xb_xcc_id() { return (unsigned)__builtin_amdgcn_s_getreg((3 << 11) | 20) & 0xFu; }
#define XB_SPIN(cond, bar) do { unsigned _sp = 0; while (cond) { __builtin_amdgcn_s_sleep(1); \
    if ((++_sp & 255u) == 0u) { if (xb_ld(&(bar)[XB_TMO])) break; if (_sp > XB_SPIN_CAP) { atomicAdd(&(bar)[XB_TMO], 1u); break; } } } } while (0)

struct XcdBarrier {
    unsigned* bar; unsigned x;
    volatile LAS unsigned* st;
};

__device__ __forceinline__ XcdBarrier xcd_barrier_post(unsigned* bar, volatile LAS unsigned* st) {
    XcdBarrier b; b.bar = bar; b.x = xb_xcc_id(); b.st = st;
    if (threadIdx.x == 0) (void)xb_add(&bar[XB_XCNT(b.x)], 1u);
    return b;
}
__device__ __forceinline__ void xcd_barrier_complete(unsigned* bar, unsigned x, unsigned& nloc, unsigned& nx) {
    const unsigned G = gridDim.x * gridDim.y * gridDim.z;
    unsigned sum, cnt, mine, sp = 0u;
    for (;;) {
        sum = 0u; cnt = 0u; mine = 0u;
#pragma unroll
        for (unsigned j = 0; j < 16; ++j) { const unsigned c = xb_ld(&bar[XB_XCNT(j)]); sum += c; cnt += (c > 0u) ? 1u : 0u; mine = (j == x) ? c : mine; }
        if (sum == G) break;
        __builtin_amdgcn_s_sleep(1);
        if ((++sp & 255u) == 0u) { if (xb_ld(&bar[XB_TMO])) break; if (sp > XB_SPIN_CAP) { atomicAdd(&bar[XB_TMO], 1u); break; } }
    }
    nloc = mine > 0u ? mine : 1u; nx = cnt > 0u ? cnt : 1u;
}

__device__ __forceinline__ void xcd_barrier(const XcdBarrier& b) {
    asm volatile("s_waitcnt vmcnt(0)" ::: "memory");
    __syncthreads();
    if (threadIdx.x == 0) {
        unsigned* bar = b.bar;
        __builtin_amdgcn_s_waitcnt(0);
        unsigned nloc = b.st[0], nx = b.st[1];
        if (nloc == 0u) { xcd_barrier_complete(bar, b.x, nloc, nx); b.st[0] = nloc; b.st[1] = nx; }
        const unsigned old = xb_add(&bar[XB_XSUB(b.x)], 1u);
        const unsigned gen = old / nloc;
        if (old + 1u == (gen + 1u) * nloc) {
            __builtin_amdgcn_fence(__ATOMIC_RELEASE, "agent");
            asm volatile("s_waitcnt vmcnt(0)" ::: "memory");
            const unsigned og = xb_add(&bar[XB_TOP], 1u);
            const unsigned tg = og / nx;
            if (og + 1u == (tg + 1u) * nx) xb_add(&bar[XB_TOPGEN], 1u);
            else XB_SPIN(xb_ld(&bar[XB_TOPGEN]) == tg, bar);
            __builtin_amdgcn_fence(__ATOMIC_ACQUIRE, "agent");
            xb_add(&bar[XB_XGEN(b.x)], 1u);
            asm volatile("s_waitcnt vmcnt(0)" ::: "memory");
        } else {
            XB_SPIN(xb_ld(&bar[XB_XGEN(b.x)]) == gen, bar);
            __builtin_amdgcn_fence(__ATOMIC_ACQUIRE, "agent");
            asm volatile("s_waitcnt vmcnt(0)" ::: "memory");
        }
    }
    __syncthreads();
}

constexpr size_t WS_BAR = 6 * MiB;
__global__ void __launch_bounds__(512, 2) mega_fwd(Args a) {
    extern __shared__ __attribute__((aligned(16))) unsigned char lds_raw[];
    LAS unsigned char* lds = (LAS unsigned char*)lds_raw;
    const int tid0 = threadIdx.x, G = gridDim.x;
    volatile LAS unsigned* MISC = (volatile LAS unsigned*)(lds + 131072 + 512);
    if (tid0 < 2) MISC[tid0] = 0u;
    __syncthreads();
    unsigned* barw = (unsigned*)(a.ws + WS_BAR);
    XcdBarrier xbar; xbar.bar = barw; xbar.x = 0; xbar.st = MISC;
    float* XL = a.out; float* XC = (float*)(a.ws + WS_XC);
    bf16_t* H = (bf16_t*)(a.ws + WS_H); bf16_t* O = (bf16_t*)(a.ws + WS_O); bf16_t* GB = (bf16_t*)(a.ws + WS_G);
    const float* mod = (const float*)(a.ws + WS_MOD);
    for (int step = a.ph_lo; step < a.ph_hi; ++step) {
        int tid = tid0; asm volatile("" : "+v"(tid));
#if DBG_CHECK
        if (step == 100) { dbg_check(a, lds, tid, G, (DBG_STOP - 1) / 10, (DBG_STOP - 1) % 10); continue; }
        if (step == 103) { dbg_save2(a, XL, tid); continue; }
        if (step == 104) { dbg_check2(a, tid); continue; }
        if (step == 102) { dbg_save(a, (DBG_STOP <= 3) ? a.in[I_X] : XL, tid); continue; }
        if (step == 101) { if (DBG_FILL) dbg_fill(a, tid, G); continue; }
        if (step == 0 && blockIdx.x == 0 && tid == 0) *(unsigned*)(a.ws + 5 * MiB) = 0u;
#endif
        if (step == 0) { if (blockIdx.x == 0) for (int i = tid; i < XCD_BAR_WORDS; i += 512) barw[i] = 0u; if (PH_MASK & 1) prologue(a, lds, tid, G); }
        else if (step == NSTEPS - 1) { if (PH_MASK & 2) final_norm_phase(DBG_IDENT ? a.in[I_X] : XL, XL, a.in[I_FNORM], tid, G); }
        else {
            const int l = (step - 1) / 10, s = (step - 1) % 10;
            if (((DBG_SKIP >> s) & 1) && ((DBG_SKIP_LAYERS >> l) & 1)) continue;
            const float* modl = mod + (size_t)l * 5 * NADA;
            const unsigned char* wl = a.ws + WS_W + (size_t)l * WS_WLAYER;
            const bool first = (l == 0 && s <= 2);
            const float* srcL = first ? a.in[I_X] : XL; const float* srcC = first ? a.in[I_CTX] : XC;
            const bool lat_only = (l == 1 && s >= 6);
            const int Mrows = lat_only ? NLAT : MT;
            if (s == 0 || s == 3 || s == 7) { if (PH_MASK & 4)
                modulate_phase(srcL, srcC, H, modl, s == 0 ? 0 : (s == 3 ? 3 : 6), Mrows, tid, G);
            } else if (s == 1 || s == 8) { if (PH_MASK & 8) {
                pg8::Gemm g{H, (const bf16_t*)(wl + (s == 1 ? WO_UP1 : WO_UP2)), Mrows, 2 * DFF, DM}; pg8::StaticOrder S; S.init(Mrows, 2 * DFF, G, (int)blockIdx.x);
                pg8::EpiSwiGLU E{GB, DFF};
                pg8::gemm_phase<pg8::EpiSwiGLU, pg8::StaticOrder, true, true>(lds, g, S, E); }
            } else if (s == 2 || s == 6 || s == 9) { if (PH_MASK & 16) {
                const bf16_t* A = (s == 6) ? O : GB; const int K = (s == 6) ? DM : DFF;
                const bf16_t* Bt = (const bf16_t*)(wl + (s == 2 ? WO_DN1 : (s == 6 ? WO_OUT : WO_DN2)));
                pg8::Gemm g{A, Bt, Mrows, DM, K}; pg8::StaticOrder S; S.init(Mrows, DM, G, (int)blockIdx.x);
                pg8::EpiResid E{srcL, srcC, XL, XC, modl, s == 2 ? 2 : (s == 6 ? 5 : 8), s == 6 ? 1.0f : 0.5f};
                pg8::gemm_phase<pg8::EpiResid, pg8::StaticOrder, true, true>(lds, g, S, E); }
            } else if (s == 4) { if (PH_MASK & 32) {
                pg8::Gemm g{H, (const bf16_t*)(wl + WO_IN), MT, DIN, DM}; pg8::StaticOrder S; S.init(MT, DIN, G, (int)blockIdx.x);
                pg8::EpiInProj E{GB};
                pg8::gemm_phase<pg8::EpiInProj, pg8::StaticOrder, true, true>(lds, g, S, E); }
            } else {
                if (PH_MASK & 64) for (int rep_ = 0; rep_ < REP_MIX; ++rep_) mix_phase(a, lds, l, tid, G, rep_ == 0 ? 7 : REP_MASK);
            }
        }
        if (step + 1 < a.ph_hi) {
            if (step == a.ph_lo) { cg::this_grid().sync(); xbar = xcd_barrier_post(barw, MISC); }
            else xcd_barrier(xbar);
        }
    }
}

extern "C" void kernel_launch(void* const* d_in, const int* in_sizes, int n_in, void* d_out, int out_size, void* d_ws, size_t ws_size, hipStream_t stream) {
    static int grid = 0;
    if (grid == 0) {
        if (n_in != 24 || in_sizes[0] != NLAT * DM || out_size != NLAT * DM || ws_size < WS_END) { fprintf(stderr, "kernel_launch: unexpected shapes (n_in %d, in0 %d, out %d, ws %zu)\n", n_in, n_in > 0 ? in_sizes[0] : -1, out_size, ws_size); grid = -1; return; }
        int dev = 0, cus = 0, per_cu = 0;
        if (hipGetDevice(&dev) != hipSuccess || hipDeviceGetAttribute(&cus, hipDeviceAttributeMultiprocessorCount, dev) != hipSuccess) { grid = -1; return; }
        if (hipFuncSetAttribute((const void*)mega_fwd, hipFuncAttributeMaxDynamicSharedMemorySize, LDS_BYTES) != hipSuccess) { fprintf(stderr, "kernel_launch: hipFuncSetAttribute failed\n"); grid = -1; return; }
        if (hipOccupancyMaxActiveBlocksPerMultiprocessor(&per_cu, (const void*)mega_fwd, 512, LDS_BYTES) != hipSuccess || per_cu < 1) { fprintf(stderr, "kernel_launch: occupancy query gave %d\n", per_cu); per_cu = 1; }
        (void)hipGetLastError();
        grid = cus * (per_cu > 1 ? 1 : per_cu);
    }
    if (grid < 0) return;
    Args a{};
    for (int i = 0; i < 24; ++i) a.in[i] = (const float*)d_in[i];
    a.out = (float*)d_out; a.ws = (unsigned char*)d_ws;
#if ONE_LAUNCH
    a.ph_lo = 0; a.ph_hi = NSTEPS;
    void* args[] = {&a};
    hipError_t e = hipLaunchCooperativeKernel((const void*)mega_fwd, dim3(grid), dim3(512), args, LDS_BYTES, stream);
    if (e != hipSuccess) fprintf(stderr, "cooperative launch failed: %s (grid %d)\n", hipGetErrorString(e), grid);
#else
#if DBG_CHECK
    for (int st = 0; st < DBG_STOP + (DBG_STOP == 20 ? 7 : 4); ++st) { const int k_ = st - DBG_STOP; const int sid = st < DBG_STOP ? st : (k_ == 0 ? 102 : (k_ == 1 ? DBG_STOP : (k_ == 2 ? 100 : (DBG_STOP != 20 ? 101 : (k_ == 3 ? 103 : (k_ == 4 ? 21 : (k_ == 5 ? 104 : 101))))))); a.ph_lo = sid; a.ph_hi = sid + 1; hipLaunchKernelGGL(mega_fwd, dim3(grid), dim3(512), LDS_BYTES, stream, a); }
#else
    for (int st = 0; st < NSTEPS; ++st) { a.ph_lo = st; a.ph_hi = st + 1; hipLaunchKernelGGL(mega_fwd, dim3(grid), dim3(512), LDS_BYTES, stream, a); }
#endif
#endif
}
```

```cpp
#include <hip/hip_runtime.h>
#include <hip/hip_cooperative_groups.h>
#include <cstdio>
#include <cstdint>
namespace cg = cooperative_groups;
#ifndef ONE_LAUNCH
#define ONE_LAUNCH 1
#endif
namespace pg8 {
#define PG8_LAS __attribute__((address_space(3)))
typedef unsigned short bf16_t;
typedef short bf16x8 __attribute__((ext_vector_type(8)));
typedef float f32x4 __attribute__((ext_vector_type(4)));
typedef unsigned u32x4 __attribute__((ext_vector_type(4)));
constexpr int BM = 256, BK = 64, HALF = 128, HTB = HALF * BK * 2  , STAGE_BYTES = 8 * HTB, NXCD = 8, WGM = 8;

__host__ __device__ __forceinline__ int lds_byte(int r, int c) { const int st = (r >> 4) * 2 + (c >> 5), rr = r & 15, cc = c & 31, ob = rr * 64 + cc * 2; return st * 1024 + (ob ^ (((ob >> 9) & 1) << 5)); }
__host__ __device__ __forceinline__ void stage_rc(int b, int& R, int& C) { const int st = b / 1024, sb = b % 1024, swz = sb ^ (((sb >> 9) & 1) << 5); R = (st >> 1) * 16 + swz / 64; C = (st & 1) * 32 + (swz % 64) / 2; }
__host__ __device__ __forceinline__ int perm32(int rho) { const int n = rho >> 4, i = rho & 15; return 8 * (i >> 2) + 4 * n + (i & 3); }

struct Unit { int pm, pn, kh; };
struct Gemm { const bf16_t* A; const bf16_t* Bt; int M, N, K; };

struct StaticOrder {
    int nM, nN, nwg, G, c;
    __host__ __device__ void init(int M, int N, int G_, int c_) { nM = M / BM; nN = N / BM; nwg = nM * nN; G = G_; c = c_; }
    __host__ __device__ bool next(int i, Unit& u) const {
        const long L = (long)i * G + c; if (L >= nwg) return false;
        int wgid = (int)L; { const int q = nwg / NXCD, r = nwg % NXCD, xcd = wgid % NXCD, off = wgid / NXCD; wgid = (xcd < r ? xcd * (q + 1) : r * (q + 1) + (xcd - r) * q) + off; }
        const int nig = WGM * nN, gid = wgid / nig, fm = gid * WGM, gsz = (nM - fm) < WGM ? (nM - fm) : WGM;
        u.pm = fm + ((wgid % nig) % gsz); u.pn = (wgid % nig) / gsz; u.kh = -1; return true;
    }
    __host__ __device__ int parts() const { return 1; }
    __device__ __forceinline__ void a_ready(const Unit&) const {}
    __device__ __forceinline__ void done(const Unit&) const {}
};

struct SplitOrder {
    StaticOrder lat; int nctx, kp;
    __host__ __device__ void init(int G_, int c_, int nctx_tiles, int kparts) { lat.init(128 * BM, 4 * BM, G_, c_); nctx = nctx_tiles; kp = kparts; }
    __host__ __device__ bool next(int i, Unit& u) const {
        const int L = i * lat.G + lat.c;
        if (L < 512) return lat.next(i, u);
        const int idx = L - 512; if (idx >= nctx * 4 * kp) return false;
        u.kh = idx % kp; const int q = idx / kp; u.pn = q & 3; u.pm = 128 + (q >> 2); return true;
    }
    __host__ __device__ int parts() const { return kp; }
    __device__ __forceinline__ void a_ready(const Unit&) const {}
    __device__ __forceinline__ void done(const Unit&) const {}
};

__device__ __forceinline__ unsigned cvt_pk_bf16(float lo, float hi) { unsigned r; asm volatile("v_cvt_pk_bf16_f32 %0, %1, %2" : "=v"(r) : "v"(lo), "v"(hi)); return r; }
typedef float f32x2 __attribute__((ext_vector_type(2)));
__device__ __forceinline__ f32x2 gelu_pk(f32x2 v) {
    const f32x2 av = __builtin_elementwise_abs(v), d = av * 0.2316418882f + 1.0f;
    f32x2 t; t.x = __builtin_amdgcn_rcpf(d.x); t.y = __builtin_amdgcn_rcpf(d.y);
    f32x2 q = t * 0.5307027145f + (-0.7265760135f); q = q * t + 0.7107068705f; q = q * t + (-0.142248368f); q = q * t + 0.127414796f; q = q * t;
    const f32x2 s = (v * v) * (-0.72134752044f);
    f32x2 e; e.x = __builtin_amdgcn_exp2f(s.x); e.y = __builtin_amdgcn_exp2f(s.y);
    const f32x2 m = v * (q * e), r = v - m;
    f32x2 o; o.x = v.x < 0.f ? m.x : r.x; o.y = v.y < 0.f ? m.y : r.y; return o;
}


constexpr int NLAT_ROWS = 32768, DMODEL = 1024, NADA_COLS = 9216;
__device__ __forceinline__ float silu_f(float a) { return a * __builtin_amdgcn_rcpf(1.0f + __builtin_amdgcn_exp2f(-1.4426950408889634f * a)); }

struct EpiSwiGLU {
    static constexpr bool PERM = true, AFTER_DRAIN = false;
    bf16_t* G; int ldc;
    __device__ __forceinline__ void operator()(const f32x4 (&acc)[2][2][4][2], const Unit& u, int wr, int wc, int fr, int fq) const {
        const int row0 = u.pm * BM + wr * 64 + fr; const int col0 = u.pn * HALF + wc * 32 + 8 * fq;
#pragma unroll
        for (int ai = 0; ai < 2; ++ai)
#pragma unroll
            for (int m = 0; m < 4; ++m) {
                bf16_t* rowp = G + (size_t)(row0 + ai * HALF + m * 16) * ldc + col0;
                const f32x4 a0 = acc[ai][0][m][0], a1 = acc[ai][0][m][1], b0 = acc[ai][1][m][0], b1 = acc[ai][1][m][1];
                u32x4 w;
                w.x = cvt_pk_bf16(silu_f(a0[0]) * b0[0], silu_f(a0[1]) * b0[1]); w.y = cvt_pk_bf16(silu_f(a0[2]) * b0[2], silu_f(a0[3]) * b0[3]);
                w.z = cvt_pk_bf16(silu_f(a1[0]) * b1[0], silu_f(a1[1]) * b1[1]); w.w = cvt_pk_bf16(silu_f(a1[2]) * b1[2], silu_f(a1[3]) * b1[3]);
                *(u32x4*)rowp = w;
            }
    }
};

struct EpiInProj {
    static constexpr bool PERM = true, AFTER_DRAIN = false;
    bf16_t* Z;
    __device__ __forceinline__ void operator()(const f32x4 (&acc)[2][2][4][2], const Unit& u, int wr, int wc, int fr, int fq) const {
        const int pn = u.pn; const bool do_gelu = (pn == 3 || pn == 4); const bool do_rope = (pn >= 5 && pn <= 8 && u.pm < 128);
        const int row0 = u.pm * BM + wr * 64 + fr; const int colb = pn * 256 + 64 * wc + 8 * fq;
        float fq8[8];
#pragma unroll
        for (int i = 0; i < 8; ++i) fq8[i] = __builtin_amdgcn_exp2f(-(float)(8 * (fq & 1) + i) * 0.8304820237218406f);
#pragma unroll
        for (int ai = 0; ai < 2; ++ai)
#pragma unroll
            for (int m = 0; m < 4; ++m) {
                const int row = row0 + ai * HALF + m * 16;
                f32x4 a0 = acc[ai][0][m][0], a1 = acc[ai][0][m][1], b0 = acc[ai][1][m][0], b1 = acc[ai][1][m][1];
                if (do_gelu) {
                    f32x2 t;
                    t = gelu_pk((f32x2){a0[0], a0[1]}); a0[0] = t.x; a0[1] = t.y; t = gelu_pk((f32x2){a0[2], a0[3]}); a0[2] = t.x; a0[3] = t.y;
                    t = gelu_pk((f32x2){a1[0], a1[1]}); a1[0] = t.x; a1[1] = t.y; t = gelu_pk((f32x2){a1[2], a1[3]}); a1[2] = t.x; a1[3] = t.y;
                    t = gelu_pk((f32x2){b0[0], b0[1]}); b0[0] = t.x; b0[1] = t.y; t = gelu_pk((f32x2){b0[2], b0[3]}); b0[2] = t.x; b0[3] = t.y;
                    t = gelu_pk((f32x2){b1[0], b1[1]}); b1[0] = t.x; b1[1] = t.y; t = gelu_pk((f32x2){b1[2], b1[3]}); b1[2] = t.x; b1[3] = t.y;
                } else if (do_rope) {
                    const int t = row & 8191; const float fpos = (float)((fq < 2) ? (t >> 6) : (t & 63));
#pragma unroll
                    for (int e = 0; e < 4; ++e) {
                        { const float ang = fpos * fq8[e]; const float c = __cosf(ang), s = __sinf(ang); const float x1 = a0[e], x2 = b0[e]; a0[e] = x1 * c - x2 * s; b0[e] = x1 * s + x2 * c; }
                        { const float ang = fpos * fq8[4 + e]; const float c = __cosf(ang), s = __sinf(ang); const float x1 = a1[e], x2 = b1[e]; a1[e] = x1 * c - x2 * s; b1[e] = x1 * s + x2 * c; }
                    }
                }
                bf16_t* rowp = Z + (size_t)row * 2816 + colb;
                u32x4 w; w.x = cvt_pk_bf16(a0[0], a0[1]); w.y = cvt_pk_bf16(a0[2], a0[3]); w.z = cvt_pk_bf16(a1[0], a1[1]); w.w = cvt_pk_bf16(a1[2], a1[3]);
                *(u32x4*)rowp = w;
                u32x4 v; v.x = cvt_pk_bf16(b0[0], b0[1]); v.y = cvt_pk_bf16(b0[2], b0[3]); v.z = cvt_pk_bf16(b1[0], b1[1]); v.w = cvt_pk_bf16(b1[2], b1[3]);
                *(u32x4*)(rowp + 32) = v;
            }
    }
};

struct EpiResid {
    static constexpr bool PERM = true, AFTER_DRAIN = false;
    const float* srcL; const float* srcC; float* dstL; float* dstC; const float* modl; int gidx; float gscale; float* part;
    __device__ __forceinline__ void operator()(const f32x4 (&acc)[2][2][4][2], const Unit& u, int wr, int wc, int fr, int fq) const {
        const bool lat = u.pm < 128;
        const float* sb = lat ? srcL + (size_t)u.pm * BM * DMODEL : srcC + (size_t)(u.pm - 128) * BM * DMODEL;
        float* db = lat ? dstL + (size_t)u.pm * BM * DMODEL : dstC + (size_t)(u.pm - 128) * BM * DMODEL;
        const float* gate = modl + (size_t)(lat ? (u.pm >> 5) : 4) * NADA_COLS + gidx * DMODEL;
        const int col0 = u.pn * BM + wc * 32 + 8 * fq;
        if (u.kh >= 0) {
            int frl = fr, fql = fq; asm volatile("" : "+v"(frl), "+v"(fql));
            float* pb = part + ((size_t)u.kh * 1024 + (size_t)(u.pm - 128) * BM) * DMODEL + u.pn * BM + wc * 32 + 8 * fql;
#pragma unroll
            for (int ai = 0; ai < 2; ++ai)
#pragma unroll
                for (int m = 0; m < 4; ++m) {
                    float* q = pb + (size_t)(ai * HALF + wr * 64 + m * 16 + frl) * DMODEL;
#pragma unroll
                    for (int bj = 0; bj < 2; ++bj)
#pragma unroll
                        for (int n = 0; n < 2; ++n) *(f32x4*)(q + bj * HALF + n * 4) = acc[ai][bj][m][n];
                }
            return;
        }
        f32x4 g4[2][2];
#pragma unroll
        for (int bj = 0; bj < 2; ++bj)
#pragma unroll
            for (int n = 0; n < 2; ++n) g4[bj][n] = *(const f32x4*)(gate + col0 + bj * HALF + n * 4) * gscale;
#pragma unroll
        for (int ai = 0; ai < 2; ++ai)
#pragma unroll
            for (int m = 0; m < 4; ++m) {
                const size_t off = (size_t)(ai * HALF + wr * 64 + m * 16 + fr) * DMODEL + col0;
#pragma unroll
                for (int bj = 0; bj < 2; ++bj)
#pragma unroll
                    for (int n = 0; n < 2; ++n) {
                        const f32x4 bs = *(const f32x4*)(sb + off + bj * HALF + n * 4);
                        *(f32x4*)(db + off + bj * HALF + n * 4) = bs + g4[bj][n] * acc[ai][bj][m][n];
                    }
                if (m & 1) asm volatile("" ::: "memory");
            }
    }
};
template <class Epi, class Sched, bool ALIGN_EPI = false, bool SP2 = false>
__device__ __forceinline__ void gemm_phase(PG8_LAS unsigned char* lds, const Gemm g, const Sched& S, const Epi& E) {
    int tid_ = threadIdx.x; asm volatile("" : "+v"(tid_));
    const int tid = tid_, wid = __builtin_amdgcn_readfirstlane(tid >> 6), lane = tid & 63, wr = wid >> 2, wc = wid & 3, fr = lane & 15, fq = lane >> 4;
    const int K = g.K, nt = K / BK;
    unsigned voffA[2], voffB[2];
#pragma unroll
    for (int i = 0; i < 2; ++i) { int R, C; stage_rc(tid * 16 + i * 8192, R, C); const int Rb = Epi::PERM ? ((R & ~31) + perm32(R & 31)) : R;
        voffA[i] = (unsigned)(R * K + C) * 2u; voffB[i] = (unsigned)(Rb * K + C) * 2u; }
    const size_t kstep = (size_t)(BK * 2);
    const size_t hstep = (size_t)HALF * K * 2;
    const size_t tstep = 2 * hstep;
    const unsigned ldsw = (unsigned)wid * 1024u;
    const int aoff = lds_byte(wr * 64 + fr, fq * 8), boff = lds_byte(wc * 32 + fr, fq * 8);
#define PG8_SA(b, h) (((b) * 2 + (h)) * HTB)
#define PG8_SB(b, h) ((4 + (b) * 2 + (h)) * HTB)
#define PG8_STAGE(bufoff, gbase, voff) do { _Pragma("unroll") for (int _i = 0; _i < 2; ++_i) \
        __builtin_amdgcn_global_load_lds((const unsigned*)((const char*)(gbase) + (voff)[_i]), (PG8_LAS unsigned*)(lds + (bufoff) + ldsw + _i * 8192), 16, 0, 0); } while (0)
#define PG8_LDA(dst, b, h) do { _Pragma("unroll") for (int m = 0; m < 4; ++m) _Pragma("unroll") for (int k = 0; k < 2; ++k) dst[m][k] = *(const PG8_LAS bf16x8*)(lds + PG8_SA(b, h) + aoff + m * 2048 + k * 1024); } while (0)
#define PG8_LDB(dst, b, h) do { _Pragma("unroll") for (int n = 0; n < 2; ++n) _Pragma("unroll") for (int k = 0; k < 2; ++k) dst[n][k] = *(const PG8_LAS bf16x8*)(lds + PG8_SB(b, h) + boff + n * 2048 + k * 1024); } while (0)
#define PG8_MMA(ai, bj, At, Bt) do { __builtin_amdgcn_s_setprio(1); _Pragma("unroll") for (int m = 0; m < 4; ++m) _Pragma("unroll") for (int n = 0; n < 2; ++n) _Pragma("unroll") for (int k = 0; k < 2; ++k) \
        acc[ai][bj][m][n] = __builtin_amdgcn_mfma_f32_16x16x32_bf16(Bt[n][k], At[m][k], acc[ai][bj][m][n], 0, 0, 0); __builtin_amdgcn_s_setprio(0); } while (0)
#define PG8_WAIT_V(n) asm volatile("s_waitcnt vmcnt(" #n ")" ::: "memory")
#define PG8_WAIT_L(n) asm volatile("s_waitcnt lgkmcnt(" #n ")" ::: "memory")
#define PG8_BAR __builtin_amdgcn_s_barrier()
#define PG8_SCHED __builtin_amdgcn_sched_barrier(0)
    Unit cur, nxt; int ui = 0;
    if (!S.next(0, cur)) return;
    f32x4 acc[2][2][4][2];
#pragma unroll
    for (int a = 0; a < 2; ++a)
#pragma unroll
        for (int b = 0; b < 2; ++b)
#pragma unroll
            for (int m = 0; m < 4; ++m)
#pragma unroll
                for (int n = 0; n < 2; ++n) acc[a][b][m][n] = (f32x4){0.f, 0.f, 0.f, 0.f};
    bf16x8 At[4][2], B0[2][2], B1[2][2];
    const int kpb = (K / S.parts()) * 2;
    const char* cA = (const char*)g.A + (size_t)cur.pm * tstep + (cur.kh > 0 ? cur.kh * kpb : 0); const char* cB = (const char*)g.Bt + (size_t)cur.pn * tstep + (cur.kh > 0 ? cur.kh * kpb : 0);
    S.a_ready(cur);
    if constexpr (SP2) {
        PG8_STAGE(PG8_SB(0, 0), cB, voffB); PG8_STAGE(PG8_SB(0, 1), cB + hstep, voffB); PG8_STAGE(PG8_SA(0, 0), cA, voffA); PG8_STAGE(PG8_SA(0, 1), cA + hstep, voffA);
        if (wr == 1) PG8_BAR;
        PG8_WAIT_V(2); PG8_BAR;
        PG8_STAGE(PG8_SB(1, 0), cB + kstep, voffB); PG8_STAGE(PG8_SA(1, 0), cA + kstep, voffA); PG8_STAGE(PG8_SB(1, 1), cB + hstep + kstep, voffB);
        PG8_WAIT_V(6); PG8_BAR;
    } else {
        PG8_STAGE(PG8_SB(0, 0), cB, voffB); PG8_STAGE(PG8_SA(0, 0), cA, voffA); PG8_STAGE(PG8_SB(0, 1), cB + hstep, voffB); PG8_STAGE(PG8_SA(0, 1), cA + hstep, voffA);
        if (wr == 1) PG8_BAR;
        PG8_WAIT_V(4); PG8_BAR;
        PG8_STAGE(PG8_SB(1, 0), cB + kstep, voffB); PG8_STAGE(PG8_SA(1, 0), cA + kstep, voffA); PG8_STAGE(PG8_SB(1, 1), cB + hstep + kstep, voffB);
        PG8_WAIT_V(6); PG8_BAR;
    }
    for (;;) {
        const bool has_next = S.next(ui + 1, nxt);
        const char* nA = has_next ? (const char*)g.A + (size_t)nxt.pm * tstep + (nxt.kh > 0 ? nxt.kh * kpb : 0) : cA; const char* nB = has_next ? (const char*)g.Bt + (size_t)nxt.pn * tstep + (nxt.kh > 0 ? nxt.kh * kpb : 0) : cB;
        const int ntu = cur.kh >= 0 ? nt / S.parts() : nt;
        for (int t = 0; t < ntu; t += 2) {
            const bool last = (t == ntu - 2);
            const char* a1 = cA + (size_t)(t + 1) * kstep;
            const char* a2 = last ? nA : cA + (size_t)(t + 2) * kstep; const char* b2 = last ? nB : cB + (size_t)(t + 2) * kstep;
            const char* a3 = a2 + kstep; const char* b3 = b2 + kstep;
            if (last && has_next) S.a_ready(nxt);
            if constexpr (SP2) {
            PG8_LDB(B0, 0, 0); PG8_LDB(B1, 0, 1); PG8_SCHED; PG8_LDA(At, 0, 0); PG8_STAGE(PG8_SA(1, 1), a1 + hstep, voffA);
            PG8_WAIT_V(8); PG8_WAIT_L(0); PG8_BAR; PG8_MMA(0, 0, At, B0); PG8_MMA(0, 1, At, B1); PG8_BAR; PG8_SCHED;
            PG8_LDA(At, 0, 1); PG8_STAGE(PG8_SB(0, 0), b2, voffB); PG8_STAGE(PG8_SB(0, 1), b2 + hstep, voffB); PG8_STAGE(PG8_SA(0, 0), a2, voffA);
            PG8_WAIT_V(8); PG8_WAIT_L(0); PG8_BAR; PG8_MMA(1, 0, At, B0); PG8_MMA(1, 1, At, B1); PG8_BAR; PG8_SCHED;
            PG8_LDB(B0, 1, 0); PG8_LDB(B1, 1, 1); PG8_SCHED; PG8_LDA(At, 1, 0); PG8_STAGE(PG8_SA(0, 1), a2 + hstep, voffA);
            PG8_WAIT_V(8); PG8_WAIT_L(0); PG8_BAR; PG8_MMA(0, 0, At, B0); PG8_MMA(0, 1, At, B1); PG8_BAR; PG8_SCHED;
            PG8_LDA(At, 1, 1); PG8_STAGE(PG8_SB(1, 0), b3, voffB); PG8_STAGE(PG8_SB(1, 1), b3 + hstep, voffB); PG8_STAGE(PG8_SA(1, 0), a3, voffA);
            PG8_WAIT_V(8); PG8_WAIT_L(0); PG8_BAR; PG8_MMA(1, 0, At, B0); PG8_MMA(1, 1, At, B1); PG8_BAR; PG8_SCHED;
            } else {
            PG8_LDB(B0, 0, 0); PG8_SCHED; PG8_LDA(At, 0, 0); PG8_STAGE(PG8_SA(1, 1), a1 + hstep, voffA);
            PG8_WAIT_L(8); PG8_BAR; PG8_WAIT_L(0); PG8_MMA(0, 0, At, B0); PG8_BAR; PG8_SCHED;
            PG8_LDB(B1, 0, 1); PG8_STAGE(PG8_SB(0, 0), b2, voffB);
            PG8_BAR; PG8_WAIT_L(0); PG8_MMA(0, 1, At, B1); PG8_BAR;
            PG8_LDA(At, 0, 1); PG8_STAGE(PG8_SA(0, 0), a2, voffA);
            PG8_BAR; PG8_WAIT_L(0); PG8_MMA(1, 0, At, B0); PG8_BAR; PG8_SCHED;
            PG8_STAGE(PG8_SB(0, 1), b2 + hstep, voffB);
            PG8_WAIT_V(6); PG8_BAR; PG8_MMA(1, 1, At, B1); PG8_BAR;
            PG8_LDB(B0, 1, 0); PG8_SCHED; PG8_LDA(At, 1, 0); PG8_STAGE(PG8_SA(0, 1), a2 + hstep, voffA);
            PG8_WAIT_L(8); PG8_BAR; PG8_WAIT_L(0); PG8_MMA(0, 0, At, B0); PG8_BAR; PG8_SCHED;
            PG8_LDB(B1, 1, 1); PG8_STAGE(PG8_SB(1, 0), b3, voffB);
            PG8_BAR; PG8_WAIT_L(0); PG8_MMA(0, 1, At, B1); PG8_BAR;
            PG8_LDA(At, 1, 1); PG8_STAGE(PG8_SA(1, 0), a3, voffA);
            PG8_BAR; PG8_WAIT_L(0); PG8_MMA(1, 0, At, B0); PG8_BAR; PG8_SCHED;
            PG8_STAGE(PG8_SB(1, 1), b3 + hstep, voffB);
            PG8_WAIT_V(6); PG8_BAR; PG8_MMA(1, 1, At, B1); PG8_BAR;
            }
        }
        if constexpr (ALIGN_EPI) { if (wr == 0) PG8_BAR; }
        if constexpr (!Epi::AFTER_DRAIN) { E(acc, cur, wr, wc, fr, fq); S.done(cur); }
        if (!has_next) break;
#pragma unroll
        for (int a = 0; a < 2; ++a)
#pragma unroll
            for (int b = 0; b < 2; ++b)
#pragma unroll
                for (int m = 0; m < 4; ++m)
#pragma unroll
                    for (int n = 0; n < 2; ++n) acc[a][b][m][n] = (f32x4){0.f, 0.f, 0.f, 0.f};
        cur = nxt; cA = nA; cB = nB; ++ui;
        if constexpr (ALIGN_EPI) { if (wr == 1) PG8_BAR; }
    }
    PG8_WAIT_V(0);
    if constexpr (!ALIGN_EPI) { if (wr == 0) PG8_BAR; }
    PG8_BAR;
    if constexpr (Epi::AFTER_DRAIN) { E.fused(acc, cur, wr, wc, fr, fq, lds, wid, lane); S.done(cur); }
#undef PG8_SA
#undef PG8_SB
#undef PG8_STAGE
#undef PG8_LDA
#undef PG8_LDB
#undef PG8_MMA
#undef PG8_WAIT_V
#undef PG8_WAIT_L
#undef PG8_BAR
#undef PG8_SCHED
}
}

#define LAS __attribute__((address_space(3)))
typedef unsigned short bf16_t;
constexpr int DM = 1024, NBATCH = 4, SEQ = 8192, CTXL = 256, NLAT = NBATCH * SEQ, NCTX = NBATCH * CTXL, MT = NLAT + NCTX, DFF = 2816, DIN = 2816, NADA = 9216;
constexpr size_t MiB = 1u << 20;
constexpr size_t WS_MOD = 0, WS_XC = 1 * MiB, WS_W = 8 * MiB, WS_WLAYER = 41 * MiB, WS_H = 90 * MiB, WS_O = 156 * MiB, WS_G = 222 * MiB, WS_END = 404 * MiB;
constexpr size_t WO_UP1 = 0, WO_DN1 = 11534336, WO_IN = WO_DN1 + 5767168, WO_OUT = WO_IN + 5767168, WO_UP2 = WO_OUT + 2097152, WO_DN2 = WO_UP2 + 11534336;
static_assert(WO_DN2 + 5767168 <= WS_WLAYER, "weights per layer");
constexpr int LDS_BYTES = 135168;

#ifndef DBG_INJECT
#define DBG_INJECT 0.0f
#endif
namespace fa {
typedef short bf16x8 __attribute__((ext_vector_type(8)));
typedef short s16x4 __attribute__((ext_vector_type(4)));
typedef float f32x16 __attribute__((ext_vector_type(16)));
typedef float f32x4 __attribute__((ext_vector_type(4)));
typedef unsigned u32x4 __attribute__((ext_vector_type(4)));
typedef unsigned u32x2 __attribute__((ext_vector_type(2)));
typedef float f32x2_t __attribute__((ext_vector_type(2)));
typedef __bf16 bf16x2_t __attribute__((ext_vector_type(2)));
__device__ __forceinline__ unsigned cvtpk(float lo, float hi) { f32x2_t v = {lo, hi}; bf16x2_t b = __builtin_convertvector(v, bf16x2_t); return __builtin_bit_cast(unsigned, b); }
__device__ __forceinline__ float bf2f(unsigned short b) { return __uint_as_float(((unsigned)b) << 16); }
__device__ __forceinline__ float max3f(float a, float b, float c) { float r; asm("v_max3_f32 %0, %1, %2, %3" : "=v"(r) : "v"(a), "v"(b), "v"(c)); return r; }
__device__ __forceinline__ float xmax32(float v) { auto rr = __builtin_amdgcn_permlane32_swap(__float_as_uint(v), __float_as_uint(v), false, false); return fmaxf(__uint_as_float(rr[0]), __uint_as_float(rr[1])); }
__device__ __forceinline__ float xsum32(float v) { auto rr = __builtin_amdgcn_permlane32_swap(__float_as_uint(v), __float_as_uint(v), false, false); return __uint_as_float(rr[0]) + __uint_as_float(rr[1]); }
__device__ __forceinline__ s16x4 vtr(const LAS unsigned char* p) { return __builtin_bit_cast(s16x4, __builtin_amdgcn_ds_read_tr16_b64_v4i16((LAS s16x4*)p)); }
__device__ __forceinline__ float lane_xor(float v, int lane, int o) { return __builtin_bit_cast(float, __builtin_amdgcn_ds_bpermute((lane ^ o) << 2, __builtin_bit_cast(int, v))); }
__device__ __forceinline__ float wave_sum(float v, int lane) {
#pragma unroll
    for (int o = 1; o < 64; o <<= 1) v += lane_xor(v, lane, o);
    return v;
}

template <int KW, int VW> struct Geo {
    static constexpr int KSTR = KW * 2 + 16, VSTR = VW * 2 + 64;
    static constexpr int KBYTES = 64 * KSTR, VBYTES = 64 * VSTR, BUF = KBYTES + VBYTES;
    static constexpr int KCH = KW / 8, VCH = VW / 8;
    static constexpr int NCH = (64 * (KCH + VCH)) / 512;
};
template <int KW, int VW, int NCHP = Geo<KW, VW>::NCH>
__device__ __forceinline__ void st_load(u32x4 (&st)[NCHP], const bf16_t* Z, long rowbase, int kcol0, int vcol0, int tid) {
    using G = Geo<KW, VW>;
#pragma unroll
    for (int i = 0; i < G::NCH; ++i) {
        const int c = tid + i * 512;
        if (i * 512 < 64 * G::KCH) { const int key = c / G::KCH, ch = c % G::KCH; st[i] = *(const u32x4*)(Z + (size_t)(rowbase + key) * DIN + kcol0 + ch * 8); }
        else { const int c2 = c - 64 * G::KCH; const int key = c2 / G::VCH, ch = c2 % G::VCH; st[i] = *(const u32x4*)(Z + (size_t)(rowbase + key) * DIN + vcol0 + ch * 8); }
    }
}
template <int KW, int VW, int NCHP = Geo<KW, VW>::NCH>
__device__ __forceinline__ void st_store(LAS unsigned char* buf, const u32x4 (&st)[NCHP], int tid) {
    using G = Geo<KW, VW>;
#pragma unroll
    for (int i = 0; i < G::NCH; ++i) {
        const int c = tid + i * 512;
        if (i * 512 < 64 * G::KCH) { const int key = c / G::KCH, ch = c % G::KCH; *(LAS u32x4*)(buf + key * G::KSTR + ch * 16) = st[i]; }
        else { const int c2 = c - 64 * G::KCH; const int key = c2 / G::VCH, ch = c2 % G::VCH; *(LAS u32x4*)(buf + G::KBYTES + key * G::VSTR + ch * 16) = st[i]; }
    }
}
__device__ __forceinline__ f32x16 qk32(const LAS unsigned char* kp, const bf16x8 (&qf)[4]) {
    f32x16 s = {0.f, 0.f, 0.f, 0.f, 0.f, 0.f, 0.f, 0.f, 0.f, 0.f, 0.f, 0.f, 0.f, 0.f, 0.f, 0.f};
#pragma unroll
    for (int ks = 0; ks < 4; ++ks) { const bf16x8 kf = *(const LAS bf16x8*)(kp + ks * 32); s = __builtin_amdgcn_mfma_f32_32x32x16_bf16(kf, qf[ks], s, 0, 0, 0); }
    return s;
}
template <int NDB, int VSTR>
__device__ __forceinline__ void pv32(f32x16 (&o)[NDB], const LAS unsigned char* vp, const f32x16& p) {
#pragma unroll
    for (int s = 0; s < 2; ++s) {
        u32x4 w; w.x = cvtpk(p[8 * s + 0], p[8 * s + 1]); w.y = cvtpk(p[8 * s + 2], p[8 * s + 3]); w.z = cvtpk(p[8 * s + 4], p[8 * s + 5]); w.w = cvtpk(p[8 * s + 6], p[8 * s + 7]);
        const bf16x8 pf = __builtin_bit_cast(bf16x8, w);
#pragma unroll
        for (int db = 0; db < NDB; ++db) {
            const s16x4 lo = vtr(vp + (16 * s) * VSTR + 64 * db), hi = vtr(vp + (16 * s + 8) * VSTR + 64 * db);
            const bf16x8 vf = {lo[0], lo[1], lo[2], lo[3], hi[0], hi[1], hi[2], hi[3]};
            o[db] = __builtin_amdgcn_mfma_f32_32x32x16_bf16(vf, pf, o[db], 0, 0, 0);
        }
    }
}
template <int NDB>
__device__ __forceinline__ void sm_update(f32x16& s0, f32x16& s1, float& m, float& l, f32x16 (&o)[NDB]) {
    float pm = fmaxf(s0[0], s1[0]);
#pragma unroll
    for (int r = 1; r < 16; ++r) pm = fmaxf(pm, fmaxf(s0[r], s1[r]));
    pm = xmax32(pm);
    if (!__all(pm - m <= 8.0f)) {
        const float mn = fmaxf(m, pm); const float alpha = __builtin_amdgcn_exp2f(m - mn); m = mn; l *= alpha;
#pragma unroll
        for (int db = 0; db < NDB; ++db)
#pragma unroll
            for (int r = 0; r < 16; ++r) o[db][r] *= alpha;
    }
    float ps = 0.f;
#pragma unroll
    for (int r = 0; r < 16; ++r) { s0[r] = __builtin_amdgcn_exp2f(s0[r] - m); s1[r] = __builtin_amdgcn_exp2f(s1[r] - m); ps += s0[r] + s1[r]; }
    l += ps;
}
constexpr float QK_C = 0.125f * 1.4426950408889634f;

template <int NDB>
__device__ __forceinline__ void sm_update_raw(f32x16& s0, f32x16& s1, float& m, float& l, f32x16 (&o)[NDB]) {
    float pm = max3f(s0[0], s1[0], s0[1]);
    pm = max3f(pm, s1[1], s1[1]);
#pragma unroll
    for (int r = 2; r < 16; ++r) pm = max3f(pm, s0[r], s1[r]);
    pm = xmax32(pm) * QK_C;
    if (!__all(pm - m <= 8.0f)) {
        const float mn = fmaxf(m, pm); const float alpha = __builtin_amdgcn_exp2f(m - mn); m = mn; l *= alpha;
#pragma unroll
        for (int db = 0; db < NDB; ++db)
#pragma unroll
            for (int r = 0; r < 16; ++r) o[db][r] *= alpha;
    }
    const float nm = -m; float ps = 0.f;
#pragma unroll
    for (int r = 0; r < 16; ++r) { s0[r] = __builtin_amdgcn_exp2f(fmaf(s0[r], QK_C, nm)); s1[r] = __builtin_amdgcn_exp2f(fmaf(s1[r], QK_C, nm)); ps += s0[r] + s1[r]; }
    l += ps;
}

__device__ __forceinline__ void glds16(const void* gsrc, unsigned lds_dst) { unsigned keep;
    asm volatile("s_mov_b32 %0, m0\n\ts_mov_b32 m0, %2\n\ts_nop 0\n\tglobal_load_lds_dwordx4 %1, off\n\ts_mov_b32 m0, %0" : "=&s"(keep) : "v"(gsrc), "s"(lds_dst) : "memory"); }
#define FA_WAIT_BAR(N) asm volatile("s_waitcnt vmcnt(" #N ") lgkmcnt(0)\n\ts_barrier" ::: "memory")
__device__ __forceinline__ f32x16 qk32s(const LAS unsigned char* kslot, const int (&ko)[4], const bf16x8 (&qf)[4]) {
    f32x16 s = {0.f, 0.f, 0.f, 0.f, 0.f, 0.f, 0.f, 0.f, 0.f, 0.f, 0.f, 0.f, 0.f, 0.f, 0.f, 0.f};
#pragma unroll
    for (int ks = 0; ks < 4; ++ks) { const bf16x8 kf = *(const LAS bf16x8*)(kslot + ko[ks]); s = __builtin_amdgcn_mfma_f32_32x32x16_bf16(kf, qf[ks], s, 0, 0, 0); }
    return s;
}
__device__ __forceinline__ void pv32d(f32x16 (&o)[4], const LAS unsigned char* vp, const f32x16& p) {
#pragma unroll
    for (int s = 0; s < 2; ++s) {
        u32x4 w; w.x = cvtpk(p[8 * s + 0], p[8 * s + 1]); w.y = cvtpk(p[8 * s + 2], p[8 * s + 3]); w.z = cvtpk(p[8 * s + 4], p[8 * s + 5]); w.w = cvtpk(p[8 * s + 6], p[8 * s + 7]);
        const bf16x8 pf = __builtin_bit_cast(bf16x8, w);
#pragma unroll
        for (int db = 0; db < 4; ++db) {
            const s16x4 lo = vtr(vp + (16 * s) * 64 + 4096 * db), hi = vtr(vp + (16 * s + 8) * 64 + 4096 * db);
            const bf16x8 vf = {lo[0], lo[1], lo[2], lo[3], hi[0], hi[1], hi[2], hi[3]};
            o[db] = __builtin_amdgcn_mfma_f32_32x32x16_bf16(vf, pf, o[db], 0, 0, 0);
        }
    }
}
__device__ __forceinline__ void diff_unit(LAS unsigned char* lds, const bf16_t* Z, bf16_t* O, int b, int hd, int q0row, int nlat_tiles, float lam, float oscale, const float* subln, int tid) {
    constexpr int KSLOT = 16384, VRING = 4 * KSLOT;
    const int lane = tid & 63, w = __builtin_amdgcn_readfirstlane(tid >> 6), r32 = lane & 31, h = lane >> 5;
    const int comp = w & 1, qblk = w >> 1;
    const int kcol0 = 1792 + hd * 128, vcol0 = 2304 + hd * 128;
    const unsigned lds0 = (unsigned)(size_t)lds;
    long kg[2], vg[2];
#pragma unroll
    for (int i = 0; i < 2; ++i) {
        const int krow = 8 * w + 4 * i + (lane >> 4);
        kg[i] = ((long)krow * DIN + kcol0 + (((lane & 15) ^ (krow & 7)) * 8)) * 2;
        const int vkey = 32 * (w & 1) + 16 * i + (lane >> 2);
        vg[i] = ((long)vkey * DIN + vcol0 + 32 * (w >> 1) + 8 * (lane & 3)) * 2;
    }
    const unsigned kdst = lds0 + (unsigned)(2 * w) * 1024u, vdst = lds0 + VRING + (unsigned)(2 * w) * 1024u;
#define DIFF_TROW(t) ((t) < nlat_tiles ? (long)b * SEQ + 64 * (t) : (long)NLAT + b * CTXL + 64 * ((t) - nlat_tiles))
#define DIFF_DMA(t) do { const char* tb_ = (const char*)Z + DIFF_TROW(t) * (long)(DIN * 2); const unsigned sl_ = (unsigned)(((t) & 3) * KSLOT); \
        glds16(tb_ + kg[0], (unsigned)__builtin_amdgcn_readfirstlane(kdst + sl_)); glds16(tb_ + kg[1], (unsigned)__builtin_amdgcn_readfirstlane(kdst + sl_ + 1024u)); \
        glds16(tb_ + vg[0], (unsigned)__builtin_amdgcn_readfirstlane(vdst + sl_)); glds16(tb_ + vg[1], (unsigned)__builtin_amdgcn_readfirstlane(vdst + sl_ + 1024u)); } while (0)
    const int NT = nlat_tiles + 4;
    DIFF_DMA(0); DIFF_DMA(1); DIFF_DMA(2);
    bf16x8 qf[4];
    { const bf16_t* qp = Z + (size_t)(q0row + 32 * qblk + r32) * DIN + 1280 + hd * 128 + comp * 64 + 8 * h;
#pragma unroll
      for (int ks = 0; ks < 4; ++ks) qf[ks] = *(const bf16x8*)(qp + 16 * ks); }
    f32x16 o[4];
#pragma unroll
    for (int db = 0; db < 4; ++db)
#pragma unroll
        for (int r = 0; r < 16; ++r) o[db][r] = 0.f;
    float m = -1e30f, l = 0.f;
    int ko[4];
#pragma unroll
    for (int ks = 0; ks < 4; ++ks) ko[ks] = r32 * 256 + (((comp * 8 + 2 * ks + h) ^ (r32 & 7)) << 4);
    const int voff = VRING + (4 * h + ((lane & 15) >> 2)) * 64 + (16 * ((lane >> 4) & 1) + 4 * (lane & 3)) * 2;
    asm volatile("s_waitcnt vmcnt(0)" ::: "memory");
    FA_WAIT_BAR(0);
    for (int t = 0; t < NT; ++t) {
        if (t + 3 < NT) DIFF_DMA(t + 3);
        const LAS unsigned char* kslot = lds + (t & 3) * KSLOT;
        bf16x8 kf[8];
#pragma unroll
        for (int i = 0; i < 8; ++i) kf[i] = *(const LAS bf16x8*)(kslot + ko[i & 3] + (i >> 2) * 8192);
        const LAS unsigned char* vs = lds + voff + (t & 3) * KSLOT;
        s16x4 va[8], vb[8];
#define DIFF_VLD(dst, g) do { _Pragma("unroll") for (int db = 0; db < 4; ++db) { dst[2 * db] = vtr(vs + (16 * (g)) * 64 + 4096 * db); dst[2 * db + 1] = vtr(vs + (16 * (g) + 8) * 64 + 4096 * db); } } while (0)
        DIFF_VLD(va, 0);
        DIFF_VLD(vb, 1);
        __builtin_amdgcn_sched_barrier(0);
        f32x16 s0 = {0.f, 0.f, 0.f, 0.f, 0.f, 0.f, 0.f, 0.f, 0.f, 0.f, 0.f, 0.f, 0.f, 0.f, 0.f, 0.f}, s1 = s0;
        __builtin_amdgcn_s_setprio(1);
#pragma unroll
        for (int ks = 0; ks < 4; ++ks) { s0 = __builtin_amdgcn_mfma_f32_32x32x16_bf16(kf[ks], qf[ks], s0, 0, 0, 0); s1 = __builtin_amdgcn_mfma_f32_32x32x16_bf16(kf[4 + ks], qf[ks], s1, 0, 0, 0); }
        __builtin_amdgcn_s_setprio(0);
        __builtin_amdgcn_sched_barrier(0);
        sm_update_raw<4>(s0, s1, m, l, o);
        bf16x8 pf[4];
#pragma unroll
        for (int g = 0; g < 4; ++g) { const f32x16& p = (g < 2) ? s0 : s1; const int e = 8 * (g & 1);
            u32x4 wv; wv.x = cvtpk(p[e + 0], p[e + 1]); wv.y = cvtpk(p[e + 2], p[e + 3]); wv.z = cvtpk(p[e + 4], p[e + 5]); wv.w = cvtpk(p[e + 6], p[e + 7]); pf[g] = __builtin_bit_cast(bf16x8, wv); }
        __builtin_amdgcn_sched_barrier(0);
#define DIFF_PV(src, g) do { __builtin_amdgcn_s_setprio(1); _Pragma("unroll") for (int db = 0; db < 4; ++db) { const bf16x8 vf = {src[2 * db][0], src[2 * db][1], src[2 * db][2], src[2 * db][3], src[2 * db + 1][0], src[2 * db + 1][1], src[2 * db + 1][2], src[2 * db + 1][3]}; \
            o[db] = __builtin_amdgcn_mfma_f32_32x32x16_bf16(vf, pf[g], o[db], 0, 0, 0); } __builtin_amdgcn_s_setprio(0); } while (0)
        DIFF_PV(va, 0);  __builtin_amdgcn_sched_barrier(0);
        DIFF_VLD(va, 2); __builtin_amdgcn_sched_barrier(0);
        DIFF_PV(vb, 1);  __builtin_amdgcn_sched_barrier(0);
        DIFF_VLD(vb, 3); __builtin_amdgcn_sched_barrier(0);
        DIFF_PV(va, 2);  __builtin_amdgcn_sched_barrier(0);
        DIFF_PV(vb, 3);  __builtin_amdgcn_sched_barrier(0);
#undef DIFF_VLD
#undef DIFF_PV
        if (t + 3 < NT) FA_WAIT_BAR(8); else if (t + 2 < NT) FA_WAIT_BAR(4); else FA_WAIT_BAR(0);
    }
#undef DIFF_TROW
#undef DIFF_DMA
    int tid_e = tid; asm volatile("" : "+v"(tid_e));
    const int lane_e = tid_e & 63, r32e = lane_e & 31, he = lane_e >> 5;
    l = xsum32(l); const float inv = 1.0f / l;
    LAS float* ex = (LAS float*)lds + qblk * 4096;
    if (comp == 1) {
#pragma unroll
        for (int db = 0; db < 4; ++db)
#pragma unroll
            for (int r = 0; r < 16; ++r) ex[(db * 16 + r) * 64 + lane_e] = o[db][r] * inv;
    }
    __syncthreads();
    if (comp == 0) {
        float ss = 0.f;
#pragma unroll
        for (int db = 0; db < 4; ++db)
#pragma unroll
            for (int r = 0; r < 16; ++r) { const float v = o[db][r] * inv - lam * ex[(db * 16 + r) * 64 + lane_e]; o[db][r] = v; ss += v * v; }
        ss = xsum32(ss);
        const float rstd = rsqrtf(ss * (1.0f / 128.0f) + 1e-6f) * oscale;
        bf16_t* op = O + (size_t)(q0row + 32 * qblk + r32e) * DM + 512 + hd * 128 + 4 * he;
#pragma unroll
        for (int db = 0; db < 4; ++db)
#pragma unroll
            for (int i = 0; i < 4; ++i) {
                const f32x4 g = *(const f32x4*)(subln + 32 * db + 8 * i + 4 * he);
                u32x2 wv; wv.x = cvtpk(o[db][4 * i + 0] * rstd * g[0], o[db][4 * i + 1] * rstd * g[1]); wv.y = cvtpk(o[db][4 * i + 2] * rstd * g[2], o[db][4 * i + 3] * rstd * g[3]);
                *(u32x2*)(op + 32 * db + 8 * i) = wv;
            }
    }
    __syncthreads();
}

constexpr int NA_RPB_OFF = 49152;
__device__ __forceinline__ void na_unit(LAS unsigned char* lds, const bf16_t* Z, bf16_t* O, const float* rpb_h, int b, int hd, int r0, int ctxq, int tid) {
    using G = Geo<64, 64>;
    const int lane = tid & 63, w = __builtin_amdgcn_readfirstlane(tid >> 6), r32 = lane & 31, h = lane >> 5;
    const int gr = r0 + (w >> 1), hh = w & 1;
    const int kcol0 = 256 + hd * 64, vcol0 = 512 + hd * 64;
    const long qrow = ctxq ? (long)NLAT + b * CTXL + 32 * w + r32 : (long)b * SEQ + gr * 64 + 32 * hh + r32;
    LAS float* rpbL = (LAS float*)(lds + NA_RPB_OFF);
    if (tid < 465) rpbL[tid] = rpb_h[tid] * 1.4426950408889634f;
    bf16x8 qf[4];
    { const bf16_t* qp = Z + (size_t)qrow * DIN + hd * 64 + 8 * h;
#pragma unroll
      for (int ks = 0; ks < 4; ++ks) qf[ks] = *(const bf16x8*)(qp + 16 * ks); }
    f32x16 o[2];
#pragma unroll
    for (int db = 0; db < 2; ++db)
#pragma unroll
        for (int r = 0; r < 16; ++r) o[db][r] = 0.f;
    float m = -1e30f, l = 0.f;
    int kr_lo = r0 - 4; kr_lo = kr_lo < 0 ? 0 : (kr_lo > 120 ? 120 : kr_lo);
    int kr_hi = r0 + 3 - 4; kr_hi = (kr_hi < 0 ? 0 : (kr_hi > 120 ? 120 : kr_hi)) + 7;
    const int NT = ctxq ? 4 : 4 + (kr_hi - kr_lo + 1);
    int ks0 = gr - 4; ks0 = ks0 < 0 ? 0 : (ks0 > 120 ? 120 : ks0);
    const int qcol = 32 * hh + r32; int w0 = qcol - 8; w0 = w0 < 0 ? 0 : (w0 > 48 ? 48 : w0);
    const int koff = r32 * G::KSTR + 16 * h;
    const int voff = G::KBYTES + (4 * h + ((lane & 15) >> 2)) * G::VSTR + (16 * ((lane >> 4) & 1) + 4 * (lane & 3)) * 2;
    u32x4 st[G::NCH];
#define NA_TROW(t) ((t) < 4 ? (long)NLAT + b * CTXL + 64 * (t) : (long)b * SEQ + (kr_lo + (t) - 4) * 64)
    u32x4 stB[G::NCH];
    st_load<64, 64>(st, Z, NA_TROW(0), kcol0, vcol0, tid);
    st_store<64, 64>(lds, st, tid);
    st_load<64, 64>(st, Z, NA_TROW(1), kcol0, vcol0, tid);
    __syncthreads();
    for (int t0 = 0; t0 < NT; t0 += 2) {
#pragma unroll
    for (int u = 0; u < 2; ++u) {
        const int t = t0 + u;
        if (t < NT) {
        LAS unsigned char* cur = lds + (t & 1) * G::BUF; LAS unsigned char* nxt = lds + ((t + 1) & 1) * G::BUF;
        if (t + 2 < NT) { if (u == 0) st_load<64, 64>(stB, Z, NA_TROW(t + 2), kcol0, vcol0, tid); else st_load<64, 64>(st, Z, NA_TROW(t + 2), kcol0, vcol0, tid); }
        const int kr = kr_lo + t - 4;
        const bool active = (t < 4) || (kr >= ks0 && kr < ks0 + 8);
        if (active) {
            f32x16 s0 = qk32(cur + koff, qf), s1 = qk32(cur + koff + 32 * G::KSTR, qf);
            if (t < 4) {
#pragma unroll
                for (int r = 0; r < 16; ++r) { s0[r] *= QK_C; s1[r] *= QK_C; }
            } else {
                const LAS float* brow = rpbL + (kr - gr + 7) * 31;
                int hq = 4 * h - qcol + 15, hw = 4 * h - w0;
                asm volatile("" : "+v"(hq), "+v"(hw));
#pragma unroll
                for (int r = 0; r < 16; ++r) {
                    const int cr = (r & 3) + 8 * (r >> 2);
                    { const int d = cr + hq; const int dc = d < 0 ? 0 : (d > 30 ? 30 : d); const bool ok = (unsigned)(cr + hw) < 16u; const float bias = brow[dc]; s0[r] = ok ? fmaf(s0[r], QK_C, bias) : -1e30f; }
                    { const int d = cr + 32 + hq; const int dc = d < 0 ? 0 : (d > 30 ? 30 : d); const bool ok = (unsigned)(cr + 32 + hw) < 16u; const float bias = brow[dc]; s1[r] = ok ? fmaf(s1[r], QK_C, bias) : -1e30f; }
                }
            }
            sm_update<2>(s0, s1, m, l, o);
            pv32<2, G::VSTR>(o, cur + voff, s0);
            pv32<2, G::VSTR>(o, cur + voff + 32 * G::VSTR, s1);
        }
        if (t + 1 < NT) { if (u == 0) st_store<64, 64>(nxt, st, tid); else st_store<64, 64>(nxt, stB, tid); }
        __syncthreads();
        }
    }
    }
#undef NA_TROW
    l = xsum32(l); const float inv = 1.0f / l;
    bf16_t* op = O + (size_t)qrow * DM + hd * 64 + 4 * h;
#pragma unroll
    for (int db = 0; db < 2; ++db)
#pragma unroll
        for (int i = 0; i < 4; ++i) {
            u32x2 wv; wv.x = cvtpk(o[db][4 * i + 0] * inv, o[db][4 * i + 1] * inv); wv.y = cvtpk(o[db][4 * i + 2] * inv, o[db][4 * i + 3] * inv);
            *(u32x2*)(op + 32 * db + 8 * i) = wv;
        }
    __syncthreads();
}

__device__ __forceinline__ void gmlp_unit(LAS unsigned char* lds, const bf16_t* Z, bf16_t* O, const float* ws_g  , const float* bs_g  , const float* gn_g  , long row0, int g, int tid) {
    constexpr int STR = 272;
    LAS unsigned char* WsL = lds; LAS unsigned char* vnT = lds + 128 * STR;
    const int lane = tid & 63, w = __builtin_amdgcn_readfirstlane(tid >> 6), r32 = lane & 31, h = lane >> 5;
#pragma unroll
    for (int i = 0; i < 8; ++i) {
        const int c = tid + i * 512; const int p = c >> 5, q4 = c & 31;
        const f32x4 v = *(const f32x4*)(ws_g + p * 128 + q4 * 4);
        u32x2 wv; wv.x = cvtpk(v[0], v[1]); wv.y = cvtpk(v[2], v[3]);
        *(LAS u32x2*)(WsL + p * STR + q4 * 8) = wv;
    }
    {
        const int q = tid >> 2, part = tid & 3;
        const bf16_t* vp = Z + (size_t)(row0 + q) * DIN + 1024 + 64 * g + 16 * part;
        const u32x4 x0 = *(const u32x4*)vp, x1 = *(const u32x4*)(vp + 8);
        float f[16];
#pragma unroll
        for (int e = 0; e < 4; ++e) { f[2 * e] = __uint_as_float(x0[e] << 16); f[2 * e + 1] = __uint_as_float(x0[e] & 0xffff0000u); f[8 + 2 * e] = __uint_as_float(x1[e] << 16); f[8 + 2 * e + 1] = __uint_as_float(x1[e] & 0xffff0000u); }
        float ss = 0.f;
#pragma unroll
        for (int e = 0; e < 16; ++e) ss += f[e] * f[e];
        ss += lane_xor(ss, lane, 1); ss += lane_xor(ss, lane, 2);
        const float rstd = rsqrtf(ss * (1.0f / 64.0f) + 1e-6f);
#pragma unroll
        for (int e = 0; e < 16; ++e) {
            const int wc = 16 * part + e; const float y = f[e] * rstd * gn_g[wc];
            *(LAS unsigned short*)(vnT + wc * STR + q * 2) = (unsigned short)(cvtpk(y, 0.f) & 0xffffu);
        }
    }
    __syncthreads();
    const int pb = w >> 1, wb = w & 1;
    f32x16 acc = {0.f, 0.f, 0.f, 0.f, 0.f, 0.f, 0.f, 0.f, 0.f, 0.f, 0.f, 0.f, 0.f, 0.f, 0.f, 0.f};
#pragma unroll
    for (int ks = 0; ks < 8; ++ks) {
        const bf16x8 a = *(const LAS bf16x8*)(WsL + (32 * pb + r32) * STR + (16 * ks + 8 * h) * 2);
        const bf16x8 bq = *(const LAS bf16x8*)(vnT + (32 * wb + r32) * STR + (16 * ks + 8 * h) * 2);
        acc = __builtin_amdgcn_mfma_f32_32x32x16_bf16(a, bq, acc, 0, 0, 0);
    }
    const int wcol = 32 * wb + r32;
#pragma unroll
    for (int r = 0; r < 16; ++r) {
        const int p = 32 * pb + (r & 3) + 8 * (r >> 2) + 4 * h;
        const float s = acc[r] + bs_g[p];
        const float uval = bf2f(Z[(size_t)(row0 + p) * DIN + 768 + 64 * g + wcol]);
        O[(size_t)(row0 + p) * DM + 256 + 64 * g + wcol] = (unsigned short)(cvtpk(uval * s, 0.f) & 0xffffu);
    }
    __syncthreads();
}
}

typedef float f32x4 __attribute__((ext_vector_type(4)));
typedef unsigned v4u __attribute__((ext_vector_type(4)));
typedef unsigned v2u __attribute__((ext_vector_type(2)));
#ifndef DBG_SKIP
#define DBG_SKIP 0
#endif
#ifndef REP_MASK
#define REP_MASK 7
#endif
#ifndef REP_MIX
#define REP_MIX 1
#endif
#ifndef DBG_SKIP_LAYERS
#define DBG_SKIP_LAYERS 3
#endif
#ifndef DBG_FILL
#define DBG_FILL 1
#endif
#ifndef DBG_CHECK
#define DBG_CHECK 0
#endif
#ifndef DBG_STOP
#define DBG_STOP 17
#endif
#ifndef DBG_IDENT
#define DBG_IDENT 0
#endif
#ifndef MIX_MASK
#define MIX_MASK 0xff
#endif
#ifndef PH_MASK
#define PH_MASK 0xff
#endif
constexpr int NSTEPS = 22;

struct Args { const float* in[24]; float* out; unsigned char* ws; int ph_lo, ph_hi; };
enum { I_X = 0, I_C, I_CTX, I_CCTX, I_WADA, I_BADA, I_F1W1, I_F1W3, I_F1W2, I_WIN, I_WOUT, I_RPB, I_GMWS, I_GMBS, I_GMNORM, I_LQ1, I_LK1, I_LQ2, I_LK2, I_SUBLN, I_F2W1, I_F2W3, I_F2W2, I_FNORM };

__device__ __forceinline__ void transpose_item(const float* W, int K, int N, bf16_t* WT, int dst_row0, int k0, int n0, LAS float* scr, int lane) {
#pragma unroll 8
    for (int i = 0; i < 32; ++i) { const int kk = 2 * i + (lane >> 5); scr[kk * 33 + (lane & 31)] = W[(size_t)(k0 + kk) * N + n0 + (lane & 31)]; }
    asm volatile("s_waitcnt lgkmcnt(0)" ::: "memory");
    const int c = lane & 7;
#pragma unroll
    for (int j = 0; j < 4; ++j) { const int n = (lane >> 3) + 8 * j; const LAS float* s = scr + (8 * c) * 33 + n;
        v4u o; o.x = fa::cvtpk(s[0 * 33], s[1 * 33]); o.y = fa::cvtpk(s[2 * 33], s[3 * 33]); o.z = fa::cvtpk(s[4 * 33], s[5 * 33]); o.w = fa::cvtpk(s[6 * 33], s[7 * 33]);
        *(v4u*)(WT + (size_t)(dst_row0 + n) * K + k0 + 8 * c) = o; }
    asm volatile("s_waitcnt lgkmcnt(0)" ::: "memory");
}

__device__ __forceinline__ void prologue(const Args& a, LAS unsigned char* lds, int tid, int G) {
    const int lane = tid & 63, wave = __builtin_amdgcn_readfirstlane(tid >> 6);
    float* mod = (float*)(a.ws + WS_MOD);
    if ((int)blockIdx.x < 288) {
        LAS float* sv = (LAS float*)lds; LAS float* red = sv + 5120;
        for (int i = tid; i < 5120; i += 512) { const int ci = i >> 10, k = i & 1023; const float c = ci < 4 ? a.in[I_C][ci * 1024 + k] : a.in[I_CCTX][k]; sv[i] = c / (1.0f + __expf(-c)); }
        __syncthreads();
        for (int it = blockIdx.x; it < 288; it += G) {
            const int l = it / 144, j0 = (it % 144) * 64;
            const float* W = a.in[I_WADA] + (size_t)l * 1024 * NADA + j0 + lane;
            float a0 = 0.f, a1 = 0.f, a2 = 0.f, a3 = 0.f, a4 = 0.f;
#pragma unroll 16
            for (int kk = 0; kk < 128; ++kk) { const int k = wave * 128 + kk; const float wv = W[(size_t)k * NADA];
                a0 += sv[k] * wv; a1 += sv[1024 + k] * wv; a2 += sv[2048 + k] * wv; a3 += sv[3072 + k] * wv; a4 += sv[4096 + k] * wv; }
            red[(wave * 5 + 0) * 64 + lane] = a0; red[(wave * 5 + 1) * 64 + lane] = a1; red[(wave * 5 + 2) * 64 + lane] = a2; red[(wave * 5 + 3) * 64 + lane] = a3; red[(wave * 5 + 4) * 64 + lane] = a4;
            __syncthreads();
            if (tid < 320) { const int i = tid >> 6, ln = tid & 63; float s = 0.f;
#pragma unroll
                for (int ww = 0; ww < 8; ++ww) s += red[(ww * 5 + i) * 64 + ln];
                mod[(size_t)(l * 5 + i) * NADA + j0 + ln] = s + a.in[I_BADA][l * NADA + j0 + ln]; }
            __syncthreads();
        }
    }
    __syncthreads();
    LAS float* scr = (LAS float*)(lds + wave * 16384);
    const int gw = blockIdx.x * 8 + wave, NGW = G * 8;
    constexpr int I_UP = 16 * 88, I_DN = 44 * 32, I_INP = 16 * 88, I_OUTP = 16 * 32;
    constexpr int PER_LAYER = 2 * I_UP + I_DN + I_INP + I_OUTP + 2 * I_UP + I_DN;
    for (int it = gw; it < 2 * PER_LAYER; it += NGW) {
        const int l = it / PER_LAYER; int r = it % PER_LAYER;
        unsigned char* wl = a.ws + WS_W + (size_t)l * WS_WLAYER;
        int which = 0;
        if (r < 2 * I_UP) which = 0; else { r -= 2 * I_UP; if (r < I_DN) which = 1; else { r -= I_DN; if (r < I_INP) which = 2; else { r -= I_INP; if (r < I_OUTP) which = 3; else { r -= I_OUTP; if (r < 2 * I_UP) which = 4; else { r -= 2 * I_UP; which = 5; } } } } }
        if (which == 0 || which == 4) {
            const int bj = r / I_UP; const int rr = r % I_UP; const int kb = rr / 88, nb = rr % 88; const int n0 = 32 * nb;
            const float* W = (which == 0 ? (bj ? a.in[I_F1W3] : a.in[I_F1W1]) : (bj ? a.in[I_F2W3] : a.in[I_F2W1])) + (size_t)l * 1024 * DFF;
            bf16_t* WT = (bf16_t*)(wl + (which == 0 ? WO_UP1 : WO_UP2));
            transpose_item(W, 1024, DFF, WT, 256 * (n0 / 128) + 128 * bj + (n0 % 128), 64 * kb, n0, scr, lane);
        } else if (which == 1 || which == 5) {
            const int kb = r / 32, nb = r % 32;
            const float* W = (which == 1 ? a.in[I_F1W2] : a.in[I_F2W2]) + (size_t)l * DFF * 1024;
            bf16_t* WT = (bf16_t*)(wl + (which == 1 ? WO_DN1 : WO_DN2));
            transpose_item(W, DFF, 1024, WT, 32 * nb, 64 * kb, 32 * nb, scr, lane);
        } else if (which == 2) {
            const int kb = r / 88, nb = r % 88; const int n0 = 32 * nb; const int pn = n0 / 256, rem = n0 % 256; const int comp = rem / 64, bj = (rem % 64) / 32;
            const float* W = a.in[I_WIN] + (size_t)l * 1024 * DIN;
            transpose_item(W, 1024, DIN, (bf16_t*)(wl + WO_IN), 256 * pn + 128 * bj + 32 * comp, 64 * kb, n0, scr, lane);
        } else {
            const int kb = r / 32, nb = r % 32;
            const float* W = a.in[I_WOUT] + (size_t)l * 1024 * 1024;
            transpose_item(W, 1024, 1024, (bf16_t*)(wl + WO_OUT), 32 * nb, 64 * kb, 32 * nb, scr, lane);
        }
    }
}

__device__ __forceinline__ void modulate_phase(const float* srcL, const float* srcC, bf16_t* H, const float* modl, int si, int nrows, int tid, int G, float* dstC, const float* part, int np, const float* pgate, float gs) {
    const int lane = tid & 63, wave = tid >> 6; const int gw = blockIdx.x * 8 + wave, NGW = G * 8;
    for (int row = gw; row < nrows; row += NGW) {
        const bool lat = row < NLAT;
        const f32x4* xr = (const f32x4*)(lat ? srcL + (size_t)row * DM : srcC + (size_t)(row - NLAT) * DM) + lane;
        const float* sh = modl + (size_t)(lat ? (row >> 13) : 4) * NADA + si * DM;
        f32x4 v[4]; float ss = 0.f;
#pragma unroll
        for (int j = 0; j < 4; ++j) v[j] = xr[64 * j];
        if (!lat && np > 0) {
            const f32x4* pr = (const f32x4*)(part + (size_t)(row - NLAT) * DM) + lane; f32x4* xw = (f32x4*)(dstC + (size_t)(row - NLAT) * DM) + lane;
#pragma unroll
            for (int j = 0; j < 4; ++j) {
                f32x4 acc = pr[64 * j];
                for (int p = 1; p < np; ++p) acc += pr[(size_t)p * (NCTX * DM / 4) + 64 * j];
                v[j] += ((const f32x4*)pgate)[lane + 64 * j] * gs * acc; xw[64 * j] = v[j];
            }
        }
#pragma unroll
        for (int j = 0; j < 4; ++j) ss += (v[j].x * v[j].x + v[j].y * v[j].y) + (v[j].z * v[j].z + v[j].w * v[j].w);
        ss = fa::wave_sum(ss, lane);
        const float rstd = rsqrtf(ss * (1.0f / DM) + 1e-6f);
        v2u* o8 = (v2u*)(H + (size_t)row * DM) + lane;
#pragma unroll
        for (int j = 0; j < 4; ++j) {
            const f32x4 h4 = ((const f32x4*)sh)[lane + 64 * j], s4 = ((const f32x4*)(sh + DM))[lane + 64 * j];
            const f32x4 y = v[j] * rstd * (s4 + 1.0f) + h4;
            v2u wv; wv.x = fa::cvtpk(y.x, y.y); wv.y = fa::cvtpk(y.z, y.w); o8[64 * j] = wv;
        }
    }
}
__device__ __forceinline__ void final_norm_phase(const float* Xs, float* X, const float* gain, int tid, int G) {
    const int lane = tid & 63, wave = tid >> 6; const int gw = blockIdx.x * 8 + wave, NGW = G * 8;
    for (int row = gw; row < NLAT; row += NGW) {
        f32x4* xr = (f32x4*)(X + (size_t)row * DM) + lane; const f32x4* xs = (const f32x4*)(Xs + (size_t)row * DM) + lane;
        f32x4 v[4]; float ss = 0.f;
#pragma unroll
        for (int j = 0; j < 4; ++j) { v[j] = xs[64 * j]; ss += (v[j].x * v[j].x + v[j].y * v[j].y) + (v[j].z * v[j].z + v[j].w * v[j].w); }
        ss = fa::wave_sum(ss, lane);
        const float rstd = rsqrtf(ss * (1.0f / DM) + 1e-6f);
#pragma unroll
        for (int j = 0; j < 4; ++j) { const f32x4 g = ((const f32x4*)gain)[lane + 64 * j]; xr[64 * j] = v[j] * rstd * g; }
    }
}

__device__ __forceinline__ void mix_phase(const Args& a, LAS unsigned char* lds, int l, int tid, int G, const int umask) {
    const bf16_t* Z = (const bf16_t*)(a.ws + WS_G); bf16_t* O = (bf16_t*)(a.ws + WS_O);
    const int lane = tid & 63;
    const float linit = (l == 0) ? 0.2f : 0.35550906759f;
    float lam;
    { const float d1 = fa::wave_sum(a.in[I_LQ1][l * 64 + lane] * a.in[I_LK1][l * 64 + lane], lane); const float d2 = fa::wave_sum(a.in[I_LQ2][l * 64 + lane] * a.in[I_LK2][l * 64 + lane], lane);
      lam = __expf(d1) - __expf(d2) + linit; }
    const float* subln = a.in[I_SUBLN] + l * 128;
    const int n_diff = 1024, n_na = 512, n_gm = (l == 0) ? 1056 : 1024, n_nac = (l == 0) ? 16 : 0, n_dc = (l == 0) ? 32 : 0;
    const int total = n_diff + n_na + n_gm + n_nac + n_dc;
    const int tid_m = tid;
    for (int it = blockIdx.x; it < total; it += G) {
        int tid = tid_m; asm volatile("" : "+v"(tid));
        int r = it;
        const bool is_dl = r < n_diff, is_dc = r >= n_diff + n_na + n_gm + n_nac;
        const bool is_nl = !is_dl && r < n_diff + n_na, is_nc = !is_dc && r >= n_diff + n_na + n_gm;
        if (is_dl || is_dc) {
            int b, hd, q0row, nlat;
            if (is_dl) { const int blk = r & 255, k = r >> 8; const int xcd = blk & 7, slot = blk >> 3; const int jj = k * 32 + slot; const int bh = 2 * xcd + (jj >> 6), qb = jj & 63;
                b = bh >> 2; hd = bh & 3; q0row = b * SEQ + qb * 128; nlat = 128; }
            else { const int rr = r - (n_diff + n_na + n_gm + n_nac); b = rr >> 3; hd = (rr >> 1) & 3; q0row = NLAT + b * CTXL + (rr & 1) * 128; nlat = 0; }
            if (umask & 1) fa::diff_unit(lds, Z, O, b, hd, q0row, nlat, lam, 1.0f - linit, subln, tid);
        } else if (is_nl || is_nc) {
            int b, hd, r0, ctxq;
            if (is_nl) { const int rr = r - n_diff; b = rr >> 7; hd = (rr >> 5) & 3; r0 = 4 * (rr & 31); ctxq = 0; }
            else { const int rr = r - (n_diff + n_na + n_gm); b = rr >> 2; hd = rr & 3; r0 = 0; ctxq = 1; }
            if (umask & 2) fa::na_unit(lds, Z, O, a.in[I_RPB] + (size_t)(l * 4 + hd) * 465, b, hd, r0, ctxq, tid);
        } else {
            const int rr = r - (n_diff + n_na); const int chunk = rr >> 2, g = rr & 3;
            const long row0 = chunk < 256 ? (long)chunk * 128 : (long)NLAT + (chunk - 256) * 128;
            if (umask & 4) fa::gmlp_unit(lds, Z, O, a.in[I_GMWS] + (size_t)(l * 4 + g) * 16384, a.in[I_GMBS] + (l * 4 + g) * 128, a.in[I_GMNORM] + (l * 4 + g) * 64, row0, g, tid);
        }
    }
}


#if DBG_CHECK
constexpr size_t WS_DBG = 5 * MiB, WS_XC2 = 404 * MiB;
__device__ __forceinline__ float dbg_bf(const bf16_t* p, size_t i) { return __uint_as_float(((unsigned)p[i]) << 16); }
__device__ __forceinline__ unsigned dbg_hash(unsigned x) { x ^= x >> 16; x *= 0x7feb352du; x ^= x >> 15; x *= 0x846ca68bu; x ^= x >> 16; return x; }
__device__ __forceinline__ bool dbg_bad(float got, float ref, float atol = 0.03f) { return !(fabsf(got - ref) <= atol + 0.03f * fabsf(ref)); }
__device__ __forceinline__ float dbg_block_sum(float v, LAS float* red, int tid) {
    v = fa::wave_sum(v, tid & 63); __syncthreads(); if ((tid & 63) == 0) red[tid >> 6] = v; __syncthreads();
    float s = 0.f; for (int i = 0; i < 8; ++i) s += red[i]; __syncthreads(); return s;
}
__device__ __forceinline__ float dbg_block_max(float v, LAS float* red, int tid) {
    for (int o = 1; o < 64; o <<= 1) v = fmaxf(v, __shfl_xor(v, o));
    __syncthreads(); if ((tid & 63) == 0) red[tid >> 6] = v; __syncthreads();
    float s = red[0]; for (int i = 1; i < 8; ++i) s = fmaxf(s, red[i]); __syncthreads(); return s;
}
template <class KR, class BI>
__device__ __forceinline__ void dbg_attn(const bf16_t* Z, long qrow, int qcol, int kcol, int vcol, int dv, int nk, KR krow, BI bias, LAS float* sc, LAS float* outv, LAS float* red, int tid) {
    float lm = -3e38f;
    for (int i = tid; i < nk; i += 512) { const long kr = krow(i); float s = 0.f; for (int d = 0; d < 64; ++d) s += dbg_bf(Z, (size_t)qrow * DIN + qcol + d) * dbg_bf(Z, (size_t)kr * DIN + kcol + d); s = s * 0.125f + bias(i); sc[i] = s; lm = fmaxf(lm, s); }
    const float m = dbg_block_max(lm, red, tid);
    float ls = 0.f;
    for (int i = tid; i < nk; i += 512) { const float p = __expf(sc[i] - m); sc[i] = p; ls += p; }
    const float tot = dbg_block_sum(ls, red, tid);
    const int d = tid & 127, part = tid >> 7;
    float acc = 0.f;
    if (d < dv) for (int i = part; i < nk; i += 4) acc += sc[i] * dbg_bf(Z, (size_t)krow(i) * DIN + vcol + d);
    __syncthreads();
    LAS float* tmp = red + 16;
    tmp[part * 128 + d] = acc; __syncthreads();
    if (tid < dv) outv[tid] = (tmp[tid] + tmp[128 + tid] + tmp[256 + tid] + tmp[384 + tid]) / tot;
    __syncthreads();
}
__device__ __forceinline__ void dbg_check(const Args& a, LAS unsigned char* lds, int tid, int G, const int l, const int sres) {
    unsigned* flags = (unsigned*)(a.ws + WS_DBG);
    const bf16_t* H = (const bf16_t*)(a.ws + WS_H); const bf16_t* Z = (const bf16_t*)(a.ws + WS_G); const bf16_t* O = (const bf16_t*)(a.ws + WS_O);
    const float* mod = (const float*)(a.ws + WS_MOD) + (size_t)l * 5 * NADA;
    const int blk = blockIdx.x;
    if (blk == 7 && tid == 0) atomicOr(flags, 1u);
    if (sres == 6) {
    {
        const int rows[8] = {0, 77, 8192, 20000, 32767, 32768, 33000, 33791};
        bool bad = false;
        for (int sidx = tid; sidx < 8 * 70; sidx += 512) {
            int ri = sidx / 70; const int row = (int)(dbg_hash(blk * 8 + ri + 1000) % (unsigned)MT); const int col = ((sidx % 70) * 37 + blk) % DIN;
            const bool rope = (col >= 1280 && col < 2304 && row < NLAT);
            const int c1 = rope ? (col & ~63) + (col & 31) : col; const int c2 = c1 + 32;
            float x1 = 0.f, x2 = 0.f;
            for (int k = 0; k < 1024; ++k) { const float hv = dbg_bf(H, (size_t)row * DM + k); x1 += hv * a.in[I_WIN][(size_t)l * 1024 * DIN + (size_t)k * DIN + c1]; if (rope) x2 += hv * a.in[I_WIN][(size_t)l * 1024 * DIN + (size_t)k * DIN + c2]; }
            float ref = x1;
            if (col >= 768 && col < 1280) ref = 0.5f * x1 * (1.0f + erff(x1 * 0.70710678f));
            if (rope) { const int t = row & 8191; const int j = col & 31; const float pos = (j < 16) ? (float)(t >> 6) : (float)(t & 63); const float fr = __builtin_amdgcn_exp2f(-(float)(j & 15) * 0.8304820237218406f);
                const float ang = pos * fr; const float c = __cosf(ang), s = __sinf(ang); ref = ((col & 63) < 32) ? x1 * c - x2 * s : x1 * s + x2 * c; }
            if (dbg_bad(dbg_bf(Z, (size_t)row * DIN + col), ref)) bad = true;
        }
        (void)rows;
        if (bad) atomicOr(flags, 2u);
    }
    {
        bool bad = false;
        if (tid < 144) {
            const int ci = tid / 36, g = (tid / 9) & 3, pi = (tid / 3) % 3, wi = tid % 3;
            const long row0 = 128L * (dbg_hash(blk * 4 + ci + 77) % (l == 0 ? 264u : 256u)); const int p = (int)(dbg_hash(blk * 16 + pi + 5) % 128u); const int w = (int)(dbg_hash(blk * 16 + wi + 11) % 64u);
            float s = 0.f;
            for (int q = 0; q < 128; ++q) { float ss = 0.f; for (int e = 0; e < 64; ++e) { const float v = dbg_bf(Z, (size_t)(row0 + q) * DIN + 1024 + 64 * g + e); ss += v * v; }
                const float vn = dbg_bf(Z, (size_t)(row0 + q) * DIN + 1024 + 64 * g + w) * rsqrtf(ss / 64.f + 1e-6f) * a.in[I_GMNORM][(l * 4 + g) * 64 + w];
                s += a.in[I_GMWS][(size_t)(l * 4 + g) * 16384 + p * 128 + q] * vn; }
            s += a.in[I_GMBS][(l * 4 + g) * 128 + p];
            const float ref = dbg_bf(Z, (size_t)(row0 + p) * DIN + 768 + 64 * g + w) * s;
            if (dbg_bad(dbg_bf(O, (size_t)(row0 + p) * DM + 256 + 64 * g + w), ref)) bad = true;
        }
        if (bad) atomicOr(flags, 4u);
    }
    for (int pass = 2; pass <= 3; ++pass) {
        LAS float* sc = (LAS float*)lds; LAS float* outv = sc + 8448; LAS float* outv2 = outv + 128; LAS float* red = outv2 + 128;
        bool bad = false;
        for (int smp = 0; smp < 2; ++smp) {
            if (pass == 2) {
                const unsigned hh_ = dbg_hash(blk * 2 + smp + 333); const int b = hh_ & 3, hd = (hh_ >> 2) & 3; const int t = (hh_ >> 4) & 8191; const bool cq = false;
                const int gr = t >> 6, gc = t & 63; int ks = gr - 4; ks = ks < 0 ? 0 : (ks > 120 ? 120 : ks); int w0 = gc - 8; w0 = w0 < 0 ? 0 : (w0 > 48 ? 48 : w0);
                const long qrow = (long)b * SEQ + t; const float* rp = a.in[I_RPB] + (size_t)(l * 4 + hd) * 465;
                auto krow = [=](int i) -> long { return i < 128 ? (long)b * SEQ + (ks + (i >> 4)) * 64 + w0 + (i & 15) : (long)NLAT + b * CTXL + (i - 128); };
                auto bias = [=](int i) -> float { return i < 128 ? rp[(ks + (i >> 4) - gr + 7) * 31 + (w0 + (i & 15) - gc + 15)] : 0.f; };
                dbg_attn(Z, qrow, hd * 64, 256 + hd * 64, 512 + hd * 64, 64, 384, krow, bias, sc, outv, red, tid);
                if (tid < 64 && dbg_bad(dbg_bf(O, (size_t)qrow * DM + hd * 64 + tid), outv[tid], 0.01f)) bad = true;
                (void)cq;
            } else {
                const unsigned hh_ = dbg_hash(blk * 2 + smp + 999); const int b = hh_ & 3, hd = (hh_ >> 2) & 3; const bool cq = ((hh_ >> 20) & 15) == 0 && (l == 0);
                const long qrow = cq ? (long)NLAT + b * CTXL + ((hh_ >> 4) & 255) : (long)b * SEQ + ((hh_ >> 4) & 8191);
                const int nk = cq ? 256 : 8448;
                auto krow = [=](int i) -> long { return cq ? (long)NLAT + b * CTXL + i : (i < 8192 ? (long)b * SEQ + i : (long)NLAT + b * CTXL + (i - 8192)); };
                auto bias = [=](int i) -> float { return 0.f; };
                dbg_attn(Z, qrow, 1280 + hd * 128, 1792 + hd * 128, 2304 + hd * 128, 128, nk, krow, bias, sc, outv, red, tid);
                dbg_attn(Z, qrow, 1280 + hd * 128 + 64, 1792 + hd * 128 + 64, 2304 + hd * 128, 128, nk, krow, bias, sc, outv2, red, tid);
                float d1 = 0.f, d2 = 0.f; for (int e = 0; e < 64; ++e) { d1 += a.in[I_LQ1][l * 64 + e] * a.in[I_LK1][l * 64 + e]; d2 += a.in[I_LQ2][l * 64 + e] * a.in[I_LK2][l * 64 + e]; }
                const float linit = l == 0 ? 0.2f : 0.35550906759f; const float lam = __expf(d1) - __expf(d2) + linit;
                float ss = 0.f; for (int e = 0; e < 128; ++e) { const float v = outv[e] - lam * outv2[e]; ss += v * v; }
                if (tid < 128) { const float ref = (outv[tid] - lam * outv2[tid]) * rsqrtf(ss / 128.f + 1e-6f) * a.in[I_SUBLN][l * 128 + tid] * (1.0f - linit);
                    if (dbg_bad(dbg_bf(O, (size_t)qrow * DM + 512 + hd * 128 + tid), ref, 0.05f)) bad = true; }
                __syncthreads();
            }
        }
        if (bad) atomicOr(flags, pass == 2 ? 8u : 16u);
    }
    }
    if (sres != 6) {
        const bf16_t* Gb = (const bf16_t*)(a.ws + WS_G);
        const float* w1 = (sres == 2 ? a.in[I_F1W1] : a.in[I_F2W1]) + (size_t)l * 1024 * DFF; const float* w3 = (sres == 2 ? a.in[I_F1W3] : a.in[I_F2W3]) + (size_t)l * 1024 * DFF;
        bool bad = false;
        for (int sidx = tid; sidx < 6 * 60; sidx += 512) {
            const int ri = sidx / 60; const int row = (int)(dbg_hash(blk * 8 + ri + 31337) % (unsigned)NLAT); const int col = ((sidx % 60) * 47 + blk * 11) % DFF;
            float x1 = 0.f, x3 = 0.f;
            for (int k = 0; k < 1024; ++k) { const float hv = dbg_bf(H, (size_t)row * DM + k); x1 += hv * w1[(size_t)k * DFF + col]; x3 += hv * w3[(size_t)k * DFF + col]; }
            const float ref = x1 / (1.0f + __expf(-x1)) * x3;
            if (dbg_bad(dbg_bf(Gb, (size_t)row * DFF + col), ref)) bad = true;
        }
        if (bad) atomicOr(flags, 2u);
    }
    {
        const float* saved = (const float*)(a.ws + WS_DBG + 65536);
        const bf16_t* A = sres == 6 ? O : (const bf16_t*)(a.ws + WS_G); const int K = sres == 6 ? DM : DFF;
        const float* W = sres == 6 ? a.in[I_WOUT] + (size_t)l * DM * DM : (sres == 2 ? a.in[I_F1W2] : a.in[I_F2W2]) + (size_t)l * DFF * DM;
        const int gidx = sres == 2 ? 2 : (sres == 6 ? 5 : 8); const float gs = sres == 6 ? 1.0f : 0.5f;
        bool bad = false;
        for (int sidx = tid; sidx < 64; sidx += 512) {
            const int ri = blk; const int row = (int)(dbg_hash(blk + 4242) % (unsigned)NLAT); const int col = (sidx * 16 + blk) % DM;
            float acc = 0.f; for (int k = 0; k < K; ++k) acc += dbg_bf(A, (size_t)row * K + k) * W[(size_t)k * DM + col];
            const float ref = saved[ri * DM + col] + gs * mod[(size_t)(row >> 13) * NADA + gidx * DM + col] * acc;
            if (dbg_bad(a.out[(size_t)row * DM + col], ref)) bad = true;
        }
        if (bad) atomicOr(flags, 32u);
    }
    if (sres != 6 && blk == 8) {
        const float* modall = (const float*)(a.ws + WS_MOD);
        bool bad = false;
        if (tid < 100) { const int ll = tid & 1, i = (tid >> 1) % 5, j = (tid * 977) % NADA;
            float acc = 0.f; for (int k = 0; k < 1024; ++k) { const float c = i < 4 ? a.in[I_C][i * 1024 + k] : a.in[I_CCTX][k]; acc += c / (1.0f + __expf(-c)) * a.in[I_WADA][(size_t)ll * 1024 * NADA + (size_t)k * NADA + j]; }
            acc += a.in[I_BADA][ll * NADA + j];
            if (dbg_bad(modall[(size_t)(ll * 5 + i) * NADA + j], acc)) bad = true; }
        if (bad) atomicOr(flags, 4u);
    }
    if (sres == 2 && l == 0 && blk == 9) {
        bool bad = false;
        if (tid < 5 * 40) { const int ri = tid / 40; const int row = ri == 0 ? 0 : ri == 1 ? 12345 : ri == 2 ? 32767 : ri == 3 ? 32768 : 33791; const int col = ((tid % 40) * 53) % DM;
            const float* xr = row < NLAT ? a.in[I_X] + (size_t)row * DM : a.in[I_CTX] + (size_t)(row - NLAT) * DM; const int bi = row < NLAT ? row >> 13 : 4;
            float ss = 0.f; for (int k = 0; k < DM; ++k) ss += xr[k] * xr[k];
            const float ref = xr[col] * rsqrtf(ss / DM + 1e-6f) * (1.0f + mod[(size_t)bi * NADA + DM + col]) + mod[(size_t)bi * NADA + col];
            if (dbg_bad(dbg_bf(H, (size_t)row * DM + col), ref)) bad = true; }
        if (bad) atomicOr(flags, 8u);
    }
    if (sres == 6) {
        const float* saved = (const float*)(a.ws + WS_DBG + 65536);
        bool bad = false;
        if (tid < 40) { const int ri = blk; const int row = (int)(dbg_hash(blk + 4242) % (unsigned)NLAT); const int col = ((tid % 40) * 53 + blk) % DM; const int bi = row >> 13;
            float ss = 0.f; for (int k = 0; k < DM; ++k) ss += saved[ri * DM + k] * saved[ri * DM + k];
            const float ref = saved[ri * DM + col] * rsqrtf(ss / DM + 1e-6f) * (1.0f + mod[(size_t)bi * NADA + 4 * DM + col]) + mod[(size_t)bi * NADA + 3 * DM + col];
            if (dbg_bad(dbg_bf(H, (size_t)row * DM + col), ref)) bad = true; }
        if (bad) atomicOr(flags, 64u);
    }
    if (sres == 6 && l == 0 && blk == 10) {
        LAS float* sc = (LAS float*)lds; LAS float* outv = sc + 8448; LAS float* red = outv + 256;
        const int b = 2, hd = 1; const long qrow = (long)NLAT + b * CTXL + 200;
        auto krow = [=](int i) -> long { return (long)NLAT + b * CTXL + i; };
        auto bias = [=](int i) -> float { return 0.f; };
        dbg_attn(Z, qrow, hd * 64, 256 + hd * 64, 512 + hd * 64, 64, 256, krow, bias, sc, outv, red, tid);
        bool bad = false;
        if (tid < 64 && dbg_bad(dbg_bf(O, (size_t)qrow * DM + hd * 64 + tid), outv[tid])) bad = true;
        if (bad) atomicOr(flags, 8u);
    }
}
__device__ __forceinline__ void dbg_save(const Args& a, const float* src, int tid) {
    float* saved = (float*)(a.ws + WS_DBG + 65536);
    { const int row = (int)(dbg_hash(blockIdx.x + 4242) % (unsigned)NLAT); for (int i = tid; i < DM; i += 512) saved[blockIdx.x * DM + i] = src[(size_t)row * DM + i]; }
}
__device__ __forceinline__ void dbg_save2(const Args& a, const float* src, int tid) {
    float* saved = (float*)(a.ws + WS_DBG + 2 * MiB);
    { const int row = (int)(dbg_hash(blockIdx.x + 777) % (unsigned)NLAT); for (int i = tid; i < DM; i += 512) saved[blockIdx.x * DM + i] = src[(size_t)row * DM + i]; }
}
__device__ __forceinline__ void dbg_check2(const Args& a, int tid) {
    const float* saved = (const float*)(a.ws + WS_DBG + 2 * MiB) + blockIdx.x * DM; unsigned* flags = (unsigned*)(a.ws + WS_DBG);
    const int row = (int)(dbg_hash(blockIdx.x + 777) % (unsigned)NLAT);
    float ss = 0.f; for (int k = 0; k < DM; ++k) ss += saved[k] * saved[k];
    bool bad = false;
    for (int c = tid; c < DM; c += 512) { const float ref = saved[c] * rsqrtf(ss / DM + 1e-6f) * a.in[I_FNORM][c]; if (dbg_bad(a.out[(size_t)row * DM + c], ref, 0.01f)) bad = true; }
    if (bad) atomicOr(flags, 64u);
}
__device__ __forceinline__ void dbg_fill(const Args& a, int tid, int G) {
    const unsigned mask = *(const volatile unsigned*)(a.ws + WS_DBG);
    const float c = __builtin_amdgcn_exp2f(0.5f * (float)(mask + 1));
    for (size_t i = (size_t)blockIdx.x * 512 + tid; i < (size_t)NLAT * DM; i += (size_t)G * 512) a.out[i] = c;
}
#endif

#define XB_TMO      128
#define XB_XCNT(j)  (256  + 64 * (j))
#define XB_XSUB(j)  (1280 + 64 * (j))
#define XB_XGEN(j)  (2304 + 64 * (j))
#define XB_TOP      3328
#define XB_TOPGEN   3392
#define XCD_BAR_WORDS 3456
#define XB_SPIN_CAP (1u << 24)

__device__ __forceinline__ unsigned xb_ld(unsigned* p)              { return __hip_atomic_load(p, __ATOMIC_RELAXED, __HIP_MEMORY_SCOPE_AGENT); }
__device__ __forceinline__ unsigned xb_add(unsigned* p, unsigned v) { return __hip_atomic_fetch_add(p, v, __ATOMIC_RELAXED, __HIP_MEMORY_SCOPE_AGENT); }
__device__ __forceinline__ unsigned xb_xcc_id() { return (unsigned)__builtin_amdgcn_s_getreg((3 << 11) | 20) & 0xFu; }
#define XB_SPIN(cond, bar) do { unsigned _sp = 0; while (cond) { __builtin_amdgcn_s_sleep(1); \
    if ((++_sp & 255u) == 0u) { if (xb_ld(&(bar)[XB_TMO])) break; if (_sp > XB_SPIN_CAP) { atomicAdd(&(bar)[XB_TMO], 1u); break; } } } } while (0)

struct XcdBarrier {
    unsigned* bar; unsigned x;
    volatile LAS unsigned* st;
};

__device__ __forceinline__ XcdBarrier xcd_barrier_post(unsigned* bar, volatile LAS unsigned* st) {
    XcdBarrier b; b.bar = bar; b.x = xb_xcc_id(); b.st = st;
    if (threadIdx.x == 0) (void)xb_add(&bar[XB_XCNT(b.x)], 1u);
    return b;
}
__device__ __forceinline__ void xcd_barrier_complete(unsigned* bar, unsigned x, unsigned& nloc, unsigned& nx) {
    const unsigned G = gridDim.x * gridDim.y * gridDim.z;
    unsigned sum, cnt, mine, sp = 0u;
    for (;;) {
        sum = 0u; cnt = 0u; mine = 0u;
#pragma unroll
        for (unsigned j = 0; j < 16; ++j) { const unsigned c = xb_ld(&bar[XB_XCNT(j)]); sum += c; cnt += (c > 0u) ? 1u : 0u; mine = (j == x) ? c : mine; }
        if (sum == G) break;
        __builtin_amdgcn_s_sleep(1);
        if ((++sp & 255u) == 0u) { if (xb_ld(&bar[XB_TMO])) break; if (sp > XB_SPIN_CAP) { atomicAdd(&bar[XB_TMO], 1u); break; } }
    }
    nloc = mine > 0u ? mine : 1u; nx = cnt > 0u ? cnt : 1u;
}

__device__ __forceinline__ void xcd_barrier(const XcdBarrier& b) {
    asm volatile("s_waitcnt vmcnt(0)" ::: "memory");
    __syncthreads();
    if (threadIdx.x == 0) {
        unsigned* bar = b.bar;
        __builtin_amdgcn_s_waitcnt(0);
        unsigned nloc = b.st[0], nx = b.st[1];
        if (nloc == 0u) { xcd_barrier_complete(bar, b.x, nloc, nx); b.st[0] = nloc; b.st[1] = nx; }
        const unsigned old = xb_add(&bar[XB_XSUB(b.x)], 1u);
        const unsigned gen = old / nloc;
        if (old + 1u == (gen + 1u) * nloc) {
            __builtin_amdgcn_fence(__ATOMIC_RELEASE, "agent");
            asm volatile("s_waitcnt vmcnt(0)" ::: "memory");
            const unsigned og = xb_add(&bar[XB_TOP], 1u);
            const unsigned tg = og / nx;
            if (og + 1u == (tg + 1u) * nx) xb_add(&bar[XB_TOPGEN], 1u);
            else XB_SPIN(xb_ld(&bar[XB_TOPGEN]) == tg, bar);
            __builtin_amdgcn_fence(__ATOMIC_ACQUIRE, "agent");
            xb_add(&bar[XB_XGEN(b.x)], 1u);
            asm volatile("s_waitcnt vmcnt(0)" ::: "memory");
        } else {
            XB_SPIN(xb_ld(&bar[XB_XGEN(b.x)]) == gen, bar);
            __builtin_amdgcn_fence(__ATOMIC_ACQUIRE, "agent");
            asm volatile("s_waitcnt vmcnt(0)" ::: "memory");
        }
    }
    __syncthreads();
}

constexpr size_t WS_PART = 404 * MiB;
constexpr size_t WS_BAR = 6 * MiB;
__global__ void __launch_bounds__(512, 2) mega_fwd(Args a) {
    extern __shared__ __attribute__((aligned(16))) unsigned char lds_raw[];
    LAS unsigned char* lds = (LAS unsigned char*)lds_raw;
    const int tid0 = threadIdx.x, G = gridDim.x;
    volatile LAS unsigned* MISC = (volatile LAS unsigned*)(lds + 131072 + 512);
    if (tid0 < 2) MISC[tid0] = 0u;
    __syncthreads();
    unsigned* barw = (unsigned*)(a.ws + WS_BAR);
    XcdBarrier xbar; xbar.bar = barw; xbar.x = 0; xbar.st = MISC;
    float* XL = a.out; float* XC = (float*)(a.ws + WS_XC);
    bf16_t* H = (bf16_t*)(a.ws + WS_H); bf16_t* O = (bf16_t*)(a.ws + WS_O); bf16_t* GB = (bf16_t*)(a.ws + WS_G);
    const float* mod = (const float*)(a.ws + WS_MOD);
    for (int step = a.ph_lo; step < a.ph_hi; ++step) {
        int tid = tid0; asm volatile("" : "+v"(tid));
#if DBG_CHECK
        if (step == 100) { dbg_check(a, lds, tid, G, (DBG_STOP - 1) / 10, (DBG_STOP - 1) % 10); continue; }
        if (step == 103) { dbg_save2(a, XL, tid); continue; }
        if (step == 104) { dbg_check2(a, tid); continue; }
        if (step == 102) { dbg_save(a, (DBG_STOP <= 3) ? a.in[I_X] : XL, tid); continue; }
        if (step == 101) { if (DBG_FILL) dbg_fill(a, tid, G); continue; }
        if (step == 0 && blockIdx.x == 0 && tid == 0) *(unsigned*)(a.ws + 5 * MiB) = 0u;
#endif
        if (step == 0) { if (blockIdx.x == 0) for (int i = tid; i < XCD_BAR_WORDS; i += 512) barw[i] = 0u; if (PH_MASK & 1) prologue(a, lds, tid, G); }
        else if (step == NSTEPS - 1) { if (PH_MASK & 2) final_norm_phase(DBG_IDENT ? a.in[I_X] : XL, XL, a.in[I_FNORM], tid, G); }
        else {
            const int l = (step - 1) / 10, s = (step - 1) % 10;
            if (((DBG_SKIP >> s) & 1) && ((DBG_SKIP_LAYERS >> l) & 1)) continue;
            const float* modl = mod + (size_t)l * 5 * NADA;
            const unsigned char* wl = a.ws + WS_W + (size_t)l * WS_WLAYER;
            const bool first = (l == 0 && s <= 2);
            const float* srcL = first ? a.in[I_X] : XL; const float* srcC = first ? a.in[I_CTX] : XC;
            const bool lat_only = (l == 1 && s >= 6);
            const int Mrows = lat_only ? NLAT : MT;
            if (s == 0 || s == 3 || s == 7) { if (PH_MASK & 4) {
                const bool pend = !lat_only && !(l == 0 && s == 0);
                const int np = !pend ? 0 : (s == 7 ? 4 : 11);
                const float* pgate = mod + (size_t)(((s == 0 && l > 0) ? l - 1 : l) * 5 + 4) * NADA + (s == 0 ? 8 : (s == 3 ? 2 : 5)) * DM;
                const float* msrcC = (l == 0 && s == 3) ? a.in[I_CTX] : srcC;
                modulate_phase(srcL, msrcC, H, modl, s == 0 ? 0 : (s == 3 ? 3 : 6), Mrows, tid, G, XC, (const float*)(a.ws + WS_PART), np, pgate, s == 7 ? 1.0f : 0.5f); }
            } else if (s == 1 || s == 8) { if (PH_MASK & 8) {
                pg8::Gemm g{H, (const bf16_t*)(wl + (s == 1 ? WO_UP1 : WO_UP2)), Mrows, 2 * DFF, DM}; pg8::StaticOrder S; S.init(Mrows, 2 * DFF, G, (int)blockIdx.x);
                pg8::EpiSwiGLU E{GB, DFF};
                pg8::gemm_phase<pg8::EpiSwiGLU, pg8::StaticOrder, true, true>(lds, g, S, E); }
            } else if (s == 2 || s == 6 || s == 9) { if (PH_MASK & 16) {
                const bf16_t* A = (s == 6) ? O : GB; const int K = (s == 6) ? DM : DFF;
                const bf16_t* Bt = (const bf16_t*)(wl + (s == 2 ? WO_DN1 : (s == 6 ? WO_OUT : WO_DN2)));
                pg8::Gemm g{A, Bt, Mrows, DM, K}; pg8::SplitOrder S; S.init(G, (int)blockIdx.x, lat_only ? 0 : 4, s == 6 ? 4 : 11);
                pg8::EpiResid E{srcL, srcC, XL, XC, modl, s == 2 ? 2 : (s == 6 ? 5 : 8), s == 6 ? 1.0f : 0.5f, (float*)(a.ws + WS_PART)};
                pg8::gemm_phase<pg8::EpiResid, pg8::SplitOrder, true, true>(lds, g, S, E); }
            } else if (s == 4) { if (PH_MASK & 32) {
                pg8::Gemm g{H, (const bf16_t*)(wl + WO_IN), MT, DIN, DM}; pg8::StaticOrder S; S.init(MT, DIN, G, (int)blockIdx.x);
                pg8::EpiInProj E{GB};
                pg8::gemm_phase<pg8::EpiInProj, pg8::StaticOrder, true, true>(lds, g, S, E); }
            } else {
                if (PH_MASK & 64) for (int rep_ = 0; rep_ < REP_MIX; ++rep_) mix_phase(a, lds, l, tid, G, rep_ == 0 ? 7 : REP_MASK);
            }
        }
        if (step + 1 < a.ph_hi) {
            if (step == a.ph_lo) { cg::this_grid().sync(); xbar = xcd_barrier_post(barw, MISC); }
            else xcd_barrier(xbar);
        }
    }
}

extern "C" void kernel_launch(void* const* d_in, const int* in_sizes, int n_in, void* d_out, int out_size, void* d_ws, size_t ws_size, hipStream_t stream) {
    static int grid = 0;
    if (grid == 0) {
        if (n_in != 24 || in_sizes[0] != NLAT * DM || out_size != NLAT * DM || ws_size < WS_END + 44 * MiB) { fprintf(stderr, "kernel_launch: unexpected shapes (n_in %d, in0 %d, out %d, ws %zu)\n", n_in, n_in > 0 ? in_sizes[0] : -1, out_size, ws_size); grid = -1; return; }
        int dev = 0, cus = 0, per_cu = 0;
        if (hipGetDevice(&dev) != hipSuccess || hipDeviceGetAttribute(&cus, hipDeviceAttributeMultiprocessorCount, dev) != hipSuccess) { grid = -1; return; }
        if (hipFuncSetAttribute((const void*)mega_fwd, hipFuncAttributeMaxDynamicSharedMemorySize, LDS_BYTES) != hipSuccess) { fprintf(stderr, "kernel_launch: hipFuncSetAttribute failed\n"); grid = -1; return; }
        if (hipOccupancyMaxActiveBlocksPerMultiprocessor(&per_cu, (const void*)mega_fwd, 512, LDS_BYTES) != hipSuccess || per_cu < 1) { fprintf(stderr, "kernel_launch: occupancy query gave %d\n", per_cu); per_cu = 1; }
        (void)hipGetLastError();
        grid = cus * (per_cu > 1 ? 1 : per_cu);
    }
    if (grid < 0) return;
    Args a{};
    for (int i = 0; i < 24; ++i) a.in[i] = (const float*)d_in[i];
    a.out = (float*)d_out; a.ws = (unsigned char*)d_ws;
#if ONE_LAUNCH
    a.ph_lo = 0; a.ph_hi = NSTEPS;
    void* args[] = {&a};
    hipError_t e = hipLaunchCooperativeKernel((const void*)mega_fwd, dim3(grid), dim3(512), args, LDS_BYTES, stream);
    if (e != hipSuccess) fprintf(stderr, "cooperative launch failed: %s (grid %d)\n", hipGetErrorString(e), grid);
#else
#if DBG_CHECK
    for (int st = 0; st < DBG_STOP + (DBG_STOP == 20 ? 7 : 4); ++st) { const int k_ = st - DBG_STOP; const int sid = st < DBG_STOP ? st : (k_ == 0 ? 102 : (k_ == 1 ? DBG_STOP : (k_ == 2 ? 100 : (DBG_STOP != 20 ? 101 : (k_ == 3 ? 103 : (k_ == 4 ? 21 : (k_ == 5 ? 104 : 101))))))); a.ph_lo = sid; a.ph_hi = sid + 1; hipLaunchKernelGGL(mega_fwd, dim3(grid), dim3(512), LDS_BYTES, stream, a); }
#else
    for (int st = 0; st < NSTEPS; ++st) { a.ph_lo = st; a.ph_hi = st + 1; hipLaunchKernelGGL(mega_fwd, dim3(grid), dim3(512), LDS_BYTES, stream, a); }
#endif
#endif
}
```

```cpp
#include <hip/hip_runtime.h>
#include <hip/hip_cooperative_groups.h>
#include <cstdio>
#include <cstdint>
namespace cg = cooperative_groups;
#ifndef ONE_LAUNCH
#define ONE_LAUNCH 1
#endif
namespace pg8 {
#define PG8_LAS __attribute__((address_space(3)))
typedef unsigned short bf16_t;
typedef short bf16x8 __attribute__((ext_vector_type(8)));
typedef float f32x4 __attribute__((ext_vector_type(4)));
typedef unsigned u32x4 __attribute__((ext_vector_type(4)));
constexpr int BM = 256, BK = 64, HALF = 128, HTB = HALF * BK * 2  , STAGE_BYTES = 8 * HTB, NXCD = 8, WGM = 8;

__host__ __device__ __forceinline__ int lds_byte(int r, int c) { const int st = (r >> 4) * 2 + (c >> 5), rr = r & 15, cc = c & 31, ob = rr * 64 + cc * 2; return st * 1024 + (ob ^ (((ob >> 9) & 1) << 5)); }
__host__ __device__ __forceinline__ void stage_rc(int b, int& R, int& C) { const int st = b / 1024, sb = b % 1024, swz = sb ^ (((sb >> 9) & 1) << 5); R = (st >> 1) * 16 + swz / 64; C = (st & 1) * 32 + (swz % 64) / 2; }
__host__ __device__ __forceinline__ int perm32(int rho) { const int n = rho >> 4, i = rho & 15; return 8 * (i >> 2) + 4 * n + (i & 3); }

struct Unit { int pm, pn, kh; };
struct Gemm { const bf16_t* A; const bf16_t* Bt; int M, N, K; };

struct StaticOrder {
    int nM, nN, nwg, G, c;
    __host__ __device__ void init(int M, int N, int G_, int c_) { nM = M / BM; nN = N / BM; nwg = nM * nN; G = G_; c = c_; }
    __host__ __device__ bool next(int i, Unit& u) const {
        const long L = (long)i * G + c; if (L >= nwg) return false;
        int wgid = (int)L; { const int q = nwg / NXCD, r = nwg % NXCD, xcd = wgid % NXCD, off = wgid / NXCD; wgid = (xcd < r ? xcd * (q + 1) : r * (q + 1) + (xcd - r) * q) + off; }
        const int nig = WGM * nN, gid = wgid / nig, fm = gid * WGM, gsz = (nM - fm) < WGM ? (nM - fm) : WGM;
        u.pm = fm + ((wgid % nig) % gsz); u.pn = (wgid % nig) / gsz; u.kh = -1; return true;
    }
    __host__ __device__ int parts() const { return 1; }
    __device__ __forceinline__ void a_ready(const Unit&) const {}
    __device__ __forceinline__ void done(const Unit&) const {}
};

struct SplitOrder {
    StaticOrder lat; int nctx, kp;
    __host__ __device__ void init(int G_, int c_, int nctx_tiles, int kparts) { lat.init(128 * BM, 4 * BM, G_, c_); nctx = nctx_tiles; kp = kparts; }
    __host__ __device__ bool next(int i, Unit& u) const {
        const int L = i * lat.G + lat.c;
        if (L < 512) return lat.next(i, u);
        const int idx = L - 512; if (idx >= nctx * 4 * kp) return false;
        u.kh = idx % kp; const int q = idx / kp; u.pn = q & 3; u.pm = 128 + (q >> 2); return true;
    }
    __host__ __device__ int parts() const { return kp; }
    __device__ __forceinline__ void a_ready(const Unit&) const {}
    __device__ __forceinline__ void done(const Unit&) const {}
};

__device__ __forceinline__ unsigned cvt_pk_bf16(float lo, float hi) { unsigned r; asm volatile("v_cvt_pk_bf16_f32 %0, %1, %2" : "=v"(r) : "v"(lo), "v"(hi)); return r; }
typedef float f32x2 __attribute__((ext_vector_type(2)));
__device__ __forceinline__ f32x2 gelu_pk(f32x2 v) {
    const f32x2 av = __builtin_elementwise_abs(v), d = av * 0.2316418882f + 1.0f;
    f32x2 t; t.x = __builtin_amdgcn_rcpf(d.x); t.y = __builtin_amdgcn_rcpf(d.y);
    f32x2 q = t * 0.5307027145f + (-0.7265760135f); q = q * t + 0.7107068705f; q = q * t + (-0.142248368f); q = q * t + 0.127414796f; q = q * t;
    const f32x2 s = (v * v) * (-0.72134752044f);
    f32x2 e; e.x = __builtin_amdgcn_exp2f(s.x); e.y = __builtin_amdgcn_exp2f(s.y);
    const f32x2 m = v * (q * e), r = v - m;
    f32x2 o; o.x = v.x < 0.f ? m.x : r.x; o.y = v.y < 0.f ? m.y : r.y; return o;
}


constexpr int NLAT_ROWS = 32768, DMODEL = 1024, NADA_COLS = 9216;
__device__ __forceinline__ float silu_f(float a) { return a * __builtin_amdgcn_rcpf(1.0f + __builtin_amdgcn_exp2f(-1.4426950408889634f * a)); }

struct EpiSwiGLU {
    static constexpr bool PERM = true, AFTER_DRAIN = false;
    bf16_t* G; int ldc;
    __device__ __forceinline__ void operator()(const f32x4 (&acc)[2][2][4][2], const Unit& u, int wr, int wc, int fr, int fq) const {
        const int row0 = u.pm * BM + wr * 64 + fr; const int col0 = u.pn * HALF + wc * 32 + 8 * fq;
#pragma unroll
        for (int ai = 0; ai < 2; ++ai)
#pragma unroll
            for (int m = 0; m < 4; ++m) {
                bf16_t* rowp = G + (size_t)(row0 + ai * HALF + m * 16) * ldc + col0;
                const f32x4 a0 = acc[ai][0][m][0], a1 = acc[ai][0][m][1], b0 = acc[ai][1][m][0], b1 = acc[ai][1][m][1];
                u32x4 w;
                w.x = cvt_pk_bf16(silu_f(a0[0]) * b0[0], silu_f(a0[1]) * b0[1]); w.y = cvt_pk_bf16(silu_f(a0[2]) * b0[2], silu_f(a0[3]) * b0[3]);
                w.z = cvt_pk_bf16(silu_f(a1[0]) * b1[0], silu_f(a1[1]) * b1[1]); w.w = cvt_pk_bf16(silu_f(a1[2]) * b1[2], silu_f(a1[3]) * b1[3]);
                *(u32x4*)rowp = w;
            }
    }
};

struct EpiInProj {
    static constexpr bool PERM = true, AFTER_DRAIN = false;
    bf16_t* Z;
    __device__ __forceinline__ void operator()(const f32x4 (&acc)[2][2][4][2], const Unit& u, int wr, int wc, int fr, int fq) const {
        const int pn = u.pn; const bool do_gelu = (pn == 3 || pn == 4); const bool do_rope = (pn >= 5 && pn <= 8 && u.pm < 128);
        const int row0 = u.pm * BM + wr * 64 + fr; const int colb = pn * 256 + 64 * wc + 8 * fq;
        float fq8[8];
#pragma unroll
        for (int i = 0; i < 8; ++i) fq8[i] = __builtin_amdgcn_exp2f(-(float)(8 * (fq & 1) + i) * 0.8304820237218406f);
#pragma unroll
        for (int ai = 0; ai < 2; ++ai)
#pragma unroll
            for (int m = 0; m < 4; ++m) {
                const int row = row0 + ai * HALF + m * 16;
                f32x4 a0 = acc[ai][0][m][0], a1 = acc[ai][0][m][1], b0 = acc[ai][1][m][0], b1 = acc[ai][1][m][1];
                if (do_gelu) {
                    f32x2 t;
                    t = gelu_pk((f32x2){a0[0], a0[1]}); a0[0] = t.x; a0[1] = t.y; t = gelu_pk((f32x2){a0[2], a0[3]}); a0[2] = t.x; a0[3] = t.y;
                    t = gelu_pk((f32x2){a1[0], a1[1]}); a1[0] = t.x; a1[1] = t.y; t = gelu_pk((f32x2){a1[2], a1[3]}); a1[2] = t.x; a1[3] = t.y;
                    t = gelu_pk((f32x2){b0[0], b0[1]}); b0[0] = t.x; b0[1] = t.y; t = gelu_pk((f32x2){b0[2], b0[3]}); b0[2] = t.x; b0[3] = t.y;
                    t = gelu_pk((f32x2){b1[0], b1[1]}); b1[0] = t.x; b1[1] = t.y; t = gelu_pk((f32x2){b1[2], b1[3]}); b1[2] = t.x; b1[3] = t.y;
                } else if (do_rope) {
                    const int t = row & 8191; const float fpos = (float)((fq < 2) ? (t >> 6) : (t & 63));
#pragma unroll
                    for (int e = 0; e < 4; ++e) {
                        { const float ang = fpos * fq8[e]; const float c = __cosf(ang), s = __sinf(ang); const float x1 = a0[e], x2 = b0[e]; a0[e] = x1 * c - x2 * s; b0[e] = x1 * s + x2 * c; }
                        { const float ang = fpos * fq8[4 + e]; const float c = __cosf(ang), s = __sinf(ang); const float x1 = a1[e], x2 = b1[e]; a1[e] = x1 * c - x2 * s; b1[e] = x1 * s + x2 * c; }
                    }
                }
                bf16_t* rowp = Z + (size_t)row * 2816 + colb;
                u32x4 w; w.x = cvt_pk_bf16(a0[0], a0[1]); w.y = cvt_pk_bf16(a0[2], a0[3]); w.z = cvt_pk_bf16(a1[0], a1[1]); w.w = cvt_pk_bf16(a1[2], a1[3]);
                *(u32x4*)rowp = w;
                u32x4 v; v.x = cvt_pk_bf16(b0[0], b0[1]); v.y = cvt_pk_bf16(b0[2], b0[3]); v.z = cvt_pk_bf16(b1[0], b1[1]); v.w = cvt_pk_bf16(b1[2], b1[3]);
                *(u32x4*)(rowp + 32) = v;
            }
    }
};

struct EpiResid {
    static constexpr bool PERM = true, AFTER_DRAIN = false;
    const float* srcL; const float* srcC; float* dstL; float* dstC; const float* modl; int gidx; float gscale; float* part;
    __device__ __forceinline__ void operator()(const f32x4 (&acc)[2][2][4][2], const Unit& u, int wr, int wc, int fr, int fq) const {
        const bool lat = u.pm < 128;
        const float* sb = lat ? srcL + (size_t)u.pm * BM * DMODEL : srcC + (size_t)(u.pm - 128) * BM * DMODEL;
        float* db = lat ? dstL + (size_t)u.pm * BM * DMODEL : dstC + (size_t)(u.pm - 128) * BM * DMODEL;
        const float* gate = modl + (size_t)(lat ? (u.pm >> 5) : 4) * NADA_COLS + gidx * DMODEL;
        const int col0 = u.pn * BM + wc * 32 + 8 * fq;
        if (u.kh >= 0) {
            int frl = fr, fql = fq; asm volatile("" : "+v"(frl), "+v"(fql));
            float* pb = part + ((size_t)u.kh * 1024 + (size_t)(u.pm - 128) * BM) * DMODEL + u.pn * BM + wc * 32 + 8 * fql;
#pragma unroll
            for (int ai = 0; ai < 2; ++ai)
#pragma unroll
                for (int m = 0; m < 4; ++m) {
                    float* q = pb + (size_t)(ai * HALF + wr * 64 + m * 16 + frl) * DMODEL;
#pragma unroll
                    for (int bj = 0; bj < 2; ++bj)
#pragma unroll
                        for (int n = 0; n < 2; ++n) *(f32x4*)(q + bj * HALF + n * 4) = acc[ai][bj][m][n];
                }
            return;
        }
        f32x4 g4[2][2];
#pragma unroll
        for (int bj = 0; bj < 2; ++bj)
#pragma unroll
            for (int n = 0; n < 2; ++n) g4[bj][n] = *(const f32x4*)(gate + col0 + bj * HALF + n * 4) * gscale;
#pragma unroll
        for (int ai = 0; ai < 2; ++ai)
#pragma unroll
            for (int m = 0; m < 4; ++m) {
                const size_t off = (size_t)(ai * HALF + wr * 64 + m * 16 + fr) * DMODEL + col0;
#pragma unroll
                for (int bj = 0; bj < 2; ++bj)
#pragma unroll
                    for (int n = 0; n < 2; ++n) {
                        const f32x4 bs = *(const f32x4*)(sb + off + bj * HALF + n * 4);
                        *(f32x4*)(db + off + bj * HALF + n * 4) = bs + g4[bj][n] * acc[ai][bj][m][n];
                    }
                if (m & 1) asm volatile("" ::: "memory");
            }
    }
};
template <class Epi, class Sched, bool ALIGN_EPI = false, bool SP2 = false>
__device__ __forceinline__ void gemm_phase(PG8_LAS unsigned char* lds, const Gemm g, const Sched& S, const Epi& E) {
    int tid_ = threadIdx.x; asm volatile("" : "+v"(tid_));
    const int tid = tid_, wid = __builtin_amdgcn_readfirstlane(tid >> 6), lane = tid & 63, wr = wid >> 2, wc = wid & 3, fr = lane & 15, fq = lane >> 4;
    const int K = g.K, nt = K / BK;
    unsigned voffA[2], voffB[2];
#pragma unroll
    for (int i = 0; i < 2; ++i) { int R, C; stage_rc(tid * 16 + i * 8192, R, C); const int Rb = Epi::PERM ? ((R & ~31) + perm32(R & 31)) : R;
        voffA[i] = (unsigned)(R * K + C) * 2u; voffB[i] = (unsigned)(Rb * K + C) * 2u; }
    const size_t kstep = (size_t)(BK * 2);
    const size_t hstep = (size_t)HALF * K * 2;
    const size_t tstep = 2 * hstep;
    const unsigned ldsw = (unsigned)wid * 1024u;
    const int aoff = lds_byte(wr * 64 + fr, fq * 8), boff = lds_byte(wc * 32 + fr, fq * 8);
#define PG8_SA(b, h) (((b) * 2 + (h)) * HTB)
#define PG8_SB(b, h) ((4 + (b) * 2 + (h)) * HTB)
#define PG8_STAGE(bufoff, gbase, voff) do { _Pragma("unroll") for (int _i = 0; _i < 2; ++_i) \
        __builtin_amdgcn_global_load_lds((const unsigned*)((const char*)(gbase) + (voff)[_i]), (PG8_LAS unsigned*)(lds + (bufoff) + ldsw + _i * 8192), 16, 0, 0); } while (0)
#define PG8_LDA(dst, b, h) do { _Pragma("unroll") for (int m = 0; m < 4; ++m) _Pragma("unroll") for (int k = 0; k < 2; ++k) dst[m][k] = *(const PG8_LAS bf16x8*)(lds + PG8_SA(b, h) + aoff + m * 2048 + k * 1024); } while (0)
#define PG8_LDB(dst, b, h) do { _Pragma("unroll") for (int n = 0; n < 2; ++n) _Pragma("unroll") for (int k = 0; k < 2; ++k) dst[n][k] = *(const PG8_LAS bf16x8*)(lds + PG8_SB(b, h) + boff + n * 2048 + k * 1024); } while (0)
#define PG8_MMA(ai, bj, At, Bt) do { __builtin_amdgcn_s_setprio(1); _Pragma("unroll") for (int m = 0; m < 4; ++m) _Pragma("unroll") for (int n = 0; n < 2; ++n) _Pragma("unroll") for (int k = 0; k < 2; ++k) \
        acc[ai][bj][m][n] = __builtin_amdgcn_mfma_f32_16x16x32_bf16(Bt[n][k], At[m][k], acc[ai][bj][m][n], 0, 0, 0); __builtin_amdgcn_s_setprio(0); } while (0)
#define PG8_WAIT_V(n) asm volatile("s_waitcnt vmcnt(" #n ")" ::: "memory")
#define PG8_WAIT_L(n) asm volatile("s_waitcnt lgkmcnt(" #n ")" ::: "memory")
#define PG8_BAR __builtin_amdgcn_s_barrier()
#define PG8_SCHED __builtin_amdgcn_sched_barrier(0)
    Unit cur, nxt; int ui = 0;
    if (!S.next(0, cur)) return;
    f32x4 acc[2][2][4][2];
#pragma unroll
    for (int a = 0; a < 2; ++a)
#pragma unroll
        for (int b = 0; b < 2; ++b)
#pragma unroll
            for (int m = 0; m < 4; ++m)
#pragma unroll
                for (int n = 0; n < 2; ++n) acc[a][b][m][n] = (f32x4){0.f, 0.f, 0.f, 0.f};
    bf16x8 At[4][2], B0[2][2], B1[2][2];
    const int kpb = (K / S.parts()) * 2;
    const char* cA = (const char*)g.A + (size_t)cur.pm * tstep + (cur.kh > 0 ? cur.kh * kpb : 0); const char* cB = (const char*)g.Bt + (size_t)cur.pn * tstep + (cur.kh > 0 ? cur.kh * kpb : 0);
    S.a_ready(cur);
    if constexpr (SP2) {
        PG8_STAGE(PG8_SB(0, 0), cB, voffB); PG8_STAGE(PG8_SB(0, 1), cB + hstep, voffB); PG8_STAGE(PG8_SA(0, 0), cA, voffA); PG8_STAGE(PG8_SA(0, 1), cA + hstep, voffA);
        if (wr == 1) PG8_BAR;
        PG8_WAIT_V(2); PG8_BAR;
        PG8_STAGE(PG8_SB(1, 0), cB + kstep, voffB); PG8_STAGE(PG8_SA(1, 0), cA + kstep, voffA); PG8_STAGE(PG8_SB(1, 1), cB + hstep + kstep, voffB);
        PG8_WAIT_V(6); PG8_BAR;
    } else {
        PG8_STAGE(PG8_SB(0, 0), cB, voffB); PG8_STAGE(PG8_SA(0, 0), cA, voffA); PG8_STAGE(PG8_SB(0, 1), cB + hstep, voffB); PG8_STAGE(PG8_SA(0, 1), cA + hstep, voffA);
        if (wr == 1) PG8_BAR;
        PG8_WAIT_V(4); PG8_BAR;
        PG8_STAGE(PG8_SB(1, 0), cB + kstep, voffB); PG8_STAGE(PG8_SA(1, 0), cA + kstep, voffA); PG8_STAGE(PG8_SB(1, 1), cB + hstep + kstep, voffB);
        PG8_WAIT_V(6); PG8_BAR;
    }
    for (;;) {
        const bool has_next = S.next(ui + 1, nxt);
        const char* nA = has_next ? (const char*)g.A + (size_t)nxt.pm * tstep + (nxt.kh > 0 ? nxt.kh * kpb : 0) : cA; const char* nB = has_next ? (const char*)g.Bt + (size_t)nxt.pn * tstep + (nxt.kh > 0 ? nxt.kh * kpb : 0) : cB;
        const int ntu = cur.kh >= 0 ? nt / S.parts() : nt;
        for (int t = 0; t < ntu; t += 2) {
            const bool last = (t == ntu - 2);
            const char* a1 = cA + (size_t)(t + 1) * kstep;
            const char* a2 = last ? nA : cA + (size_t)(t + 2) * kstep; const char* b2 = last ? nB : cB + (size_t)(t + 2) * kstep;
            const char* a3 = a2 + kstep; const char* b3 = b2 + kstep;
            if (last && has_next) S.a_ready(nxt);
            if constexpr (SP2) {
            PG8_LDB(B0, 0, 0); PG8_LDB(B1, 0, 1); PG8_SCHED; PG8_LDA(At, 0, 0); PG8_STAGE(PG8_SA(1, 1), a1 + hstep, voffA);
            PG8_WAIT_V(8); PG8_WAIT_L(0); PG8_BAR; PG8_MMA(0, 0, At, B0); PG8_MMA(0, 1, At, B1); PG8_BAR; PG8_SCHED;
            PG8_LDA(At, 0, 1); PG8_STAGE(PG8_SB(0, 0), b2, voffB); PG8_STAGE(PG8_SB(0, 1), b2 + hstep, voffB); PG8_STAGE(PG8_SA(0, 0), a2, voffA);
            PG8_WAIT_V(8); PG8_WAIT_L(0); PG8_BAR; PG8_MMA(1, 0, At, B0); PG8_MMA(1, 1, At, B1); PG8_BAR; PG8_SCHED;
            PG8_LDB(B0, 1, 0); PG8_LDB(B1, 1, 1); PG8_SCHED; PG8_LDA(At, 1, 0); PG8_STAGE(PG8_SA(0, 1), a2 + hstep, voffA);
            PG8_WAIT_V(8); PG8_WAIT_L(0); PG8_BAR; PG8_MMA(0, 0, At, B0); PG8_MMA(0, 1, At, B1); PG8_BAR; PG8_SCHED;
            PG8_LDA(At, 1, 1); PG8_STAGE(PG8_SB(1, 0), b3, voffB); PG8_STAGE(PG8_SB(1, 1), b3 + hstep, voffB); PG8_STAGE(PG8_SA(1, 0), a3, voffA);
            PG8_WAIT_V(8); PG8_WAIT_L(0); PG8_BAR; PG8_MMA(1, 0, At, B0); PG8_MMA(1, 1, At, B1); PG8_BAR; PG8_SCHED;
            } else {
            PG8_LDB(B0, 0, 0); PG8_SCHED; PG8_LDA(At, 0, 0); PG8_STAGE(PG8_SA(1, 1), a1 + hstep, voffA);
            PG8_WAIT_L(8); PG8_BAR; PG8_WAIT_L(0); PG8_MMA(0, 0, At, B0); PG8_BAR; PG8_SCHED;
            PG8_LDB(B1, 0, 1); PG8_STAGE(PG8_SB(0, 0), b2, voffB);
            PG8_BAR; PG8_WAIT_L(0); PG8_MMA(0, 1, At, B1); PG8_BAR;
            PG8_LDA(At, 0, 1); PG8_STAGE(PG8_SA(0, 0), a2, voffA);
            PG8_BAR; PG8_WAIT_L(0); PG8_MMA(1, 0, At, B0); PG8_BAR; PG8_SCHED;
            PG8_STAGE(PG8_SB(0, 1), b2 + hstep, voffB);
            PG8_WAIT_V(6); PG8_BAR; PG8_MMA(1, 1, At, B1); PG8_BAR;
            PG8_LDB(B0, 1, 0); PG8_SCHED; PG8_LDA(At, 1, 0); PG8_STAGE(PG8_SA(0, 1), a2 + hstep, voffA);
            PG8_WAIT_L(8); PG8_BAR; PG8_WAIT_L(0); PG8_MMA(0, 0, At, B0); PG8_BAR; PG8_SCHED;
            PG8_LDB(B1, 1, 1); PG8_STAGE(PG8_SB(1, 0), b3, voffB);
            PG8_BAR; PG8_WAIT_L(0); PG8_MMA(0, 1, At, B1); PG8_BAR;
            PG8_LDA(At, 1, 1); PG8_STAGE(PG8_SA(1, 0), a3, voffA);
            PG8_BAR; PG8_WAIT_L(0); PG8_MMA(1, 0, At, B0); PG8_BAR; PG8_SCHED;
            PG8_STAGE(PG8_SB(1, 1), b3 + hstep, voffB);
            PG8_WAIT_V(6); PG8_BAR; PG8_MMA(1, 1, At, B1); PG8_BAR;
            }
        }
        if constexpr (ALIGN_EPI) { if (wr == 0) PG8_BAR; }
        if constexpr (!Epi::AFTER_DRAIN) { E(acc, cur, wr, wc, fr, fq); S.done(cur); }
        if (!has_next) break;
#pragma unroll
        for (int a = 0; a < 2; ++a)
#pragma unroll
            for (int b = 0; b < 2; ++b)
#pragma unroll
                for (int m = 0; m < 4; ++m)
#pragma unroll
                    for (int n = 0; n < 2; ++n) acc[a][b][m][n] = (f32x4){0.f, 0.f, 0.f, 0.f};
        cur = nxt; cA = nA; cB = nB; ++ui;
        if constexpr (ALIGN_EPI) { if (wr == 1) PG8_BAR; }
    }
    PG8_WAIT_V(0);
    if constexpr (!ALIGN_EPI) { if (wr == 0) PG8_BAR; }
    PG8_BAR;
    if constexpr (Epi::AFTER_DRAIN) { E.fused(acc, cur, wr, wc, fr, fq, lds, wid, lane); S.done(cur); }
#undef PG8_SA
#undef PG8_SB
#undef PG8_STAGE
#undef PG8_LDA
#undef PG8_LDB
#undef PG8_MMA
#undef PG8_WAIT_V
#undef PG8_WAIT_L
#undef PG8_BAR
#undef PG8_SCHED
}
}

#define LAS __attribute__((address_space(3)))
typedef unsigned short bf16_t;
constexpr int DM = 1024, NBATCH = 4, SEQ = 8192, CTXL = 256, NLAT = NBATCH * SEQ, NCTX = NBATCH * CTXL, MT = NLAT + NCTX, DFF = 2816, DIN = 2816, NADA = 9216;
constexpr size_t MiB = 1u << 20;
constexpr size_t WS_MOD = 0, WS_XC = 1 * MiB, WS_W = 8 * MiB, WS_WLAYER = 41 * MiB, WS_H = 90 * MiB, WS_O = 156 * MiB, WS_G = 222 * MiB, WS_END = 404 * MiB;
constexpr size_t WO_UP1 = 0, WO_DN1 = 11534336, WO_IN = WO_DN1 + 5767168, WO_OUT = WO_IN + 5767168, WO_UP2 = WO_OUT + 2097152, WO_DN2 = WO_UP2 + 11534336;
static_assert(WO_DN2 + 5767168 <= WS_WLAYER, "weights per layer");
constexpr int LDS_BYTES = 135168;

#ifndef DBG_INJECT
#define DBG_INJECT 0.0f
#endif
namespace fa {
typedef short bf16x8 __attribute__((ext_vector_type(8)));
typedef short s16x4 __attribute__((ext_vector_type(4)));
typedef float f32x16 __attribute__((ext_vector_type(16)));
typedef float f32x4 __attribute__((ext_vector_type(4)));
typedef unsigned u32x4 __attribute__((ext_vector_type(4)));
typedef unsigned u32x2 __attribute__((ext_vector_type(2)));
typedef float f32x2_t __attribute__((ext_vector_type(2)));
typedef __bf16 bf16x2_t __attribute__((ext_vector_type(2)));
__device__ __forceinline__ unsigned cvtpk(float lo, float hi) { f32x2_t v = {lo, hi}; bf16x2_t b = __builtin_convertvector(v, bf16x2_t); return __builtin_bit_cast(unsigned, b); }
__device__ __forceinline__ float bf2f(unsigned short b) { return __uint_as_float(((unsigned)b) << 16); }
__device__ __forceinline__ float max3f(float a, float b, float c) { float r; asm("v_max3_f32 %0, %1, %2, %3" : "=v"(r) : "v"(a), "v"(b), "v"(c)); return r; }
__device__ __forceinline__ float xmax32(float v) { auto rr = __builtin_amdgcn_permlane32_swap(__float_as_uint(v), __float_as_uint(v), false, false); return fmaxf(__uint_as_float(rr[0]), __uint_as_float(rr[1])); }
__device__ __forceinline__ float xsum32(float v) { auto rr = __builtin_amdgcn_permlane32_swap(__float_as_uint(v), __float_as_uint(v), false, false); return __uint_as_float(rr[0]) + __uint_as_float(rr[1]); }
__device__ __forceinline__ s16x4 vtr(const LAS unsigned char* p) { return __builtin_bit_cast(s16x4, __builtin_amdgcn_ds_read_tr16_b64_v4i16((LAS s16x4*)p)); }
__device__ __forceinline__ float lane_xor(float v, int lane, int o) { return __builtin_bit_cast(float, __builtin_amdgcn_ds_bpermute((lane ^ o) << 2, __builtin_bit_cast(int, v))); }
__device__ __forceinline__ float wave_sum(float v, int lane) {
#pragma unroll
    for (int o = 1; o < 64; o <<= 1) v += lane_xor(v, lane, o);
    return v;
}

template <int KW, int VW> struct Geo {
    static constexpr int KSTR = KW * 2 + 16, VSTR = VW * 2 + 64;
    static constexpr int KBYTES = 64 * KSTR, VBYTES = 64 * VSTR, BUF = KBYTES + VBYTES;
    static constexpr int KCH = KW / 8, VCH = VW / 8;
    static constexpr int NCH = (64 * (KCH + VCH)) / 512;
};
template <int KW, int VW, int NCHP = Geo<KW, VW>::NCH>
__device__ __forceinline__ void st_load(u32x4 (&st)[NCHP], const bf16_t* Z, long rowbase, int kcol0, int vcol0, int tid) {
    using G = Geo<KW, VW>;
#pragma unroll
    for (int i = 0; i < G::NCH; ++i) {
        const int c = tid + i * 512;
        if (i * 512 < 64 * G::KCH) { const int key = c / G::KCH, ch = c % G::KCH; st[i] = *(const u32x4*)(Z + (size_t)(rowbase + key) * DIN + kcol0 + ch * 8); }
        else { const int c2 = c - 64 * G::KCH; const int key = c2 / G::VCH, ch = c2 % G::VCH; st[i] = *(const u32x4*)(Z + (size_t)(rowbase + key) * DIN + vcol0 + ch * 8); }
    }
}
template <int KW, int VW, int NCHP = Geo<KW, VW>::NCH>
__device__ __forceinline__ void st_store(LAS unsigned char* buf, const u32x4 (&st)[NCHP], int tid) {
    using G = Geo<KW, VW>;
#pragma unroll
    for (int i = 0; i < G::NCH; ++i) {
        const int c = tid + i * 512;
        if (i * 512 < 64 * G::KCH) { const int key = c / G::KCH, ch = c % G::KCH; *(LAS u32x4*)(buf + key * G::KSTR + ch * 16) = st[i]; }
        else { const int c2 = c - 64 * G::KCH; const int key = c2 / G::VCH, ch = c2 % G::VCH; *(LAS u32x4*)(buf + G::KBYTES + key * G::VSTR + ch * 16) = st[i]; }
    }
}
__device__ __forceinline__ f32x16 qk32(const LAS unsigned char* kp, const bf16x8 (&qf)[4]) {
    f32x16 s = {0.f, 0.f, 0.f, 0.f, 0.f, 0.f, 0.f, 0.f, 0.f, 0.f, 0.f, 0.f, 0.f, 0.f, 0.f, 0.f};
#pragma unroll
    for (int ks = 0; ks < 4; ++ks) { const bf16x8 kf = *(const LAS bf16x8*)(kp + ks * 32); s = __builtin_amdgcn_mfma_f32_32x32x16_bf16(kf, qf[ks], s, 0, 0, 0); }
    return s;
}
template <int NDB, int VSTR>
__device__ __forceinline__ void pv32(f32x16 (&o)[NDB], const LAS unsigned char* vp, const f32x16& p) {
#pragma unroll
    for (int s = 0; s < 2; ++s) {
        u32x4 w; w.x = cvtpk(p[8 * s + 0], p[8 * s + 1]); w.y = cvtpk(p[8 * s + 2], p[8 * s + 3]); w.z = cvtpk(p[8 * s + 4], p[8 * s + 5]); w.w = cvtpk(p[8 * s + 6], p[8 * s + 7]);
        const bf16x8 pf = __builtin_bit_cast(bf16x8, w);
#pragma unroll
        for (int db = 0; db < NDB; ++db) {
            const s16x4 lo = vtr(vp + (16 * s) * VSTR + 64 * db), hi = vtr(vp + (16 * s + 8) * VSTR + 64 * db);
            const bf16x8 vf = {lo[0], lo[1], lo[2], lo[3], hi[0], hi[1], hi[2], hi[3]};
            o[db] = __builtin_amdgcn_mfma_f32_32x32x16_bf16(vf, pf, o[db], 0, 0, 0);
        }
    }
}
template <int NDB>
__device__ __forceinline__ void sm_update(f32x16& s0, f32x16& s1, float& m, float& l, f32x16 (&o)[NDB]) {
    float pm = fmaxf(s0[0], s1[0]);
#pragma unroll
    for (int r = 1; r < 16; ++r) pm = fmaxf(pm, fmaxf(s0[r], s1[r]));
    pm = xmax32(pm);
    if (!__all(pm - m <= 8.0f)) {
        const float mn = fmaxf(m, pm); const float alpha = __builtin_amdgcn_exp2f(m - mn); m = mn; l *= alpha;
#pragma unroll
        for (int db = 0; db < NDB; ++db)
#pragma unroll
            for (int r = 0; r < 16; ++r) o[db][r] *= alpha;
    }
    float ps = 0.f;
#pragma unroll
    for (int r = 0; r < 16; ++r) { s0[r] = __builtin_amdgcn_exp2f(s0[r] - m); s1[r] = __builtin_amdgcn_exp2f(s1[r] - m); ps += s0[r] + s1[r]; }
    l += ps;
}
constexpr float QK_C = 0.125f * 1.4426950408889634f;

template <int NDB>
__device__ __forceinline__ void sm_update_raw(f32x16& s0, f32x16& s1, float& m, float& l, f32x16 (&o)[NDB]) {
    float pm = max3f(s0[0], s1[0], s0[1]);
    pm = max3f(pm, s1[1], s1[1]);
#pragma unroll
    for (int r = 2; r < 16; ++r) pm = max3f(pm, s0[r], s1[r]);
    pm = xmax32(pm) * QK_C;
    if (!__all(pm - m <= 8.0f)) {
        const float mn = fmaxf(m, pm); const float alpha = __builtin_amdgcn_exp2f(m - mn); m = mn; l *= alpha;
#pragma unroll
        for (int db = 0; db < NDB; ++db)
#pragma unroll
            for (int r = 0; r < 16; ++r) o[db][r] *= alpha;
    }
    const float nm = -m; float ps = 0.f;
#pragma unroll
    for (int r = 0; r < 16; ++r) { s0[r] = __builtin_amdgcn_exp2f(fmaf(s0[r], QK_C, nm)); s1[r] = __builtin_amdgcn_exp2f(fmaf(s1[r], QK_C, nm)); ps += s0[r] + s1[r]; }
    l += ps;
}

__device__ __forceinline__ void glds16(const void* gsrc, unsigned lds_dst) { unsigned keep;
    asm volatile("s_mov_b32 %0, m0\n\ts_mov_b32 m0, %2\n\ts_nop 0\n\tglobal_load_lds_dwordx4 %1, off\n\ts_mov_b32 m0, %0" : "=&s"(keep) : "v"(gsrc), "s"(lds_dst) : "memory"); }
#define FA_WAIT_BAR(N) asm volatile("s_waitcnt vmcnt(" #N ") lgkmcnt(0)\n\ts_barrier" ::: "memory")
__device__ __forceinline__ f32x16 qk32s(const LAS unsigned char* kslot, const int (&ko)[4], const bf16x8 (&qf)[4]) {
    f32x16 s = {0.f, 0.f, 0.f, 0.f, 0.f, 0.f, 0.f, 0.f, 0.f, 0.f, 0.f, 0.f, 0.f, 0.f, 0.f, 0.f};
#pragma unroll
    for (int ks = 0; ks < 4; ++ks) { const bf16x8 kf = *(const LAS bf16x8*)(kslot + ko[ks]); s = __builtin_amdgcn_mfma_f32_32x32x16_bf16(kf, qf[ks], s, 0, 0, 0); }
    return s;
}
__device__ __forceinline__ void pv32d(f32x16 (&o)[4], const LAS unsigned char* vp, const f32x16& p) {
#pragma unroll
    for (int s = 0; s < 2; ++s) {
        u32x4 w; w.x = cvtpk(p[8 * s + 0], p[8 * s + 1]); w.y = cvtpk(p[8 * s + 2], p[8 * s + 3]); w.z = cvtpk(p[8 * s + 4], p[8 * s + 5]); w.w = cvtpk(p[8 * s + 6], p[8 * s + 7]);
        const bf16x8 pf = __builtin_bit_cast(bf16x8, w);
#pragma unroll
        for (int db = 0; db < 4; ++db) {
            const s16x4 lo = vtr(vp + (16 * s) * 64 + 4096 * db), hi = vtr(vp + (16 * s + 8) * 64 + 4096 * db);
            const bf16x8 vf = {lo[0], lo[1], lo[2], lo[3], hi[0], hi[1], hi[2], hi[3]};
            o[db] = __builtin_amdgcn_mfma_f32_32x32x16_bf16(vf, pf, o[db], 0, 0, 0);
        }
    }
}
__device__ __forceinline__ void diff_unit(LAS unsigned char* lds, const bf16_t* Z, bf16_t* O, int b, int hd, int q0row, int nlat_tiles, float lam, float oscale, const float* subln, int tid) {
    constexpr int KSLOT = 16384, VRING = 4 * KSLOT;
    const int lane = tid & 63, w = __builtin_amdgcn_readfirstlane(tid >> 6), r32 = lane & 31, h = lane >> 5;
    const int comp = w & 1, qblk = w >> 1;
    const int kcol0 = 1792 + hd * 128, vcol0 = 2304 + hd * 128;
    const unsigned lds0 = (unsigned)(size_t)lds;
    long kg[2], vg[2];
#pragma unroll
    for (int i = 0; i < 2; ++i) {
        const int krow = 8 * w + 4 * i + (lane >> 4);
        kg[i] = ((long)krow * DIN + kcol0 + (((lane & 15) ^ (krow & 7)) * 8)) * 2;
        const int vkey = 32 * (w & 1) + 16 * i + (lane >> 2);
        vg[i] = ((long)vkey * DIN + vcol0 + 32 * (w >> 1) + 8 * (lane & 3)) * 2;
    }
    const unsigned kdst = lds0 + (unsigned)(2 * w) * 1024u, vdst = lds0 + VRING + (unsigned)(2 * w) * 1024u;
#define DIFF_TROW(t) ((t) < nlat_tiles ? (long)b * SEQ + 64 * (t) : (long)NLAT + b * CTXL + 64 * ((t) - nlat_tiles))
#define DIFF_DMA(t) do { const char* tb_ = (const char*)Z + DIFF_TROW(t) * (long)(DIN * 2); const unsigned sl_ = (unsigned)(((t) & 3) * KSLOT); \
        glds16(tb_ + kg[0], (unsigned)__builtin_amdgcn_readfirstlane(kdst + sl_)); glds16(tb_ + kg[1], (unsigned)__builtin_amdgcn_readfirstlane(kdst + sl_ + 1024u)); \
        glds16(tb_ + vg[0], (unsigned)__builtin_amdgcn_readfirstlane(vdst + sl_)); glds16(tb_ + vg[1], (unsigned)__builtin_amdgcn_readfirstlane(vdst + sl_ + 1024u)); } while (0)
    const int NT = nlat_tiles + 4;
    DIFF_DMA(0); DIFF_DMA(1); DIFF_DMA(2);
    bf16x8 qf[4];
    { const bf16_t* qp = Z + (size_t)(q0row + 32 * qblk + r32) * DIN + 1280 + hd * 128 + comp * 64 + 8 * h;
#pragma unroll
      for (int ks = 0; ks < 4; ++ks) qf[ks] = *(const bf16x8*)(qp + 16 * ks); }
    f32x16 o[4];
#pragma unroll
    for (int db = 0; db < 4; ++db)
#pragma unroll
        for (int r = 0; r < 16; ++r) o[db][r] = 0.f;
    float m = -1e30f, l = 0.f;
    int ko[4];
#pragma unroll
    for (int ks = 0; ks < 4; ++ks) ko[ks] = r32 * 256 + (((comp * 8 + 2 * ks + h) ^ (r32 & 7)) << 4);
    const int voff = VRING + (4 * h + ((lane & 15) >> 2)) * 64 + (16 * ((lane >> 4) & 1) + 4 * (lane & 3)) * 2;
    asm volatile("s_waitcnt vmcnt(0)" ::: "memory");
    FA_WAIT_BAR(0);
    for (int t = 0; t < NT; ++t) {
        if (t + 3 < NT) DIFF_DMA(t + 3);
        const LAS unsigned char* kslot = lds + (t & 3) * KSLOT;
        bf16x8 kf[8];
#pragma unroll
        for (int i = 0; i < 8; ++i) kf[i] = *(const LAS bf16x8*)(kslot + ko[i & 3] + (i >> 2) * 8192);
        const LAS unsigned char* vs = lds + voff + (t & 3) * KSLOT;
        s16x4 va[8], vb[8];
#define DIFF_VLD(dst, g) do { _Pragma("unroll") for (int db = 0; db < 4; ++db) { dst[2 * db] = vtr(vs + (16 * (g)) * 64 + 4096 * db); dst[2 * db + 1] = vtr(vs + (16 * (g) + 8) * 64 + 4096 * db); } } while (0)
        DIFF_VLD(va, 0);
        DIFF_VLD(vb, 1);
        __builtin_amdgcn_sched_barrier(0);
        f32x16 s0 = {0.f, 0.f, 0.f, 0.f, 0.f, 0.f, 0.f, 0.f, 0.f, 0.f, 0.f, 0.f, 0.f, 0.f, 0.f, 0.f}, s1 = s0;
        __builtin_amdgcn_s_setprio(1);
#pragma unroll
        for (int ks = 0; ks < 4; ++ks) { s0 = __builtin_amdgcn_mfma_f32_32x32x16_bf16(kf[ks], qf[ks], s0, 0, 0, 0); s1 = __builtin_amdgcn_mfma_f32_32x32x16_bf16(kf[4 + ks], qf[ks], s1, 0, 0, 0); }
        __builtin_amdgcn_s_setprio(0);
        __builtin_amdgcn_sched_barrier(0);
        sm_update_raw<4>(s0, s1, m, l, o);
        bf16x8 pf[4];
#pragma unroll
        for (int g = 0; g < 4; ++g) { const f32x16& p = (g < 2) ? s0 : s1; const int e = 8 * (g & 1);
            u32x4 wv; wv.x = cvtpk(p[e + 0], p[e + 1]); wv.y = cvtpk(p[e + 2], p[e + 3]); wv.z = cvtpk(p[e + 4], p[e + 5]); wv.w = cvtpk(p[e + 6], p[e + 7]); pf[g] = __builtin_bit_cast(bf16x8, wv); }
        __builtin_amdgcn_sched_barrier(0);
#define DIFF_PV(src, g) do { __builtin_amdgcn_s_setprio(1); _Pragma("unroll") for (int db = 0; db < 4; ++db) { const bf16x8 vf = {src[2 * db][0], src[2 * db][1], src[2 * db][2], src[2 * db][3], src[2 * db + 1][0], src[2 * db + 1][1], src[2 * db + 1][2], src[2 * db + 1][3]}; \
            o[db] = __builtin_amdgcn_mfma_f32_32x32x16_bf16(vf, pf[g], o[db], 0, 0, 0); } __builtin_amdgcn_s_setprio(0); } while (0)
        DIFF_PV(va, 0);  __builtin_amdgcn_sched_barrier(0);
        DIFF_VLD(va, 2); __builtin_amdgcn_sched_barrier(0);
        DIFF_PV(vb, 1);  __builtin_amdgcn_sched_barrier(0);
        DIFF_VLD(vb, 3); __builtin_amdgcn_sched_barrier(0);
        DIFF_PV(va, 2);  __builtin_amdgcn_sched_barrier(0);
        DIFF_PV(vb, 3);  __builtin_amdgcn_sched_barrier(0);
#undef DIFF_VLD
#undef DIFF_PV
        if (t + 3 < NT) FA_WAIT_BAR(8); else if (t + 2 < NT) FA_WAIT_BAR(4); else FA_WAIT_BAR(0);
    }
#undef DIFF_TROW
#undef DIFF_DMA
    int tid_e = tid; asm volatile("" : "+v"(tid_e));
    const int lane_e = tid_e & 63, r32e = lane_e & 31, he = lane_e >> 5;
    l = xsum32(l); const float inv = 1.0f / l;
    LAS float* ex = (LAS float*)lds + qblk * 4096;
    if (comp == 1) {
#pragma unroll
        for (int db = 0; db < 4; ++db)
#pragma unroll
            for (int r = 0; r < 16; ++r) ex[(db * 16 + r) * 64 + lane_e] = o[db][r] * inv;
    }
    __syncthreads();
    if (comp == 0) {
        float ss = 0.f;
#pragma unroll
        for (int db = 0; db < 4; ++db)
#pragma unroll
            for (int r = 0; r < 16; ++r) { const float v = o[db][r] * inv - lam * ex[(db * 16 + r) * 64 + lane_e]; o[db][r] = v; ss += v * v; }
        ss = xsum32(ss);
        const float rstd = rsqrtf(ss * (1.0f / 128.0f) + 1e-6f) * oscale;
        bf16_t* op = O + (size_t)(q0row + 32 * qblk + r32e) * DM + 512 + hd * 128 + 4 * he;
#pragma unroll
        for (int db = 0; db < 4; ++db)
#pragma unroll
            for (int i = 0; i < 4; ++i) {
                const f32x4 g = *(const f32x4*)(subln + 32 * db + 8 * i + 4 * he);
                u32x2 wv; wv.x = cvtpk(o[db][4 * i + 0] * rstd * g[0], o[db][4 * i + 1] * rstd * g[1]); wv.y = cvtpk(o[db][4 * i + 2] * rstd * g[2], o[db][4 * i + 3] * rstd * g[3]);
                *(u32x2*)(op + 32 * db + 8 * i) = wv;
            }
    }
    __syncthreads();
}

constexpr int NA_RPB_OFF = 49152;
__device__ __forceinline__ void na_unit(LAS unsigned char* lds, const bf16_t* Z, bf16_t* O, const float* rpb_h, int b, int hd, int r0, int ctxq, int tid) {
    using G = Geo<64, 64>;
    const int lane = tid & 63, w = __builtin_amdgcn_readfirstlane(tid >> 6), r32 = lane & 31, h = lane >> 5;
    const int gr = r0 + (w >> 1), hh = w & 1;
    const int kcol0 = 256 + hd * 64, vcol0 = 512 + hd * 64;
    const long qrow = ctxq ? (long)NLAT + b * CTXL + 32 * w + r32 : (long)b * SEQ + gr * 64 + 32 * hh + r32;
    LAS float* rpbL = (LAS float*)(lds + NA_RPB_OFF);
    if (tid < 465) rpbL[tid] = rpb_h[tid] * 1.4426950408889634f;
    bf16x8 qf[4];
    { const bf16_t* qp = Z + (size_t)qrow * DIN + hd * 64 + 8 * h;
#pragma unroll
      for (int ks = 0; ks < 4; ++ks) qf[ks] = *(const bf16x8*)(qp + 16 * ks); }
    f32x16 o[2];
#pragma unroll
    for (int db = 0; db < 2; ++db)
#pragma unroll
        for (int r = 0; r < 16; ++r) o[db][r] = 0.f;
    float m = -1e30f, l = 0.f;
    int kr_lo = r0 - 4; kr_lo = kr_lo < 0 ? 0 : (kr_lo > 120 ? 120 : kr_lo);
    int kr_hi = r0 + 3 - 4; kr_hi = (kr_hi < 0 ? 0 : (kr_hi > 120 ? 120 : kr_hi)) + 7;
    const int NT = ctxq ? 4 : 4 + (kr_hi - kr_lo + 1);
    int ks0 = gr - 4; ks0 = ks0 < 0 ? 0 : (ks0 > 120 ? 120 : ks0);
    const int qcol = 32 * hh + r32; int w0 = qcol - 8; w0 = w0 < 0 ? 0 : (w0 > 48 ? 48 : w0);
    const int koff = r32 * G::KSTR + 16 * h;
    const int voff = G::KBYTES + (4 * h + ((lane & 15) >> 2)) * G::VSTR + (16 * ((lane >> 4) & 1) + 4 * (lane & 3)) * 2;
    u32x4 st[G::NCH];
#define NA_TROW(t) ((t) < 4 ? (long)NLAT + b * CTXL + 64 * (t) : (long)b * SEQ + (kr_lo + (t) - 4) * 64)
    u32x4 stB[G::NCH];
    st_load<64, 64>(st, Z, NA_TROW(0), kcol0, vcol0, tid);
    st_store<64, 64>(lds, st, tid);
    st_load<64, 64>(st, Z, NA_TROW(1), kcol0, vcol0, tid);
    __syncthreads();
    for (int t0 = 0; t0 < NT; t0 += 2) {
#pragma unroll
    for (int u = 0; u < 2; ++u) {
        const int t = t0 + u;
        if (t < NT) {
        LAS unsigned char* cur = lds + (t & 1) * G::BUF; LAS unsigned char* nxt = lds + ((t + 1) & 1) * G::BUF;
        if (t + 2 < NT) { if (u == 0) st_load<64, 64>(stB, Z, NA_TROW(t + 2), kcol0, vcol0, tid); else st_load<64, 64>(st, Z, NA_TROW(t + 2), kcol0, vcol0, tid); }
        const int kr = kr_lo + t - 4;
        const bool active = (t < 4) || (kr >= ks0 && kr < ks0 + 8);
        if (active) {
            f32x16 s0 = qk32(cur + koff, qf), s1 = qk32(cur + koff + 32 * G::KSTR, qf);
            if (t < 4) {
#pragma unroll
                for (int r = 0; r < 16; ++r) { s0[r] *= QK_C; s1[r] *= QK_C; }
            } else {
                const LAS float* brow = rpbL + (kr - gr + 7) * 31;
                int hq = 4 * h - qcol + 15, hw = 4 * h - w0;
                asm volatile("" : "+v"(hq), "+v"(hw));
#pragma unroll
                for (int r = 0; r < 16; ++r) {
                    const int cr = (r & 3) + 8 * (r >> 2);
                    { const int d = cr + hq; const int dc = d < 0 ? 0 : (d > 30 ? 30 : d); const bool ok = (unsigned)(cr + hw) < 16u; const float bias = brow[dc]; s0[r] = ok ? fmaf(s0[r], QK_C, bias) : -1e30f; }
                    { const int d = cr + 32 + hq; const int dc = d < 0 ? 0 : (d > 30 ? 30 : d); const bool ok = (unsigned)(cr + 32 + hw) < 16u; const float bias = brow[dc]; s1[r] = ok ? fmaf(s1[r], QK_C, bias) : -1e30f; }
                }
            }
            sm_update<2>(s0, s1, m, l, o);
            pv32<2, G::VSTR>(o, cur + voff, s0);
            pv32<2, G::VSTR>(o, cur + voff + 32 * G::VSTR, s1);
        }
        if (t + 1 < NT) { if (u == 0) st_store<64, 64>(nxt, st, tid); else st_store<64, 64>(nxt, stB, tid); }
        __syncthreads();
        }
    }
    }
#undef NA_TROW
    l = xsum32(l); const float inv = 1.0f / l;
    bf16_t* op = O + (size_t)qrow * DM + hd * 64 + 4 * h;
#pragma unroll
    for (int db = 0; db < 2; ++db)
#pragma unroll
        for (int i = 0; i < 4; ++i) {
            u32x2 wv; wv.x = cvtpk(o[db][4 * i + 0] * inv, o[db][4 * i + 1] * inv); wv.y = cvtpk(o[db][4 * i + 2] * inv, o[db][4 * i + 3] * inv);
            *(u32x2*)(op + 32 * db + 8 * i) = wv;
        }
    __syncthreads();
}

__device__ __forceinline__ void gmlp_unit(LAS unsigned char* lds, const bf16_t* Z, bf16_t* O, const float* ws_g  , const float* bs_g  , const float* gn_g  , long row0, int g, int tid) {
    constexpr int STR = 272;
    LAS unsigned char* WsL = lds; LAS unsigned char* vnT = lds + 128 * STR;
    const int lane = tid & 63, w = __builtin_amdgcn_readfirstlane(tid >> 6), r32 = lane & 31, h = lane >> 5;
    const int pbq = w >> 1, wbq = w & 1; const int wcolq = 32 * wbq + r32;
    unsigned short uq[16]; float bq16[16];
#pragma unroll
    for (int r = 0; r < 16; ++r) { const int p = 32 * pbq + (r & 3) + 8 * (r >> 2) + 4 * h; uq[r] = Z[(size_t)(row0 + p) * DIN + 768 + 64 * g + wcolq]; bq16[r] = bs_g[p]; }
#pragma unroll
    for (int i = 0; i < 8; ++i) {
        const int c = tid + i * 512; const int p = c >> 5, q4 = c & 31;
        const f32x4 v = *(const f32x4*)(ws_g + p * 128 + q4 * 4);
        u32x2 wv; wv.x = cvtpk(v[0], v[1]); wv.y = cvtpk(v[2], v[3]);
        *(LAS u32x2*)(WsL + p * STR + q4 * 8) = wv;
    }
    {
        const int q = tid >> 2, part = tid & 3;
        const bf16_t* vp = Z + (size_t)(row0 + q) * DIN + 1024 + 64 * g + 16 * part;
        const u32x4 x0 = *(const u32x4*)vp, x1 = *(const u32x4*)(vp + 8);
        float f[16];
#pragma unroll
        for (int e = 0; e < 4; ++e) { f[2 * e] = __uint_as_float(x0[e] << 16); f[2 * e + 1] = __uint_as_float(x0[e] & 0xffff0000u); f[8 + 2 * e] = __uint_as_float(x1[e] << 16); f[8 + 2 * e + 1] = __uint_as_float(x1[e] & 0xffff0000u); }
        float ss = 0.f;
#pragma unroll
        for (int e = 0; e < 16; ++e) ss += f[e] * f[e];
        ss += lane_xor(ss, lane, 1); ss += lane_xor(ss, lane, 2);
        const float rstd = rsqrtf(ss * (1.0f / 64.0f) + 1e-6f);
#pragma unroll
        for (int e = 0; e < 16; ++e) {
            const int wc = 16 * part + e; const float y = f[e] * rstd * gn_g[wc];
            *(LAS unsigned short*)(vnT + wc * STR + q * 2) = (unsigned short)(cvtpk(y, 0.f) & 0xffffu);
        }
    }
    __syncthreads();
    const int pb = w >> 1, wb = w & 1;
    f32x16 acc = {0.f, 0.f, 0.f, 0.f, 0.f, 0.f, 0.f, 0.f, 0.f, 0.f, 0.f, 0.f, 0.f, 0.f, 0.f, 0.f};
#pragma unroll
    for (int ks = 0; ks < 8; ++ks) {
        const bf16x8 a = *(const LAS bf16x8*)(WsL + (32 * pb + r32) * STR + (16 * ks + 8 * h) * 2);
        const bf16x8 bq = *(const LAS bf16x8*)(vnT + (32 * wb + r32) * STR + (16 * ks + 8 * h) * 2);
        acc = __builtin_amdgcn_mfma_f32_32x32x16_bf16(a, bq, acc, 0, 0, 0);
    }
    const int wcol = 32 * wb + r32;
#pragma unroll
    for (int r = 0; r < 16; ++r) {
        const int p = 32 * pb + (r & 3) + 8 * (r >> 2) + 4 * h;
        const float s = acc[r] + bq16[r];
        const float uval = bf2f(uq[r]);
        O[(size_t)(row0 + p) * DM + 256 + 64 * g + wcol] = (unsigned short)(cvtpk(uval * s, 0.f) & 0xffffu);
    }
    __syncthreads();
}
}

typedef float f32x4 __attribute__((ext_vector_type(4)));
typedef unsigned v4u __attribute__((ext_vector_type(4)));
typedef unsigned v2u __attribute__((ext_vector_type(2)));
#ifndef DBG_SKIP
#define DBG_SKIP 0
#endif
#ifndef REP_MASK
#define REP_MASK 7
#endif
#ifndef REP_MIX
#define REP_MIX 1
#endif
#ifndef DBG_SKIP_LAYERS
#define DBG_SKIP_LAYERS 3
#endif
#ifndef DBG_FILL
#define DBG_FILL 1
#endif
#ifndef DBG_CHECK
#define DBG_CHECK 0
#endif
#ifndef DBG_STOP
#define DBG_STOP 17
#endif
#ifndef DBG_IDENT
#define DBG_IDENT 0
#endif
#ifndef MIX_MASK
#define MIX_MASK 0xff
#endif
#ifndef PH_MASK
#define PH_MASK 0xff
#endif
constexpr int NSTEPS = 22;

struct Args { const float* in[24]; float* out; unsigned char* ws; int ph_lo, ph_hi; };
enum { I_X = 0, I_C, I_CTX, I_CCTX, I_WADA, I_BADA, I_F1W1, I_F1W3, I_F1W2, I_WIN, I_WOUT, I_RPB, I_GMWS, I_GMBS, I_GMNORM, I_LQ1, I_LK1, I_LQ2, I_LK2, I_SUBLN, I_F2W1, I_F2W3, I_F2W2, I_FNORM };

__device__ __forceinline__ void transpose_item(const float* W, int K, int N, bf16_t* WT, int dst_row0, int k0, int n0, LAS float* scr, int lane) {
#pragma unroll 8
    for (int i = 0; i < 32; ++i) { const int kk = 2 * i + (lane >> 5); scr[kk * 33 + (lane & 31)] = W[(size_t)(k0 + kk) * N + n0 + (lane & 31)]; }
    asm volatile("s_waitcnt lgkmcnt(0)" ::: "memory");
    const int c = lane & 7;
#pragma unroll
    for (int j = 0; j < 4; ++j) { const int n = (lane >> 3) + 8 * j; const LAS float* s = scr + (8 * c) * 33 + n;
        v4u o; o.x = fa::cvtpk(s[0 * 33], s[1 * 33]); o.y = fa::cvtpk(s[2 * 33], s[3 * 33]); o.z = fa::cvtpk(s[4 * 33], s[5 * 33]); o.w = fa::cvtpk(s[6 * 33], s[7 * 33]);
        *(v4u*)(WT + (size_t)(dst_row0 + n) * K + k0 + 8 * c) = o; }
    asm volatile("s_waitcnt lgkmcnt(0)" ::: "memory");
}

__device__ __forceinline__ void prologue(const Args& a, LAS unsigned char* lds, int tid, int G) {
    const int lane = tid & 63, wave = __builtin_amdgcn_readfirstlane(tid >> 6);
    float* mod = (float*)(a.ws + WS_MOD);
    if ((int)blockIdx.x < 288) {
        LAS float* sv = (LAS float*)lds; LAS float* red = sv + 5120;
        for (int i = tid; i < 5120; i += 512) { const int ci = i >> 10, k = i & 1023; const float c = ci < 4 ? a.in[I_C][ci * 1024 + k] : a.in[I_CCTX][k]; sv[i] = c / (1.0f + __expf(-c)); }
        __syncthreads();
        for (int it = blockIdx.x; it < 288; it += G) {
            const int l = it / 144, j0 = (it % 144) * 64;
            const float* W = a.in[I_WADA] + (size_t)l * 1024 * NADA + j0 + lane;
            float a0 = 0.f, a1 = 0.f, a2 = 0.f, a3 = 0.f, a4 = 0.f;
#pragma unroll 16
            for (int kk = 0; kk < 128; ++kk) { const int k = wave * 128 + kk; const float wv = W[(size_t)k * NADA];
                a0 += sv[k] * wv; a1 += sv[1024 + k] * wv; a2 += sv[2048 + k] * wv; a3 += sv[3072 + k] * wv; a4 += sv[4096 + k] * wv; }
            red[(wave * 5 + 0) * 64 + lane] = a0; red[(wave * 5 + 1) * 64 + lane] = a1; red[(wave * 5 + 2) * 64 + lane] = a2; red[(wave * 5 + 3) * 64 + lane] = a3; red[(wave * 5 + 4) * 64 + lane] = a4;
            __syncthreads();
            if (tid < 320) { const int i = tid >> 6, ln = tid & 63; float s = 0.f;
#pragma unroll
                for (int ww = 0; ww < 8; ++ww) s += red[(ww * 5 + i) * 64 + ln];
                mod[(size_t)(l * 5 + i) * NADA + j0 + ln] = s + a.in[I_BADA][l * NADA + j0 + ln]; }
            __syncthreads();
        }
    }
    __syncthreads();
    LAS float* scr = (LAS float*)(lds + wave * 16384);
    const int gw = blockIdx.x * 8 + wave, NGW = G * 8;
    constexpr int I_UP = 16 * 88, I_DN = 44 * 32, I_INP = 16 * 88, I_OUTP = 16 * 32;
    constexpr int PER_LAYER = 2 * I_UP + I_DN + I_INP + I_OUTP + 2 * I_UP + I_DN;
    for (int it = gw; it < 2 * PER_LAYER; it += NGW) {
        const int l = it / PER_LAYER; int r = it % PER_LAYER;
        unsigned char* wl = a.ws + WS_W + (size_t)l * WS_WLAYER;
        int which = 0;
        if (r < 2 * I_UP) which = 0; else { r -= 2 * I_UP; if (r < I_DN) which = 1; else { r -= I_DN; if (r < I_INP) which = 2; else { r -= I_INP; if (r < I_OUTP) which = 3; else { r -= I_OUTP; if (r < 2 * I_UP) which = 4; else { r -= 2 * I_UP; which = 5; } } } } }
        if (which == 0 || which == 4) {
            const int bj = r / I_UP; const int rr = r % I_UP; const int kb = rr / 88, nb = rr % 88; const int n0 = 32 * nb;
            const float* W = (which == 0 ? (bj ? a.in[I_F1W3] : a.in[I_F1W1]) : (bj ? a.in[I_F2W3] : a.in[I_F2W1])) + (size_t)l * 1024 * DFF;
            bf16_t* WT = (bf16_t*)(wl + (which == 0 ? WO_UP1 : WO_UP2));
            transpose_item(W, 1024, DFF, WT, 256 * (n0 / 128) + 128 * bj + (n0 % 128), 64 * kb, n0, scr, lane);
        } else if (which == 1 || which == 5) {
            const int kb = r / 32, nb = r % 32;
            const float* W = (which == 1 ? a.in[I_F1W2] : a.in[I_F2W2]) + (size_t)l * DFF * 1024;
            bf16_t* WT = (bf16_t*)(wl + (which == 1 ? WO_DN1 : WO_DN2));
            transpose_item(W, DFF, 1024, WT, 32 * nb, 64 * kb, 32 * nb, scr, lane);
        } else if (which == 2) {
            const int kb = r / 88, nb = r % 88; const int n0 = 32 * nb; const int pn = n0 / 256, rem = n0 % 256; const int comp = rem / 64, bj = (rem % 64) / 32;
            const float* W = a.in[I_WIN] + (size_t)l * 1024 * DIN;
            transpose_item(W, 1024, DIN, (bf16_t*)(wl + WO_IN), 256 * pn + 128 * bj + 32 * comp, 64 * kb, n0, scr, lane);
        } else {
            const int kb = r / 32, nb = r % 32;
            const float* W = a.in[I_WOUT] + (size_t)l * 1024 * 1024;
            transpose_item(W, 1024, 1024, (bf16_t*)(wl + WO_OUT), 32 * nb, 64 * kb, 32 * nb, scr, lane);
        }
    }
}

__device__ __forceinline__ void modulate_phase(const float* srcL, const float* srcC, bf16_t* H, const float* modl, int si, int nrows, int tid, int G, float* dstC, const float* part, int np, const float* pgate, float gs) {
    const int lane = tid & 63, wave = tid >> 6; const int gw = blockIdx.x * 8 + wave, NGW = G * 8;
    for (int row = gw; row < nrows; row += NGW) {
        const bool lat = row < NLAT;
        const f32x4* xr = (const f32x4*)(lat ? srcL + (size_t)row * DM : srcC + (size_t)(row - NLAT) * DM) + lane;
        const float* sh = modl + (size_t)(lat ? (row >> 13) : 4) * NADA + si * DM;
        f32x4 v[4]; float ss = 0.f;
#pragma unroll
        for (int j = 0; j < 4; ++j) v[j] = xr[64 * j];
        if (!lat && np > 0) {
            const f32x4* pr = (const f32x4*)(part + (size_t)(row - NLAT) * DM) + lane; f32x4* xw = (f32x4*)(dstC + (size_t)(row - NLAT) * DM) + lane;
#pragma unroll
            for (int j = 0; j < 4; ++j) {
                f32x4 acc = pr[64 * j];
                for (int p = 1; p < np; ++p) acc += pr[(size_t)p * (NCTX * DM / 4) + 64 * j];
                v[j] += ((const f32x4*)pgate)[lane + 64 * j] * gs * acc; xw[64 * j] = v[j];
            }
        }
#pragma unroll
        for (int j = 0; j < 4; ++j) ss += (v[j].x * v[j].x + v[j].y * v[j].y) + (v[j].z * v[j].z + v[j].w * v[j].w);
        ss = fa::wave_sum(ss, lane);
        const float rstd = rsqrtf(ss * (1.0f / DM) + 1e-6f);
        v2u* o8 = (v2u*)(H + (size_t)row * DM) + lane;
#pragma unroll
        for (int j = 0; j < 4; ++j) {
            const f32x4 h4 = ((const f32x4*)sh)[lane + 64 * j], s4 = ((const f32x4*)(sh + DM))[lane + 64 * j];
            const f32x4 y = v[j] * rstd * (s4 + 1.0f) + h4;
            v2u wv; wv.x = fa::cvtpk(y.x, y.y); wv.y = fa::cvtpk(y.z, y.w); o8[64 * j] = wv;
        }
    }
}
__device__ __forceinline__ void final_norm_phase(const float* Xs, float* X, const float* gain, int tid, int G) {
    const int lane = tid & 63, wave = tid >> 6; const int gw = blockIdx.x * 8 + wave, NGW = G * 8;
    for (int row = gw; row < NLAT; row += NGW) {
        f32x4* xr = (f32x4*)(X + (size_t)row * DM) + lane; const f32x4* xs = (const f32x4*)(Xs + (size_t)row * DM) + lane;
        f32x4 v[4]; float ss = 0.f;
#pragma unroll
        for (int j = 0; j < 4; ++j) { v[j] = xs[64 * j]; ss += (v[j].x * v[j].x + v[j].y * v[j].y) + (v[j].z * v[j].z + v[j].w * v[j].w); }
        ss = fa::wave_sum(ss, lane);
        const float rstd = rsqrtf(ss * (1.0f / DM) + 1e-6f);
#pragma unroll
        for (int j = 0; j < 4; ++j) { const f32x4 g = ((const f32x4*)gain)[lane + 64 * j]; xr[64 * j] = v[j] * rstd * g; }
    }
}

__device__ __forceinline__ void mix_phase(const Args& a, LAS unsigned char* lds, int l, int tid, int G, const int umask) {
    const bf16_t* Z = (const bf16_t*)(a.ws + WS_G); bf16_t* O = (bf16_t*)(a.ws + WS_O);
    const int lane = tid & 63;
    const float linit = (l == 0) ? 0.2f : 0.35550906759f;
    float lam;
    { const float d1 = fa::wave_sum(a.in[I_LQ1][l * 64 + lane] * a.in[I_LK1][l * 64 + lane], lane); const float d2 = fa::wave_sum(a.in[I_LQ2][l * 64 + lane] * a.in[I_LK2][l * 64 + lane], lane);
      lam = __expf(d1) - __expf(d2) + linit; }
    const float* subln = a.in[I_SUBLN] + l * 128;
    const int n_diff = 1024, n_na = 512, n_gm = (l == 0) ? 1056 : 1024, n_nac = (l == 0) ? 16 : 0, n_dc = (l == 0) ? 32 : 0;
    const int total = n_diff + n_na + n_gm + n_nac + n_dc;
    const int tid_m = tid;
    for (int it = blockIdx.x; it < total; it += G) {
        int tid = tid_m; asm volatile("" : "+v"(tid));
        int r = it;
        const bool is_dl = r < n_diff, is_dc = r >= n_diff + n_na + n_gm + n_nac;
        const bool is_nl = !is_dl && r < n_diff + n_na, is_nc = !is_dc && r >= n_diff + n_na + n_gm;
        if (is_dl || is_dc) {
            int b, hd, q0row, nlat;
            if (is_dl) { const int blk = r & 255, k = r >> 8; const int xcd = blk & 7, slot = blk >> 3; const int jj = k * 32 + slot; const int bh = 2 * xcd + (jj >> 6), qb = jj & 63;
                b = bh >> 2; hd = bh & 3; q0row = b * SEQ + qb * 128; nlat = 128; }
            else { const int rr = r - (n_diff + n_na + n_gm + n_nac); b = rr >> 3; hd = (rr >> 1) & 3; q0row = NLAT + b * CTXL + (rr & 1) * 128; nlat = 0; }
            if (umask & 1) fa::diff_unit(lds, Z, O, b, hd, q0row, nlat, lam, 1.0f - linit, subln, tid);
        } else if (is_nl || is_nc) {
            int b, hd, r0, ctxq;
            if (is_nl) { const int rr = r - n_diff; b = rr >> 7; hd = (rr >> 5) & 3; r0 = 4 * (rr & 31); ctxq = 0; }
            else { const int rr = r - (n_diff + n_na + n_gm); b = rr >> 2; hd = rr & 3; r0 = 0; ctxq = 1; }
            if (umask & 2) fa::na_unit(lds, Z, O, a.in[I_RPB] + (size_t)(l * 4 + hd) * 465, b, hd, r0, ctxq, tid);
        } else {
            const int rr = r - (n_diff + n_na); const int chunk = rr >> 2, g = rr & 3;
            const long row0 = chunk < 256 ? (long)chunk * 128 : (long)NLAT + (chunk - 256) * 128;
            if (umask & 4) fa::gmlp_unit(lds, Z, O, a.in[I_GMWS] + (size_t)(l * 4 + g) * 16384, a.in[I_GMBS] + (l * 4 + g) * 128, a.in[I_GMNORM] + (l * 4 + g) * 64, row0, g, tid);
        }
    }
}


#if DBG_CHECK
constexpr size_t WS_DBG = 5 * MiB, WS_XC2 = 404 * MiB;
__device__ __forceinline__ float dbg_bf(const bf16_t* p, size_t i) { return __uint_as_float(((unsigned)p[i]) << 16); }
__device__ __forceinline__ unsigned dbg_hash(unsigned x) { x ^= x >> 16; x *= 0x7feb352du; x ^= x >> 15; x *= 0x846ca68bu; x ^= x >> 16; return x; }
__device__ __forceinline__ bool dbg_bad(float got, float ref, float atol = 0.03f) { return !(fabsf(got - ref) <= atol + 0.03f * fabsf(ref)); }
__device__ __forceinline__ float dbg_block_sum(float v, LAS float* red, int tid) {
    v = fa::wave_sum(v, tid & 63); __syncthreads(); if ((tid & 63) == 0) red[tid >> 6] = v; __syncthreads();
    float s = 0.f; for (int i = 0; i < 8; ++i) s += red[i]; __syncthreads(); return s;
}
__device__ __forceinline__ float dbg_block_max(float v, LAS float* red, int tid) {
    for (int o = 1; o < 64; o <<= 1) v = fmaxf(v, __shfl_xor(v, o));
    __syncthreads(); if ((tid & 63) == 0) red[tid >> 6] = v; __syncthreads();
    float s = red[0]; for (int i = 1; i < 8; ++i) s = fmaxf(s, red[i]); __syncthreads(); return s;
}
template <class KR, class BI>
__device__ __forceinline__ void dbg_attn(const bf16_t* Z, long qrow, int qcol, int kcol, int vcol, int dv, int nk, KR krow, BI bias, LAS float* sc, LAS float* outv, LAS float* red, int tid) {
    float lm = -3e38f;
    for (int i = tid; i < nk; i += 512) { const long kr = krow(i); float s = 0.f; for (int d = 0; d < 64; ++d) s += dbg_bf(Z, (size_t)qrow * DIN + qcol + d) * dbg_bf(Z, (size_t)kr * DIN + kcol + d); s = s * 0.125f + bias(i); sc[i] = s; lm = fmaxf(lm, s); }
    const float m = dbg_block_max(lm, red, tid);
    float ls = 0.f;
    for (int i = tid; i < nk; i += 512) { const float p = __expf(sc[i] - m); sc[i] = p; ls += p; }
    const float tot = dbg_block_sum(ls, red, tid);
    const int d = tid & 127, part = tid >> 7;
    float acc = 0.f;
    if (d < dv) for (int i = part; i < nk; i += 4) acc += sc[i] * dbg_bf(Z, (size_t)krow(i) * DIN + vcol + d);
    __syncthreads();
    LAS float* tmp = red + 16;
    tmp[part * 128 + d] = acc; __syncthreads();
    if (tid < dv) outv[tid] = (tmp[tid] + tmp[128 + tid] + tmp[256 + tid] + tmp[384 + tid]) / tot;
    __syncthreads();
}
__device__ __forceinline__ void dbg_check(const Args& a, LAS unsigned char* lds, int tid, int G, const int l, const int sres) {
    unsigned* flags = (unsigned*)(a.ws + WS_DBG);
    const bf16_t* H = (const bf16_t*)(a.ws + WS_H); const bf16_t* Z = (const bf16_t*)(a.ws + WS_G); const bf16_t* O = (const bf16_t*)(a.ws + WS_O);
    const float* mod = (const float*)(a.ws + WS_MOD) + (size_t)l * 5 * NADA;
    const int blk = blockIdx.x;
    if (blk == 7 && tid == 0) atomicOr(flags, 1u);
    if (sres == 6) {
    {
        const int rows[8] = {0, 77, 8192, 20000, 32767, 32768, 33000, 33791};
        bool bad = false;
        for (int sidx = tid; sidx < 8 * 70; sidx += 512) {
            int ri = sidx / 70; const int row = (int)(dbg_hash(blk * 8 + ri + 1000) % (unsigned)MT); const int col = ((sidx % 70) * 37 + blk) % DIN;
            const bool rope = (col >= 1280 && col < 2304 && row < NLAT);
            const int c1 = rope ? (col & ~63) + (col & 31) : col; const int c2 = c1 + 32;
            float x1 = 0.f, x2 = 0.f;
            for (int k = 0; k < 1024; ++k) { const float hv = dbg_bf(H, (size_t)row * DM + k); x1 += hv * a.in[I_WIN][(size_t)l * 1024 * DIN + (size_t)k * DIN + c1]; if (rope) x2 += hv * a.in[I_WIN][(size_t)l * 1024 * DIN + (size_t)k * DIN + c2]; }
            float ref = x1;
            if (col >= 768 && col < 1280) ref = 0.5f * x1 * (1.0f + erff(x1 * 0.70710678f));
            if (rope) { const int t = row & 8191; const int j = col & 31; const float pos = (j < 16) ? (float)(t >> 6) : (float)(t & 63); const float fr = __builtin_amdgcn_exp2f(-(float)(j & 15) * 0.8304820237218406f);
                const float ang = pos * fr; const float c = __cosf(ang), s = __sinf(ang); ref = ((col & 63) < 32) ? x1 * c - x2 * s : x1 * s + x2 * c; }
            if (dbg_bad(dbg_bf(Z, (size_t)row * DIN + col), ref)) bad = true;
        }
        (void)rows;
        if (bad) atomicOr(flags, 2u);
    }
    {
        bool bad = false;
        if (tid < 144) {
            const int ci = tid / 36, g = (tid / 9) & 3, pi = (tid / 3) % 3, wi = tid % 3;
            const long row0 = 128L * (dbg_hash(blk * 4 + ci + 77) % (l == 0 ? 264u : 256u)); const int p = (int)(dbg_hash(blk * 16 + pi + 5) % 128u); const int w = (int)(dbg_hash(blk * 16 + wi + 11) % 64u);
            float s = 0.f;
            for (int q = 0; q < 128; ++q) { float ss = 0.f; for (int e = 0; e < 64; ++e) { const float v = dbg_bf(Z, (size_t)(row0 + q) * DIN + 1024 + 64 * g + e); ss += v * v; }
                const float vn = dbg_bf(Z, (size_t)(row0 + q) * DIN + 1024 + 64 * g + w) * rsqrtf(ss / 64.f + 1e-6f) * a.in[I_GMNORM][(l * 4 + g) * 64 + w];
                s += a.in[I_GMWS][(size_t)(l * 4 + g) * 16384 + p * 128 + q] * vn; }
            s += a.in[I_GMBS][(l * 4 + g) * 128 + p];
            const float ref = dbg_bf(Z, (size_t)(row0 + p) * DIN + 768 + 64 * g + w) * s;
            if (dbg_bad(dbg_bf(O, (size_t)(row0 + p) * DM + 256 + 64 * g + w), ref)) bad = true;
        }
        if (bad) atomicOr(flags, 4u);
    }
    for (int pass = 2; pass <= 3; ++pass) {
        LAS float* sc = (LAS float*)lds; LAS float* outv = sc + 8448; LAS float* outv2 = outv + 128; LAS float* red = outv2 + 128;
        bool bad = false;
        for (int smp = 0; smp < 2; ++smp) {
            if (pass == 2) {
                const unsigned hh_ = dbg_hash(blk * 2 + smp + 333); const int b = hh_ & 3, hd = (hh_ >> 2) & 3; const int t = (hh_ >> 4) & 8191; const bool cq = false;
                const int gr = t >> 6, gc = t & 63; int ks = gr - 4; ks = ks < 0 ? 0 : (ks > 120 ? 120 : ks); int w0 = gc - 8; w0 = w0 < 0 ? 0 : (w0 > 48 ? 48 : w0);
                const long qrow = (long)b * SEQ + t; const float* rp = a.in[I_RPB] + (size_t)(l * 4 + hd) * 465;
                auto krow = [=](int i) -> long { return i < 128 ? (long)b * SEQ + (ks + (i >> 4)) * 64 + w0 + (i & 15) : (long)NLAT + b * CTXL + (i - 128); };
                auto bias = [=](int i) -> float { return i < 128 ? rp[(ks + (i >> 4) - gr + 7) * 31 + (w0 + (i & 15) - gc + 15)] : 0.f; };
                dbg_attn(Z, qrow, hd * 64, 256 + hd * 64, 512 + hd * 64, 64, 384, krow, bias, sc, outv, red, tid);
                if (tid < 64 && dbg_bad(dbg_bf(O, (size_t)qrow * DM + hd * 64 + tid), outv[tid], 0.01f)) bad = true;
                (void)cq;
            } else {
                const unsigned hh_ = dbg_hash(blk * 2 + smp + 999); const int b = hh_ & 3, hd = (hh_ >> 2) & 3; const bool cq = ((hh_ >> 20) & 15) == 0 && (l == 0);
                const long qrow = cq ? (long)NLAT + b * CTXL + ((hh_ >> 4) & 255) : (long)b * SEQ + ((hh_ >> 4) & 8191);
                const int nk = cq ? 256 : 8448;
                auto krow = [=](int i) -> long { return cq ? (long)NLAT + b * CTXL + i : (i < 8192 ? (long)b * SEQ + i : (long)NLAT + b * CTXL + (i - 8192)); };
                auto bias = [=](int i) -> float { return 0.f; };
                dbg_attn(Z, qrow, 1280 + hd * 128, 1792 + hd * 128, 2304 + hd * 128, 128, nk, krow, bias, sc, outv, red, tid);
                dbg_attn(Z, qrow, 1280 + hd * 128 + 64, 1792 + hd * 128 + 64, 2304 + hd * 128, 128, nk, krow, bias, sc, outv2, red, tid);
                float d1 = 0.f, d2 = 0.f; for (int e = 0; e < 64; ++e) { d1 += a.in[I_LQ1][l * 64 + e] * a.in[I_LK1][l * 64 + e]; d2 += a.in[I_LQ2][l * 64 + e] * a.in[I_LK2][l * 64 + e]; }
                const float linit = l == 0 ? 0.2f : 0.35550906759f; const float lam = __expf(d1) - __expf(d2) + linit;
                float ss = 0.f; for (int e = 0; e < 128; ++e) { const float v = outv[e] - lam * outv2[e]; ss += v * v; }
                if (tid < 128) { const float ref = (outv[tid] - lam * outv2[tid]) * rsqrtf(ss / 128.f + 1e-6f) * a.in[I_SUBLN][l * 128 + tid] * (1.0f - linit);
                    if (dbg_bad(dbg_bf(O, (size_t)qrow * DM + 512 + hd * 128 + tid), ref, 0.05f)) bad = true; }
                __syncthreads();
            }
        }
        if (bad) atomicOr(flags, pass == 2 ? 8u : 16u);
    }
    }
    if (sres != 6) {
        const bf16_t* Gb = (const bf16_t*)(a.ws + WS_G);
        const float* w1 = (sres == 2 ? a.in[I_F1W1] : a.in[I_F2W1]) + (size_t)l * 1024 * DFF; const float* w3 = (sres == 2 ? a.in[I_F1W3] : a.in[I_F2W3]) + (size_t)l * 1024 * DFF;
        bool bad = false;
        for (int sidx = tid; sidx < 6 * 60; sidx += 512) {
            const int ri = sidx / 60; const int row = (int)(dbg_hash(blk * 8 + ri + 31337) % (unsigned)NLAT); const int col = ((sidx % 60) * 47 + blk * 11) % DFF;
            float x1 = 0.f, x3 = 0.f;
            for (int k = 0; k < 1024; ++k) { const float hv = dbg_bf(H, (size_t)row * DM + k); x1 += hv * w1[(size_t)k * DFF + col]; x3 += hv * w3[(size_t)k * DFF + col]; }
            const float ref = x1 / (1.0f + __expf(-x1)) * x3;
            if (dbg_bad(dbg_bf(Gb, (size_t)row * DFF + col), ref)) bad = true;
        }
        if (bad) atomicOr(flags, 2u);
    }
    {
        const float* saved = (const float*)(a.ws + WS_DBG + 65536);
        const bf16_t* A = sres == 6 ? O : (const bf16_t*)(a.ws + WS_G); const int K = sres == 6 ? DM : DFF;
        const float* W = sres == 6 ? a.in[I_WOUT] + (size_t)l * DM * DM : (sres == 2 ? a.in[I_F1W2] : a.in[I_F2W2]) + (size_t)l * DFF * DM;
        const int gidx = sres == 2 ? 2 : (sres == 6 ? 5 : 8); const float gs = sres == 6 ? 1.0f : 0.5f;
        bool bad = false;
        for (int sidx = tid; sidx < 64; sidx += 512) {
            const int ri = blk; const int row = (int)(dbg_hash(blk + 4242) % (unsigned)NLAT); const int col = (sidx * 16 + blk) % DM;
            float acc = 0.f; for (int k = 0; k < K; ++k) acc += dbg_bf(A, (size_t)row * K + k) * W[(size_t)k * DM + col];
            const float ref = saved[ri * DM + col] + gs * mod[(size_t)(row >> 13) * NADA + gidx * DM + col] * acc;
            if (dbg_bad(a.out[(size_t)row * DM + col], ref)) bad = true;
        }
        if (bad) atomicOr(flags, 32u);
    }
    if (sres != 6 && blk == 8) {
        const float* modall = (const float*)(a.ws + WS_MOD);
        bool bad = false;
        if (tid < 100) { const int ll = tid & 1, i = (tid >> 1) % 5, j = (tid * 977) % NADA;
            float acc = 0.f; for (int k = 0; k < 1024; ++k) { const float c = i < 4 ? a.in[I_C][i * 1024 + k] : a.in[I_CCTX][k]; acc += c / (1.0f + __expf(-c)) * a.in[I_WADA][(size_t)ll * 1024 * NADA + (size_t)k * NADA + j]; }
            acc += a.in[I_BADA][ll * NADA + j];
            if (dbg_bad(modall[(size_t)(ll * 5 + i) * NADA + j], acc)) bad = true; }
        if (bad) atomicOr(flags, 4u);
    }
    if (sres == 2 && l == 0 && blk == 9) {
        bool bad = false;
        if (tid < 5 * 40) { const int ri = tid / 40; const int row = ri == 0 ? 0 : ri == 1 ? 12345 : ri == 2 ? 32767 : ri == 3 ? 32768 : 33791; const int col = ((tid % 40) * 53) % DM;
            const float* xr = row < NLAT ? a.in[I_X] + (size_t)row * DM : a.in[I_CTX] + (size_t)(row - NLAT) * DM; const int bi = row < NLAT ? row >> 13 : 4;
            float ss = 0.f; for (int k = 0; k < DM; ++k) ss += xr[k] * xr[k];
            const float ref = xr[col] * rsqrtf(ss / DM + 1e-6f) * (1.0f + mod[(size_t)bi * NADA + DM + col]) + mod[(size_t)bi * NADA + col];
            if (dbg_bad(dbg_bf(H, (size_t)row * DM + col), ref)) bad = true; }
        if (bad) atomicOr(flags, 8u);
    }
    if (sres == 6) {
        const float* saved = (const float*)(a.ws + WS_DBG + 65536);
        bool bad = false;
        if (tid < 40) { const int ri = blk; const int row = (int)(dbg_hash(blk + 4242) % (unsigned)NLAT); const int col = ((tid % 40) * 53 + blk) % DM; const int bi = row >> 13;
            float ss = 0.f; for (int k = 0; k < DM; ++k) ss += saved[ri * DM + k] * saved[ri * DM + k];
            const float ref = saved[ri * DM + col] * rsqrtf(ss / DM + 1e-6f) * (1.0f + mod[(size_t)bi * NADA + 4 * DM + col]) + mod[(size_t)bi * NADA + 3 * DM + col];
            if (dbg_bad(dbg_bf(H, (size_t)row * DM + col), ref)) bad = true; }
        if (bad) atomicOr(flags, 64u);
    }
    if (sres == 6 && l == 0 && blk == 10) {
        LAS float* sc = (LAS float*)lds; LAS float* outv = sc + 8448; LAS float* red = outv + 256;
        const int b = 2, hd = 1; const long qrow = (long)NLAT + b * CTXL + 200;
        auto krow = [=](int i) -> long { return (long)NLAT + b * CTXL + i; };
        auto bias = [=](int i) -> float { return 0.f; };
        dbg_attn(Z, qrow, hd * 64, 256 + hd * 64, 512 + hd * 64, 64, 256, krow, bias, sc, outv, red, tid);
        bool bad = false;
        if (tid < 64 && dbg_bad(dbg_bf(O, (size_t)qrow * DM + hd * 64 + tid), outv[tid])) bad = true;
        if (bad) atomicOr(flags, 8u);
    }
}
__device__ __forceinline__ void dbg_save(const Args& a, const float* src, int tid) {
    float* saved = (float*)(a.ws + WS_DBG + 65536);
    { const int row = (int)(dbg_hash(blockIdx.x + 4242) % (unsigned)NLAT); for (int i = tid; i < DM; i += 512) saved[blockIdx.x * DM + i] = src[(size_t)row * DM + i]; }
}
__device__ __forceinline__ void dbg_save2(const Args& a, const float* src, int tid) {
    float* saved = (float*)(a.ws + WS_DBG + 2 * MiB);
    { const int row = (int)(dbg_hash(blockIdx.x + 777) % (unsigned)NLAT); for (int i = tid; i < DM; i += 512) saved[blockIdx.x * DM + i] = src[(size_t)row * DM + i]; }
}
__device__ __forceinline__ void dbg_check2(const Args& a, int tid) {
    const float* saved = (const float*)(a.ws + WS_DBG + 2 * MiB) + blockIdx.x * DM; unsigned* flags = (unsigned*)(a.ws + WS_DBG);
    const int row = (int)(dbg_hash(blockIdx.x + 777) % (unsigned)NLAT);
    float ss = 0.f; for (int k = 0; k < DM; ++k) ss += saved[k] * saved[k];
    bool bad = false;
    for (int c = tid; c < DM; c += 512) { const float ref = saved[c] * rsqrtf(ss / DM + 1e-6f) * a.in[I_FNORM][c]; if (dbg_bad(a.out[(size_t)row * DM + c], ref, 0.01f)) bad = true; }
    if (bad) atomicOr(flags, 64u);
}
__device__ __forceinline__ void dbg_fill(const Args& a, int tid, int G) {
    const unsigned mask = *(const volatile unsigned*)(a.ws + WS_DBG);
    const float c = __builtin_amdgcn_exp2f(0.5f * (float)(mask + 1));
    for (size_t i = (size_t)blockIdx.x * 512 + tid; i < (size_t)NLAT * DM; i += (size_t)G * 512) a.out[i] = c;
}
#endif

#define XB_TMO      128
#define XB_XCNT(j)  (256  + 64 * (j))
#define XB_XSUB(j)  (1280 + 64 * (j))
#define XB_XGEN(j)  (2304 + 64 * (j))
#define XB_TOP      3328
#define XB_TOPGEN   3392
#define XCD_BAR_WORDS 3456
#define XB_SPIN_CAP (1u << 24)

__device__ __forceinline__ unsigned xb_ld(unsigned* p)              { return __hip_atomic_load(p, __ATOMIC_RELAXED, __HIP_MEMORY_SCOPE_AGENT); }
__device__ __forceinline__ unsigned xb_add(unsigned* p, unsigned v) { return __hip_atomic_fetch_add(p, v, __ATOMIC_RELAXED, __HIP_MEMORY_SCOPE_AGENT); }
__device__ __forceinline__ unsigned xb_xcc_id() { return (unsigned)__builtin_amdgcn_s_getreg((3 << 11) | 20) & 0xFu; }
#define XB_SPIN(cond, bar) do { unsigned _sp = 0; while (cond) { __builtin_amdgcn_s_sleep(1); \
    if ((++_sp & 255u) == 0u) { if (xb_ld(&(bar)[XB_TMO])) break; if (_sp > XB_SPIN_CAP) { atomicAdd(&(bar)[XB_TMO], 1u); break; } } } } while (0)

struct XcdBarrier {
    unsigned* bar; unsigned x;
    volatile LAS unsigned* st;
};

__device__ __forceinline__ XcdBarrier xcd_barrier_post(unsigned* bar, volatile LAS unsigned* st) {
    XcdBarrier b; b.bar = bar; b.x = xb_xcc_id(); b.st = st;
    if (threadIdx.x == 0) (void)xb_add(&bar[XB_XCNT(b.x)], 1u);
    return b;
}
__device__ __forceinline__ void xcd_barrier_complete(unsigned* bar, unsigned x, unsigned& nloc, unsigned& nx) {
    const unsigned G = gridDim.x * gridDim.y * gridDim.z;
    unsigned sum, cnt, mine, sp = 0u;
    for (;;) {
        sum = 0u; cnt = 0u; mine = 0u;
#pragma unroll
        for (unsigned j = 0; j < 16; ++j) { const unsigned c = xb_ld(&bar[XB_XCNT(j)]); sum += c; cnt += (c > 0u) ? 1u : 0u; mine = (j == x) ? c : mine; }
        if (sum == G) break;
        __builtin_amdgcn_s_sleep(1);
        if ((++sp & 255u) == 0u) { if (xb_ld(&bar[XB_TMO])) break; if (sp > XB_SPIN_CAP) { atomicAdd(&bar[XB_TMO], 1u); break; } }
    }
    nloc = mine > 0u ? mine : 1u; nx = cnt > 0u ? cnt : 1u;
}

__device__ __forceinline__ void xcd_barrier(const XcdBarrier& b) {
    asm volatile("s_waitcnt vmcnt(0)" ::: "memory");
    __syncthreads();
    if (threadIdx.x == 0) {
        unsigned* bar = b.bar;
        __builtin_amdgcn_s_waitcnt(0);
        unsigned nloc = b.st[0], nx = b.st[1];
        if (nloc == 0u) { xcd_barrier_complete(bar, b.x, nloc, nx); b.st[0] = nloc; b.st[1] = nx; }
        const unsigned old = xb_add(&bar[XB_XSUB(b.x)], 1u);
        const unsigned gen = old / nloc;
        if (old + 1u == (gen + 1u) * nloc) {
            __builtin_amdgcn_fence(__ATOMIC_RELEASE, "agent");
            asm volatile("s_waitcnt vmcnt(0)" ::: "memory");
            const unsigned og = xb_add(&bar[XB_TOP], 1u);
            const unsigned tg = og / nx;
            if (og + 1u == (tg + 1u) * nx) xb_add(&bar[XB_TOPGEN], 1u);
            else XB_SPIN(xb_ld(&bar[XB_TOPGEN]) == tg, bar);
            __builtin_amdgcn_fence(__ATOMIC_ACQUIRE, "agent");
            xb_add(&bar[XB_XGEN(b.x)], 1u);
            asm volatile("s_waitcnt vmcnt(0)" ::: "memory");
        } else {
            XB_SPIN(xb_ld(&bar[XB_XGEN(b.x)]) == gen, bar);
            __builtin_amdgcn_fence(__ATOMIC_ACQUIRE, "agent");
            asm volatile("s_waitcnt vmcnt(0)" ::: "memory");
        }
    }
    __syncthreads();
}

constexpr size_t WS_PART = 404 * MiB;
constexpr size_t WS_BAR = 6 * MiB;
__global__ void __launch_bounds__(512, 2) mega_fwd(Args a) {
    extern __shared__ __attribute__((aligned(16))) unsigned char lds_raw[];
    LAS unsigned char* lds = (LAS unsigned char*)lds_raw;
    const int tid0 = threadIdx.x, G = gridDim.x;
    volatile LAS unsigned* MISC = (volatile LAS unsigned*)(lds + 131072 + 512);
    if (tid0 < 2) MISC[tid0] = 0u;
    __syncthreads();
    unsigned* barw = (unsigned*)(a.ws + WS_BAR);
    XcdBarrier xbar; xbar.bar = barw; xbar.x = 0; xbar.st = MISC;
    float* XL = a.out; float* XC = (float*)(a.ws + WS_XC);
    bf16_t* H = (bf16_t*)(a.ws + WS_H); bf16_t* O = (bf16_t*)(a.ws + WS_O); bf16_t* GB = (bf16_t*)(a.ws + WS_G);
    const float* mod = (const float*)(a.ws + WS_MOD);
    for (int step = a.ph_lo; step < a.ph_hi; ++step) {
        int tid = tid0; asm volatile("" : "+v"(tid));
#if DBG_CHECK
        if (step == 100) { dbg_check(a, lds, tid, G, (DBG_STOP - 1) / 10, (DBG_STOP - 1) % 10); continue; }
        if (step == 103) { dbg_save2(a, XL, tid); continue; }
        if (step == 104) { dbg_check2(a, tid); continue; }
        if (step == 102) { dbg_save(a, (DBG_STOP <= 3) ? a.in[I_X] : XL, tid); continue; }
        if (step == 101) { if (DBG_FILL) dbg_fill(a, tid, G); continue; }
        if (step == 0 && blockIdx.x == 0 && tid == 0) *(unsigned*)(a.ws + 5 * MiB) = 0u;
#endif
        if (step == 0) { if (blockIdx.x == 0) for (int i = tid; i < XCD_BAR_WORDS; i += 512) barw[i] = 0u; if (PH_MASK & 1) prologue(a, lds, tid, G); }
        else if (step == NSTEPS - 1) { if (PH_MASK & 2) final_norm_phase(DBG_IDENT ? a.in[I_X] : XL, XL, a.in[I_FNORM], tid, G); }
        else {
            const int l = (step - 1) / 10, s = (step - 1) % 10;
            if (((DBG_SKIP >> s) & 1) && ((DBG_SKIP_LAYERS >> l) & 1)) continue;
            const float* modl = mod + (size_t)l * 5 * NADA;
            const unsigned char* wl = a.ws + WS_W + (size_t)l * WS_WLAYER;
            const bool first = (l == 0 && s <= 2);
            const float* srcL = first ? a.in[I_X] : XL; const float* srcC = first ? a.in[I_CTX] : XC;
            const bool lat_only = (l == 1 && s >= 6);
            const int Mrows = lat_only ? NLAT : MT;
            if (s == 0 || s == 3 || s == 7) { if (PH_MASK & 4) {
                const bool pend = !lat_only && !(l == 0 && s == 0);
                const int np = !pend ? 0 : (s == 7 ? 4 : 11);
                const float* pgate = mod + (size_t)(((s == 0 && l > 0) ? l - 1 : l) * 5 + 4) * NADA + (s == 0 ? 8 : (s == 3 ? 2 : 5)) * DM;
                const float* msrcC = (l == 0 && s == 3) ? a.in[I_CTX] : srcC;
                modulate_phase(srcL, msrcC, H, modl, s == 0 ? 0 : (s == 3 ? 3 : 6), Mrows, tid, G, XC, (const float*)(a.ws + WS_PART), np, pgate, s == 7 ? 1.0f : 0.5f); }
            } else if (s == 1 || s == 8) { if (PH_MASK & 8) {
                pg8::Gemm g{H, (const bf16_t*)(wl + (s == 1 ? WO_UP1 : WO_UP2)), Mrows, 2 * DFF, DM}; pg8::StaticOrder S; S.init(Mrows, 2 * DFF, G, (int)blockIdx.x);
                pg8::EpiSwiGLU E{GB, DFF};
                pg8::gemm_phase<pg8::EpiSwiGLU, pg8::StaticOrder, true, true>(lds, g, S, E); }
            } else if (s == 2 || s == 6 || s == 9) { if (PH_MASK & 16) {
                const bf16_t* A = (s == 6) ? O : GB; const int K = (s == 6) ? DM : DFF;
                const bf16_t* Bt = (const bf16_t*)(wl + (s == 2 ? WO_DN1 : (s == 6 ? WO_OUT : WO_DN2)));
                pg8::Gemm g{A, Bt, Mrows, DM, K}; pg8::SplitOrder S; S.init(G, (int)blockIdx.x, lat_only ? 0 : 4, s == 6 ? 4 : 11);
                pg8::EpiResid E{srcL, srcC, XL, XC, modl, s == 2 ? 2 : (s == 6 ? 5 : 8), s == 6 ? 1.0f : 0.5f, (float*)(a.ws + WS_PART)};
                pg8::gemm_phase<pg8::EpiResid, pg8::SplitOrder, true, true>(lds, g, S, E); }
            } else if (s == 4) { if (PH_MASK & 32) {
                pg8::Gemm g{H, (const bf16_t*)(wl + WO_IN), MT, DIN, DM}; pg8::StaticOrder S; S.init(MT, DIN, G, (int)blockIdx.x);
                pg8::EpiInProj E{GB};
                pg8::gemm_phase<pg8::EpiInProj, pg8::StaticOrder, true, true>(lds, g, S, E); }
            } else {
                if (PH_MASK & 64) for (int rep_ = 0; rep_ < REP_MIX; ++rep_) mix_phase(a, lds, l, tid, G, rep_ == 0 ? 7 : REP_MASK);
            }
        }
        if (step + 1 < a.ph_hi) {
            if (step == a.ph_lo) { cg::this_grid().sync(); xbar = xcd_barrier_post(barw, MISC); }
            else xcd_barrier(xbar);
        }
    }
}

extern "C" void kernel_launch(void* const* d_in, const int* in_sizes, int n_in, void* d_out, int out_size, void* d_ws, size_t ws_size, hipStream_t stream) {
    static int grid = 0;
    if (grid == 0) {
        if (n_in != 24 || in_sizes[0] != NLAT * DM || out_size != NLAT * DM || ws_size < WS_END + 44 * MiB) { fprintf(stderr, "kernel_launch: unexpected shapes (n_in %d, in0 %d, out %d, ws %zu)\n", n_in, n_in > 0 ? in_sizes[0] : -1, out_size, ws_size); grid = -1; return; }
        int dev = 0, cus = 0, per_cu = 0;
        if (hipGetDevice(&dev) != hipSuccess || hipDeviceGetAttribute(&cus, hipDeviceAttributeMultiprocessorCount, dev) != hipSuccess) { grid = -1; return; }
        if (hipFuncSetAttribute((const void*)mega_fwd, hipFuncAttributeMaxDynamicSharedMemorySize, LDS_BYTES) != hipSuccess) { fprintf(stderr, "kernel_launch: hipFuncSetAttribute failed\n"); grid = -1; return; }
        if (hipOccupancyMaxActiveBlocksPerMultiprocessor(&per_cu, (const void*)mega_fwd, 512, LDS_BYTES) != hipSuccess || per_cu < 1) { fprintf(stderr, "kernel_launch: occupancy query gave %d\n", per_cu); per_cu = 1; }
        (void)hipGetLastError();
        grid = cus * (per_cu > 1 ? 1 : per_cu);
    }
    if (grid < 0) return;
    Args a{};
    for (int i = 0; i < 24; ++i) a.in[i] = (const float*)d_in[i];
    a.out = (float*)d_out; a.ws = (unsigned char*)d_ws;
#if ONE_LAUNCH
    a.ph_lo = 0; a.ph_hi = NSTEPS;
    void* args[] = {&a};
    hipError_t e = hipLaunchCooperativeKernel((const void*)mega_fwd, dim3(grid), dim3(512), args, LDS_BYTES, stream);
    if (e != hipSuccess) fprintf(stderr, "cooperative launch failed: %s (grid %d)\n", hipGetErrorString(e), grid);
#else
#if DBG_CHECK
    for (int st = 0; st < DBG_STOP + (DBG_STOP == 20 ? 7 : 4); ++st) { const int k_ = st - DBG_STOP; const int sid = st < DBG_STOP ? st : (k_ == 0 ? 102 : (k_ == 1 ? DBG_STOP : (k_ == 2 ? 100 : (DBG_STOP != 20 ? 101 : (k_ == 3 ? 103 : (k_ == 4 ? 21 : (k_ == 5 ? 104 : 101))))))); a.ph_lo = sid; a.ph_hi = sid + 1; hipLaunchKernelGGL(mega_fwd, dim3(grid), dim3(512), LDS_BYTES, stream, a); }
#else
    for (int st = 0; st < NSTEPS; ++st) { a.ph_lo = st; a.ph_hi = st + 1; hipLaunchKernelGGL(mega_fwd, dim3(grid), dim3(512), LDS_BYTES, stream, a); }
#endif
#endif
}
```
